# Optimizing an MI355X kernel written in HIP

```python
import math
import jax, jax.numpy as jnp
from jax import lax
import numpy as np

D_MODEL = 2048
BATCH = 1
SEQ = 16384
DEPTH = 2

CHUNK = 64
CONV_W = D_MODEL // 4
CONV_K = 3
RET_HEADS = 6
RET_DK = 64
RET_DV = 128
RET_QK = RET_HEADS * RET_DK
RET_V = RET_HEADS * RET_DV
FOX_HEADS = 6
FOX_DH = 128
FOX_W = FOX_HEADS * FOX_DH
Q_BLOCK = 128
D_MIX = CONV_W + RET_V + FOX_W
IN_SPLITS = (CONV_W, CONV_W, CONV_W, RET_QK, RET_QK, RET_V, RET_V, FOX_W, FOX_W, FOX_W, FOX_HEADS)
N_IN = 3 * CONV_W + 2 * RET_QK + 2 * RET_V + 3 * FOX_W + FOX_HEADS
N_EXPERTS = 64
N_GROUPS = 8
GROUP_SIZE = N_EXPERTS // N_GROUPS
TOP_K = 2
D_EXPERT = D_MODEL // 4
EXPERT_BLOCK = 128
ROPE_BASE = 10000.0
EPS = 1e-6

kernel_name = "hybrid_conv_retention_fox_moe_adaln"

F32 = jnp.float32


def rms_norm(x, g):
    xf = x.astype(F32)
    y = xf * lax.rsqrt(jnp.mean(xf * xf, axis=-1, keepdims=True) + EPS)
    return (y * g.astype(F32)).astype(x.dtype)


def modulate(x, g, shift, scale):
    return rms_norm(x, g) * (1.0 + scale[:, None, :]) + shift[:, None, :]


def rotary(t, pos):
    half = t.shape[-1] // 2
    inv = ROPE_BASE ** (-jnp.arange(half, dtype=F32) / half)
    ang = pos[:, None] * inv[None, :]
    cos = jnp.cos(ang)[None, :, None, :]
    sin = jnp.sin(ang)[None, :, None, :]
    tf = t.astype(F32)
    t1, t2 = tf[..., :half], tf[..., half:]
    return jnp.concatenate([t1 * cos - t2 * sin, t2 * cos + t1 * sin], axis=-1).astype(t.dtype)


def short_conv(b_gate, c_gate, u, w):
    z = c_gate * u
    y = lax.conv_general_dilated(
        z, w[:, None, :].astype(z.dtype), window_strides=(1,), padding=[(CONV_K - 1, 0)],
        dimension_numbers=("NWC", "WIO", "NWC"), feature_group_count=z.shape[-1])
    return b_gate * y


def retention(q, k, v, gate, gn_g):
    Bsz, S, H, dk = q.shape
    dv = v.shape[-1]
    nc = S // CHUNK

    def chunks(t):
        return t.reshape(Bsz, nc, CHUNK, H, t.shape[-1]).transpose(1, 0, 3, 2, 4)

    qc, kc, vc = chunks(q), chunks(k) * (dk ** -0.5), chunks(v)
    log_g = jnp.log(1.0 - 2.0 ** (-5.0 - jnp.arange(H, dtype=F32)))
    n = jnp.arange(CHUNK, dtype=F32)
    intra = jnp.exp(log_g[:, None, None] * jnp.abs(n[:, None] - n[None, :]))
    q_dec = jnp.exp(log_g[:, None] * (n + 1.0))
    k_dec = jnp.exp(log_g[:, None] * (CHUNK - 1.0 - n))
    c_dec = jnp.exp(log_g * CHUNK)

    scores = jnp.einsum('cbhnd,cbhmd->cbhnm', qc, kc) * intra
    o_intra = jnp.einsum('cbhnm,cbhmv->cbhnv', scores, vc.astype(scores.dtype))
    kv = jnp.einsum('cbhmd,cbhmv->cbhdv', (kc * k_dec[:, :, None]).astype(F32), vc.astype(F32))

    def step(state, kv_i):
        return state * c_dec[:, None, None] + kv_i, state

    _, prev = lax.scan(step, jnp.zeros((Bsz, H, dk, dv), F32), kv)
    o_cross = jnp.einsum('cbhnd,cbhdv->cbhnv', qc.astype(F32), prev) * q_dec[:, :, None]
    o = (o_intra.astype(F32) + o_cross).transpose(1, 0, 3, 2, 4).reshape(Bsz, S, H, dv)
    mu = jnp.mean(o, axis=-1, keepdims=True)
    var = jnp.mean((o - mu) ** 2, axis=-1, keepdims=True)
    o = ((o - mu) * lax.rsqrt(var + EPS)).reshape(Bsz, S, H * dv) * gn_g.astype(F32)
    return (jax.nn.silu(gate.astype(F32)) * o).astype(gate.dtype)


def forgetting_attention(q, k, v, f_logit):
    Bsz, S, H, d = q.shape
    nqb = S // Q_BLOCK
    cum = jnp.cumsum(jax.nn.log_sigmoid(f_logit.astype(F32)), axis=1).transpose(0, 2, 1)
    kh = k.transpose(0, 2, 1, 3)
    vh = v.transpose(0, 2, 1, 3)
    qb = q.transpose(0, 2, 1, 3).reshape(Bsz, H, nqb, Q_BLOCK, d).transpose(2, 0, 1, 3, 4)
    cq = cum.reshape(Bsz, H, nqb, Q_BLOCK).transpose(2, 0, 1, 3)
    kpos = jnp.arange(S)
    scale = d ** -0.5

    def block(args):
        i, q_i, c_i = args
        s = jnp.einsum('bhqd,bhkd->bhqk', q_i, kh).astype(F32) * scale
        s = s + c_i[..., None] - cum[:, :, None, :]
        qpos = i * Q_BLOCK + jnp.arange(Q_BLOCK)
        s = jnp.where(kpos[None, :] <= qpos[:, None], s, -jnp.inf)
        p = jax.nn.softmax(s, axis=-1)
        return jnp.einsum('bhqk,bhkd->bhqd', p.astype(vh.dtype), vh)

    out = lax.map(block, (jnp.arange(nqb), qb, cq))
    return out.transpose(1, 0, 3, 2, 4).reshape(Bsz, S, H * d)


def moe_ffn(h, router_w, router_b, w_gate, w_up, w_down):
    Bsz, S, D = h.shape
    T = Bsz * S
    ht = h.reshape(T, D)
    aff = jax.nn.sigmoid((ht @ router_w).astype(F32))
    sel = aff + router_b.astype(F32)
    grp_score = lax.top_k(sel.reshape(T, N_GROUPS, GROUP_SIZE), 2)[0].sum(-1)
    g_idx = jnp.argmax(grp_score, axis=-1)
    in_group = (jnp.arange(N_EXPERTS) // GROUP_SIZE)[None, :] == g_idx[:, None]
    _, top_idx = lax.top_k(jnp.where(in_group, sel, -jnp.inf), TOP_K)
    top_aff = jnp.take_along_axis(aff, top_idx, axis=-1)
    top_w = top_aff / jnp.sum(top_aff, axis=-1, keepdims=True)

    A = T * TOP_K
    P = ((A + N_EXPERTS * (EXPERT_BLOCK - 1)) + EXPERT_BLOCK - 1) // EXPERT_BLOCK * EXPERT_BLOCK
    nb = P // EXPERT_BLOCK
    flat_e = top_idx.reshape(A)
    order = jnp.argsort(flat_e)
    sorted_e = flat_e[order]
    counts = jnp.bincount(flat_e, length=N_EXPERTS)
    padded = (counts + EXPERT_BLOCK - 1) // EXPERT_BLOCK * EXPERT_BLOCK
    pad_end = jnp.cumsum(padded)
    pad_start = pad_end - padded
    start = jnp.cumsum(counts) - counts
    slot = pad_start[sorted_e] + jnp.arange(A) - start[sorted_e]
    slot_token = jnp.full((P,), T, jnp.int32).at[slot].set((order // TOP_K).astype(jnp.int32))
    xs = jnp.concatenate([ht, jnp.zeros((1, D), ht.dtype)], axis=0)[slot_token].reshape(nb, EXPERT_BLOCK, D)
    blk_e = jnp.minimum(jnp.searchsorted(pad_end, jnp.arange(nb) * EXPERT_BLOCK, side='right'), N_EXPERTS - 1)

    def expert_block(args):
        xb, e = args
        return (jax.nn.silu(xb @ w_gate[e]) * (xb @ w_up[e])) @ w_down[e]

    ys = lax.map(expert_block, (xs, blk_e)).reshape(P, D)
    slot_of_assign = jnp.zeros((A,), slot.dtype).at[order].set(slot)
    y = jnp.sum(ys[slot_of_assign].reshape(T, TOP_K, D) * top_w[..., None].astype(ys.dtype), axis=1)
    return y.reshape(Bsz, S, D)


def setup_inputs(seed: int = 0) -> dict:
    key = jax.random.key(seed)
    ks = jax.random.split(key, 20)

    def nrm(k, shape, scale):
        return jax.random.normal(k, shape, F32) * scale

    L, D = DEPTH, D_MODEL
    return {
        "x": nrm(ks[0], (BATCH, SEQ, D), 1.0),
        "c": nrm(ks[1], (BATCH, D), 1.0),
        "ada_w": nrm(ks[2], (L, D, 6 * D), 0.5 * D ** -0.5),
        "ada_b": nrm(ks[3], (L, 6 * D), 0.02),
        "norm1_g": 1.0 + nrm(ks[4], (L, D), 0.02),
        "norm2_g": 1.0 + nrm(ks[5], (L, D), 0.02),
        "w_in": nrm(ks[6], (L, D, N_IN), D ** -0.5),
        "conv_w": nrm(ks[7], (L, CONV_K, CONV_W), CONV_K ** -0.5),
        "ret_gn_g": 1.0 + nrm(ks[8], (L, RET_V), 0.02),
        "fox_fb": 3.0 + nrm(ks[9], (L, FOX_HEADS), 0.1),
        "w_out": nrm(ks[10], (L, D_MIX, D), D_MIX ** -0.5),
        "router_w": nrm(ks[11], (D, N_EXPERTS), D ** -0.5),
        "router_b": nrm(ks[12], (N_EXPERTS,), 0.01),
        "moe_w_gate": nrm(ks[13], (L, N_EXPERTS, D, D_EXPERT), D ** -0.5),
        "moe_w_up": nrm(ks[14], (L, N_EXPERTS, D, D_EXPERT), D ** -0.5),
        "moe_w_down": nrm(ks[15], (L, N_EXPERTS, D_EXPERT, D), D_EXPERT ** -0.5),
        "final_g": 1.0 + nrm(ks[16], (D,), 0.02),
    }


def reference(x, c, ada_w, ada_b, norm1_g, norm2_g, w_in, conv_w, ret_gn_g, fox_fb, w_out,
              router_w, router_b, moe_w_gate, moe_w_up, moe_w_down, final_g):
    Bsz, S, _ = x.shape
    pos = jnp.arange(S, dtype=F32)
    split_at = np.cumsum(np.array(IN_SPLITS))[:-1].tolist()
    c_act = jax.nn.silu(c)
    for l in range(DEPTH):
        mod = c_act @ ada_w[l] + ada_b[l]
        sh1, sc1, g1, sh2, sc2, g2 = jnp.split(mod, 6, axis=-1)

        h = modulate(x, norm1_g[l], sh1, sc1)
        proj = h @ w_in[l]
        cb, cc, cu, rq, rk, rv, rg, fq, fk, fv, ff = jnp.split(proj, split_at, axis=-1)
        y_conv = short_conv(cb, cc, cu, conv_w[l])
        rq = rotary(rq.reshape(Bsz, S, RET_HEADS, RET_DK), pos)
        rk = rotary(rk.reshape(Bsz, S, RET_HEADS, RET_DK), pos)
        y_ret = retention(rq, rk, rv.reshape(Bsz, S, RET_HEADS, RET_DV), rg, ret_gn_g[l])
        y_fox = forgetting_attention(
            fq.reshape(Bsz, S, FOX_HEADS, FOX_DH), fk.reshape(Bsz, S, FOX_HEADS, FOX_DH),
            fv.reshape(Bsz, S, FOX_HEADS, FOX_DH), ff + fox_fb[l])
        mixed = jnp.concatenate([y_conv.astype(x.dtype), y_ret.astype(x.dtype), y_fox.astype(x.dtype)], axis=-1)
        x = x + g1[:, None, :] * (mixed @ w_out[l])

        h2 = modulate(x, norm2_g[l], sh2, sc2)
        x = x + g2[:, None, :] * moe_ffn(h2, router_w, router_b, moe_w_gate[l], moe_w_up[l], moe_w_down[l]).astype(x.dtype)
    return rms_norm(x, final_g)
```

```cpp
#define MK_PER_PHASE 0
#include <hip/hip_runtime.h>
#include <cstdio>
#include <cstdint>

#define GAS __attribute__((address_space(1)))
#define LAS __attribute__((address_space(3)))
typedef unsigned short bf16;
typedef unsigned v4u __attribute__((ext_vector_type(4)));
typedef unsigned v2u __attribute__((ext_vector_type(2)));
typedef float f32x2 __attribute__((ext_vector_type(2)));
typedef float f32x4 __attribute__((ext_vector_type(4)));
typedef float f32x16 __attribute__((ext_vector_type(16)));
typedef short bf16x8 __attribute__((ext_vector_type(8)));
typedef short s16x4 __attribute__((ext_vector_type(4)));
typedef GAS unsigned gu32;

constexpr int S_ = 16384, D_ = 2048, NL = 2, NIN = 6150, NPJ = 6144;
constexpr int C_CB = 0, C_CC = 512, C_CU = 1024, C_RQ = 1536, C_RK = 1920, C_RV = 2304, C_RG = 3072, C_FQ = 3840, C_FK = 4608, C_FV = 5376, C_FF = 6144;
constexpr int M_CONV = 0, M_RET = 512, M_FOX = 1280;
constexpr int NE = 64, DE = 512, PMAX = 49152;
constexpr float EPS_ = 1e-6f;

namespace pg8 {
#define PG8_LAS __attribute__((address_space(3)))
typedef unsigned short bf16_t;
typedef short bf16x8 __attribute__((ext_vector_type(8)));
typedef float f32x4 __attribute__((ext_vector_type(4)));
typedef unsigned u32x4 __attribute__((ext_vector_type(4)));
constexpr int BM = 256, BK = 64, HALF = 128, HTB = HALF * BK * 2  , STAGE_BYTES = 8 * HTB, NXCD = 8, WGM = 8;

__host__ __device__ __forceinline__ int lds_byte(int r, int c) { const int st = (r >> 4) * 2 + (c >> 5), rr = r & 15, cc = c & 31, ob = rr * 64 + cc * 2; return st * 1024 + (ob ^ (((ob >> 9) & 1) << 5)); }
__host__ __device__ __forceinline__ void stage_rc(int b, int& R, int& C) { const int st = b / 1024, sb = b % 1024, swz = sb ^ (((sb >> 9) & 1) << 5); R = (st >> 1) * 16 + swz / 64; C = (st & 1) * 32 + (swz % 64) / 2; }
__host__ __device__ __forceinline__ int perm32(int rho) { const int n = rho >> 4, i = rho & 15; return 8 * (i >> 2) + 4 * n + (i & 3); }

struct Unit { int pm, pn; long ao, bo; };
struct Gemm { const bf16_t* A; const bf16_t* Bt; int M, N, K, KL, lda; };

struct DenseOrder {
    int nM, nN, nwg, G, c; long tsB;
    __device__ void init(int M, int N, int K, int G_, int c_) { nM = M / BM; nN = N / BM; nwg = nM * nN; G = G_; c = c_; tsB = (long)BM * K * 2; }
    __device__ bool next(int i, Unit& u) const {
        const long L = (long)i * G + c; if (L >= nwg) return false;
        int wgid = (int)L; { const int q = nwg / NXCD, r = nwg % NXCD, xcd = wgid % NXCD, off = wgid / NXCD; wgid = (xcd < r ? xcd * (q + 1) : r * (q + 1) + (xcd - r) * q) + off; }
        const int nig = WGM * nN, gid = wgid / nig, fm = gid * WGM, gsz = (nM - fm) < WGM ? (nM - fm) : WGM;
        u.pm = fm + ((wgid % nig) % gsz); u.pn = (wgid % nig) / gsz; u.ao = (long)u.pm * tsB; u.bo = (long)u.pn * tsB; return true;
    }
    __device__ __forceinline__ void a_ready(const Unit&) const {}
    __device__ __forceinline__ void done(const Unit&) const {}
};
struct MoeOrder {
    const PG8_LAS int* te; int nT, nN, G, c; long estride, tsB, tsA; const PG8_LAS int* tokbuf;
    __device__ bool next(int i, Unit& u) const {
        long L;
#if 1
        if (G == 256) { const int U = nT * nN, x = c & 7, q = U >> 3, rem = U & 7, len = q + (x < rem ? 1 : 0), start = x * q + (x < rem ? x : rem), idx = (c >> 3) + 32 * i;
            if (idx >= len) return false; L = start + idx; } else
#endif
        { L = (long)i * G + c; if (L >= (long)nT * nN) return false; }
        u.pm = (int)(L / nN); u.pn = (int)(L % nN); u.ao = (long)u.pm * tsA; u.bo = (long)te[u.pm] * estride + (long)u.pn * tsB; return true;
    }
    __device__ __forceinline__ int tok(int i, int r) const { return tokbuf[i * 256 + r]; }
    __device__ __forceinline__ void a_ready(const Unit&) const {}
    __device__ __forceinline__ void done(const Unit&) const {}
};
struct RouterOrder {
    int G, c; long tsA, kbytes;
    __device__ bool next(int i, Unit& u) const {
        const long L = (long)i * G + c; if (L >= 256) return false;
        u.pm = (int)(L >> 2); u.pn = (int)(L & 3); u.ao = (long)u.pm * tsA + (long)u.pn * kbytes; u.bo = (long)u.pn * kbytes; return true;
    }
    __device__ __forceinline__ void a_ready(const Unit&) const {}
    __device__ __forceinline__ void done(const Unit&) const {}
};

__device__ __forceinline__ unsigned cvt_pk_bf16(float lo, float hi) { unsigned r; asm volatile("v_cvt_pk_bf16_f32 %0, %1, %2" : "=v"(r) : "v"(lo), "v"(hi)); return r; }

struct EpiBf16 {
    static constexpr bool PERM = true, AFTER_DRAIN = false;
    bf16_t* O; int ldc;
    __device__ __forceinline__ void operator()(const f32x4 (&acc)[2][2][4][2], const Unit& u, int wr, int wc, int fr, int fq) const {
        const int row0 = u.pm * BM + wr * 64 + fr, col0 = u.pn * BM + wc * 32 + 8 * fq;
#pragma unroll
        for (int ai = 0; ai < 2; ++ai)
#pragma unroll
            for (int m = 0; m < 4; ++m) { bf16_t* rowp = O + (size_t)(row0 + ai * HALF + m * 16) * ldc + col0;
#pragma unroll
                for (int bj = 0; bj < 2; ++bj) { const f32x4 v0 = acc[ai][bj][m][0], v1 = acc[ai][bj][m][1];
                    u32x4 w; w.x = cvt_pk_bf16(v0[0], v0[1]); w.y = cvt_pk_bf16(v0[2], v0[3]); w.z = cvt_pk_bf16(v1[0], v1[1]); w.w = cvt_pk_bf16(v1[2], v1[3]);
                    *(u32x4*)(rowp + bj * HALF) = w;
#ifdef DBL_EPI
                    asm volatile("" ::: "memory"); *(u32x4*)(rowp + bj * HALF) = w;
#endif
                    } }
    }
};
struct EpiResid {
    static constexpr bool PERM = false, AFTER_DRAIN = false;
    const float* Xi; float* Xo; const float* g; int ldc;
    __device__ __forceinline__ void operator()(const f32x4 (&acc)[2][2][4][2], const Unit& u, int wr, int wc, int fr, int fq) const {
        const int row0 = u.pm * BM + wr * 64 + fr, col0 = u.pn * BM + wc * 32 + 4 * fq;
        f32x4 gv[2][2];
#pragma unroll
        for (int bj = 0; bj < 2; ++bj)
#pragma unroll
            for (int n = 0; n < 2; ++n) gv[bj][n] = *(const f32x4*)(g + col0 + bj * HALF + 16 * n);
#pragma unroll
        for (int ai = 0; ai < 2; ++ai)
#pragma unroll
            for (int m = 0; m < 4; ++m) { const size_t ro = (size_t)(row0 + ai * HALF + m * 16) * ldc + col0;
#pragma unroll
                for (int bj = 0; bj < 2; ++bj)
#pragma unroll
                    for (int n = 0; n < 2; ++n) { const size_t o = ro + bj * HALF + 16 * n; const f32x4 xi = *(const f32x4*)(Xi + o);
                        *(f32x4*)(Xo + o) = xi + gv[bj][n] * acc[ai][bj][m][n]; } }
    }
};
struct EpiLogits {
    static constexpr bool PERM = false, AFTER_DRAIN = false;
    float* Lg;
    __device__ __forceinline__ void operator()(const f32x4 (&acc)[2][2][4][2], const Unit& u, int wr, int wc, int fr, int fq) const {
        const int row0 = u.pn * 16384 + u.pm * BM + wr * 64 + fr, col0 = wc * 32 + 4 * fq;
#pragma unroll
        for (int ai = 0; ai < 2; ++ai)
#pragma unroll
            for (int m = 0; m < 4; ++m)
#pragma unroll
                for (int n = 0; n < 2; ++n) *(f32x4*)(Lg + (size_t)(row0 + ai * HALF + m * 16) * 128 + col0 + 16 * n) = acc[ai][0][m][n];
    }
};
struct EpiGateUp {
    static constexpr bool PERM = true, AFTER_DRAIN = false;
    bf16_t* O; int ldc;
    __device__ __forceinline__ void operator()(const f32x4 (&acc)[2][2][4][2], const Unit& u, int wr, int wc, int fr, int fq) const {
        const int row0 = u.pm * BM + wr * 64 + fr, col0 = u.pn * HALF + wc * 32 + 8 * fq;
#pragma unroll
        for (int ai = 0; ai < 2; ++ai)
#pragma unroll
            for (int m = 0; m < 4; ++m) { float a[8];
#pragma unroll
                for (int n = 0; n < 2; ++n)
#pragma unroll
                    for (int i = 0; i < 4; ++i) { const float gt = acc[ai][0][m][n][i], up = acc[ai][1][m][n][i];
                        a[n * 4 + i] = gt * __builtin_amdgcn_rcpf(1.f + __builtin_amdgcn_exp2f(-1.4426950408889634f * gt)) * up; }
                u32x4 w; w.x = cvt_pk_bf16(a[0], a[1]); w.y = cvt_pk_bf16(a[2], a[3]); w.z = cvt_pk_bf16(a[4], a[5]); w.w = cvt_pk_bf16(a[6], a[7]);
                *(u32x4*)(O + (size_t)(row0 + ai * HALF + m * 16) * ldc + col0) = w; }
    }
};

template <class Epi, class Sched, bool ALIGN_EPI = false, bool SP2 = false, bool GATHER = false, int BAUX = 0>
__device__ __forceinline__ void gemm_phase(PG8_LAS unsigned char* lds, const Gemm g, const Sched& S, const Epi& E) {
    int tid = threadIdx.x; asm volatile("" : "+v"(tid));
    const int wid = __builtin_amdgcn_readfirstlane(tid >> 6), lane = tid & 63, wr = wid >> 2, wc = wid & 3, fr = lane & 15, fq = lane >> 4;
    static_assert(!GATHER || SP2, "gathered A rows: SP2 loop only");
    const int K = g.K, nt = g.KL / BK;
    unsigned voffA[2], voffB[2], gC2[2]; int gR[2];
#pragma unroll
    for (int i = 0; i < 2; ++i) { int R, C; stage_rc(tid * 16 + i * 8192, R, C); const int Rb = Epi::PERM ? ((R & ~31) + perm32(R & 31)) : R;
        voffA[i] = (unsigned)(R * K + C) * 2u; voffB[i] = (unsigned)(Rb * K + C) * 2u; gR[i] = R; gC2[i] = (unsigned)C * 2u; }
    unsigned vC[2][2], vN[2][2];
    const size_t kstep = (size_t)(BK * 2);
    const size_t hstep = (size_t)HALF * K * 2;
    const size_t tstep = 2 * hstep;
    const unsigned ldsw = (unsigned)wid * 1024u;
    const int aoff = lds_byte(wr * 64 + fr, fq * 8), boff = lds_byte(wc * 32 + fr, fq * 8);
#define PG8_SA(b, h) (((b) * 2 + (h)) * HTB)
#define PG8_SB(b, h) ((4 + (b) * 2 + (h)) * HTB)
#define PG8_STAGE(bufoff, gbase, voff) do { _Pragma("unroll") for (int _i = 0; _i < 2; ++_i) \
        __builtin_amdgcn_global_load_lds((const unsigned*)((const char*)(gbase) + (voff)[_i]), (PG8_LAS unsigned*)(lds + (bufoff) + ldsw + _i * 8192), 16, 0, 0); } while (0)
#define PG8_STAGE_A(bufoff, ptr, h, VS) do { if constexpr (GATHER) { PG8_STAGE(bufoff, ptr, VS[h]); } else { PG8_STAGE(bufoff, (ptr) + ((h) ? hstep : 0), voffA); } } while (0)
#define PG8_STAGE_B(bufoff, gbase, voff) do { _Pragma("unroll") for (int _i = 0; _i < 2; ++_i) \
        __builtin_amdgcn_global_load_lds((const unsigned*)((const char*)(gbase) + (voff)[_i]), (PG8_LAS unsigned*)(lds + (bufoff) + ldsw + _i * 8192), 16, 0, BAUX); } while (0)
#define PG8_LDA(dst, b, h) do { _Pragma("unroll") for (int m = 0; m < 4; ++m) _Pragma("unroll") for (int k = 0; k < 2; ++k) dst[m][k] = *(const PG8_LAS bf16x8*)(lds + PG8_SA(b, h) + aoff + m * 2048 + k * 1024); } while (0)
#define PG8_LDB(dst, b, h) do { _Pragma("unroll") for (int n = 0; n < 2; ++n) _Pragma("unroll") for (int k = 0; k < 2; ++k) dst[n][k] = *(const PG8_LAS bf16x8*)(lds + PG8_SB(b, h) + boff + n * 2048 + k * 1024); } while (0)
#define PG8_MMA(ai, bj, At, Bt) do { __builtin_amdgcn_s_setprio(1); _Pragma("unroll") for (int m = 0; m < 4; ++m) _Pragma("unroll") for (int n = 0; n < 2; ++n) _Pragma("unroll") for (int k = 0; k < 2; ++k) \
        acc[ai][bj][m][n] = __builtin_amdgcn_mfma_f32_16x16x32_bf16(Bt[n][k], At[m][k], acc[ai][bj][m][n], 0, 0, 0); __builtin_amdgcn_s_setprio(0); } while (0)
#define PG8_WAIT_V(n) asm volatile("s_waitcnt vmcnt(" #n ")" ::: "memory")
#define PG8_WAIT_L(n) asm volatile("s_waitcnt lgkmcnt(" #n ")" ::: "memory")
#define PG8_BAR __builtin_amdgcn_s_barrier()
#define PG8_SCHED __builtin_amdgcn_sched_barrier(0)
    Unit cur, nxt; int ui = 0;
    if (!S.next(0, cur)) return;
    f32x4 acc[2][2][4][2];
#pragma unroll
    for (int a = 0; a < 2; ++a)
#pragma unroll
        for (int b = 0; b < 2; ++b)
#pragma unroll
            for (int m = 0; m < 4; ++m)
#pragma unroll
                for (int n = 0; n < 2; ++n) acc[a][b][m][n] = (f32x4){0.f, 0.f, 0.f, 0.f};
    bf16x8 At[4][2], B0[2][2], B1[2][2];
    const char* cA = (const char*)g.A + cur.ao; const char* cB = (const char*)g.Bt + cur.bo;
    if constexpr (GATHER) {
#pragma unroll
        for (int h = 0; h < 2; ++h)
#pragma unroll
            for (int i = 0; i < 2; ++i) { vC[h][i] = (unsigned)S.tok(0, gR[i] + HALF * h) * (unsigned)g.lda + gC2[i]; vN[h][i] = vC[h][i]; } }
    S.a_ready(cur);
    if constexpr (SP2) {
        PG8_STAGE_B(PG8_SB(0, 0), cB, voffB); PG8_STAGE_B(PG8_SB(0, 1), cB + hstep, voffB); PG8_STAGE_A(PG8_SA(0, 0), cA, 0, vC); PG8_STAGE_A(PG8_SA(0, 1), cA, 1, vC);
        if (wr == 1) PG8_BAR;
        PG8_WAIT_V(2); PG8_BAR;
        PG8_STAGE_B(PG8_SB(1, 0), cB + kstep, voffB); PG8_STAGE_A(PG8_SA(1, 0), cA + kstep, 0, vC); PG8_STAGE_B(PG8_SB(1, 1), cB + hstep + kstep, voffB);
        PG8_WAIT_V(6); PG8_BAR;
    } else {
        PG8_STAGE_B(PG8_SB(0, 0), cB, voffB); PG8_STAGE(PG8_SA(0, 0), cA, voffA); PG8_STAGE_B(PG8_SB(0, 1), cB + hstep, voffB); PG8_STAGE(PG8_SA(0, 1), cA + hstep, voffA);
        if (wr == 1) PG8_BAR;
        PG8_WAIT_V(4); PG8_BAR;
        PG8_STAGE_B(PG8_SB(1, 0), cB + kstep, voffB); PG8_STAGE(PG8_SA(1, 0), cA + kstep, voffA); PG8_STAGE_B(PG8_SB(1, 1), cB + hstep + kstep, voffB);
        PG8_WAIT_V(6); PG8_BAR;
    }
    for (;;) {
        const bool has_next = S.next(ui + 1, nxt);
        const char* nA = has_next ? (const char*)g.A + nxt.ao : cA; const char* nB = has_next ? (const char*)g.Bt + nxt.bo : cB;
        if constexpr (GATHER) { if (has_next) {
#pragma unroll
            for (int h = 0; h < 2; ++h)
#pragma unroll
                for (int i = 0; i < 2; ++i) vN[h][i] = (unsigned)S.tok(ui + 1, gR[i] + HALF * h) * (unsigned)g.lda + gC2[i]; } }
        for (int t = 0; t < nt; t += 2) {
            const bool last = (t == nt - 2);
            const char* a1 = cA + (size_t)(t + 1) * kstep;
            const char* a2 = last ? nA : cA + (size_t)(t + 2) * kstep; const char* b2 = last ? nB : cB + (size_t)(t + 2) * kstep;
            const char* a3 = a2 + kstep; const char* b3 = b2 + kstep;
            if (last && has_next) S.a_ready(nxt);
            unsigned v2[2][2];
            if constexpr (GATHER) { const bool un = last && has_next;
#pragma unroll
                for (int h = 0; h < 2; ++h)
#pragma unroll
                    for (int i = 0; i < 2; ++i) v2[h][i] = un ? vN[h][i] : vC[h][i]; }
            if constexpr (SP2) {
            PG8_LDB(B0, 0, 0); PG8_LDB(B1, 0, 1); PG8_SCHED; PG8_LDA(At, 0, 0); PG8_STAGE_A(PG8_SA(1, 1), a1, 1, vC);
            PG8_WAIT_V(8); PG8_WAIT_L(0); PG8_BAR; PG8_MMA(0, 0, At, B0); PG8_MMA(0, 1, At, B1); PG8_BAR; PG8_SCHED;
            PG8_LDA(At, 0, 1); PG8_STAGE_B(PG8_SB(0, 0), b2, voffB); PG8_STAGE_B(PG8_SB(0, 1), b2 + hstep, voffB); PG8_STAGE_A(PG8_SA(0, 0), a2, 0, v2);
            PG8_WAIT_V(8); PG8_WAIT_L(0); PG8_BAR; PG8_MMA(1, 0, At, B0); PG8_MMA(1, 1, At, B1); PG8_BAR; PG8_SCHED;
            PG8_LDB(B0, 1, 0); PG8_LDB(B1, 1, 1); PG8_SCHED; PG8_LDA(At, 1, 0); PG8_STAGE_A(PG8_SA(0, 1), a2, 1, v2);
            PG8_WAIT_V(8); PG8_WAIT_L(0); PG8_BAR; PG8_MMA(0, 0, At, B0); PG8_MMA(0, 1, At, B1); PG8_BAR; PG8_SCHED;
            PG8_LDA(At, 1, 1); PG8_STAGE_B(PG8_SB(1, 0), b3, voffB); PG8_STAGE_B(PG8_SB(1, 1), b3 + hstep, voffB); PG8_STAGE_A(PG8_SA(1, 0), a3, 0, v2);
            PG8_WAIT_V(8); PG8_WAIT_L(0); PG8_BAR; PG8_MMA(1, 0, At, B0); PG8_MMA(1, 1, At, B1); PG8_BAR; PG8_SCHED;
            } else {
            PG8_LDB(B0, 0, 0); PG8_SCHED; PG8_LDA(At, 0, 0); PG8_STAGE(PG8_SA(1, 1), a1 + hstep, voffA);
            PG8_WAIT_L(8); PG8_BAR; PG8_WAIT_L(0); PG8_MMA(0, 0, At, B0); PG8_BAR; PG8_SCHED;
            PG8_LDB(B1, 0, 1); PG8_STAGE_B(PG8_SB(0, 0), b2, voffB);
            PG8_BAR; PG8_WAIT_L(0); PG8_MMA(0, 1, At, B1); PG8_BAR;
            PG8_LDA(At, 0, 1); PG8_STAGE(PG8_SA(0, 0), a2, voffA);
            PG8_BAR; PG8_WAIT_L(0); PG8_MMA(1, 0, At, B0); PG8_BAR; PG8_SCHED;
            PG8_STAGE_B(PG8_SB(0, 1), b2 + hstep, voffB);
            PG8_WAIT_V(6); PG8_BAR; PG8_MMA(1, 1, At, B1); PG8_BAR;
            PG8_LDB(B0, 1, 0); PG8_SCHED; PG8_LDA(At, 1, 0); PG8_STAGE(PG8_SA(0, 1), a2 + hstep, voffA);
            PG8_WAIT_L(8); PG8_BAR; PG8_WAIT_L(0); PG8_MMA(0, 0, At, B0); PG8_BAR; PG8_SCHED;
            PG8_LDB(B1, 1, 1); PG8_STAGE_B(PG8_SB(1, 0), b3, voffB);
            PG8_BAR; PG8_WAIT_L(0); PG8_MMA(0, 1, At, B1); PG8_BAR;
            PG8_LDA(At, 1, 1); PG8_STAGE(PG8_SA(1, 0), a3, voffA);
            PG8_BAR; PG8_WAIT_L(0); PG8_MMA(1, 0, At, B0); PG8_BAR; PG8_SCHED;
            PG8_STAGE_B(PG8_SB(1, 1), b3 + hstep, voffB);
            PG8_WAIT_V(6); PG8_BAR; PG8_MMA(1, 1, At, B1); PG8_BAR;
            }
        }
        if constexpr (ALIGN_EPI) { if (wr == 0) PG8_BAR; }
        if constexpr (!Epi::AFTER_DRAIN) { E(acc, cur, wr, wc, fr, fq); S.done(cur); }
        if (!has_next) break;
#pragma unroll
        for (int a = 0; a < 2; ++a)
#pragma unroll
            for (int b = 0; b < 2; ++b)
#pragma unroll
                for (int m = 0; m < 4; ++m)
#pragma unroll
                    for (int n = 0; n < 2; ++n) acc[a][b][m][n] = (f32x4){0.f, 0.f, 0.f, 0.f};
        cur = nxt; cA = nA; cB = nB; ++ui;
        if constexpr (GATHER) {
#pragma unroll
            for (int h = 0; h < 2; ++h)
#pragma unroll
                for (int i = 0; i < 2; ++i) vC[h][i] = vN[h][i]; }
        if constexpr (ALIGN_EPI) { if (wr == 1) PG8_BAR; }
    }
    PG8_WAIT_V(0);
    if constexpr (!ALIGN_EPI) { if (wr == 0) PG8_BAR; }
    PG8_BAR;
    if constexpr (Epi::AFTER_DRAIN) { E.fused(acc, cur, wr, wc, fr, fq, lds, wid, lane); S.done(cur); }
#undef PG8_SA
#undef PG8_SB
#undef PG8_STAGE
#undef PG8_STAGE_B
#undef PG8_STAGE_A
#undef PG8_LDA
#undef PG8_LDB
#undef PG8_MMA
#undef PG8_WAIT_V
#undef PG8_WAIT_L
#undef PG8_BAR
#undef PG8_SCHED
}
}

namespace fa {
constexpr int D = 128, QBLK = 32, KVBLK = 64, QB = 256;
constexpr float SCALE = 0.08838834764831845f;
constexpr float THR = 8.f;
constexpr int SHM_K = KVBLK * D * 2, SHM_V = KVBLK * D * 2;
constexpr int OFF_V = 0, OFF_K = SHM_V, OFF_B = SHM_V + SHM_K, ATT_BUF = OFF_B + 256  , OFF_W = 2 * ATT_BUF, ATT_LDS = OFF_W + 8 * 64 * 4;
#define KSWZ(row, colB) ((row) * 256 + ((colB) ^ (((row) & 7) << 4)))
#define SBAR() __builtin_amdgcn_sched_barrier(0)
__device__ __forceinline__ int v_st(int k, int c) { const int kk = (k & ~0xC) | ((k & 4) << 1) | ((k & 8) >> 1); return ((kk >> 3) * 4 + (c >> 5)) * 512 + ((kk & 7) * 32 + (c & 31)) * 2; }
__device__ __forceinline__ int v_rd_base(int lane) { return ((lane & 3) << 3) | (((lane >> 2) & 3) << 6) | (((lane >> 4) & 1) << 5) | (((lane >> 5) & 1) << 8); }
constexpr int v_rd_off(int d0, int ks, int half) { return d0 * 512 + ks * 4096 + half * 2048; }
__device__ __forceinline__ int crow(int r, int hi) { return (r & 3) + 8 * (r >> 2) + 4 * hi; }
__device__ __forceinline__ unsigned cvtpk(float lo, float hi) { unsigned r; asm volatile("v_cvt_pk_bf16_f32 %0, %1, %2" : "=v"(r) : "v"(lo), "v"(hi)); return r; }
__device__ __forceinline__ void mask_tile(f32x16& p0, f32x16& p1, int dq) {
    const float NEG = -__builtin_inff();
#pragma unroll
    for (int r = 0; r < 16; ++r) {
        const int c = (r & 3) + 8 * (r >> 2);
        if (dq - c < 0) p0[r] = NEG;
        if (dq - c - 32 < 0) p1[r] = NEG;
    }
}
__device__ __forceinline__ void partialSM(f32x16& p0, f32x16& p1, float& m_reg, float& mn, float& alpha) {
    float pmax = p0[0];
#pragma unroll
    for (int r = 1; r < 16; ++r) pmax = fmaxf(pmax, p0[r]);
#pragma unroll
    for (int r = 0; r < 16; ++r) pmax = fmaxf(pmax, p1[r]);
    { auto rr = __builtin_amdgcn_permlane32_swap(__float_as_uint(pmax), __float_as_uint(pmax), false, false);
      pmax = fmaxf(__uint_as_float(rr[0]), __uint_as_float(rr[1])); }
    constexpr float C2 = 1.4426950408889634f * SCALE;
    if (__builtin_expect(__all((pmax - m_reg) * SCALE <= THR), 1)) { mn = m_reg; alpha = 1.f; }
    else { mn = fmaxf(m_reg, pmax); alpha = __builtin_amdgcn_exp2f((m_reg - mn) * C2); m_reg = mn; }
    const float mnL = -mn * C2;
#pragma unroll
    for (int r = 0; r < 16; ++r) p0[r] = fmaf(p0[r], C2, mnL);
#pragma unroll
    for (int r = 0; r < 16; ++r) p1[r] = fmaf(p1[r], C2, mnL);
#pragma unroll
    for (int r = 0; r < 16; ++r) p0[r] = __builtin_amdgcn_exp2f(p0[r]);
}
__device__ __forceinline__ void finishSM(f32x16& p0, f32x16& p1, float alpha, float& l_reg, bf16x8& pa0, bf16x8& pa1, bf16x8& pa2, bf16x8& pa3) {
#pragma unroll
    for (int r = 0; r < 16; ++r) p1[r] = __builtin_amdgcn_exp2f(p1[r]);
    float ps = 0;
#pragma unroll
    for (int r = 0; r < 16; ++r) ps += p0[r];
#pragma unroll
    for (int r = 0; r < 16; ++r) ps += p1[r];
    { auto rr = __builtin_amdgcn_permlane32_swap(__float_as_uint(ps), __float_as_uint(ps), false, false);
      ps = __uint_as_float(rr[0]) + __uint_as_float(rr[1]); }
    l_reg = l_reg * alpha + ps;
#define PK4(P, B_, OUT) do { unsigned a0 = cvtpk(P[B_+0], P[B_+1]), a1 = cvtpk(P[B_+2], P[B_+3]);                          \
        unsigned b0 = cvtpk(P[B_+4], P[B_+5]), b1 = cvtpk(P[B_+6], P[B_+7]);                                             \
        auto r0 = __builtin_amdgcn_permlane32_swap(a0, b0, false, false); auto r1 = __builtin_amdgcn_permlane32_swap(a1, b1, false, false); \
        v4u w = {r0[0], r1[0], r0[1], r1[1]}; OUT = *reinterpret_cast<bf16x8*>(&w); } while (0)
    PK4(p0, 0, pa0); PK4(p0, 8, pa1); PK4(p1, 0, pa2); PK4(p1, 8, pa3);
#undef PK4
}
__device__ __forceinline__ void qkt(f32x16& p0, f32x16& p1, const char* K_lds, const float* b_lds, int r32, int hi, const bf16x8* qr) {
#pragma unroll
    for (int g = 0; g < 4; ++g) { const f32x4 a = *(const f32x4*)(b_lds + 8 * g + 4 * hi), b = *(const f32x4*)(b_lds + 32 + 8 * g + 4 * hi);
#pragma unroll
        for (int i = 0; i < 4; ++i) { p0[4 * g + i] = a[i]; p1[4 * g + i] = b[i]; } }
    const char* kb[4];
#pragma unroll
    for (int dd = 0; dd < 4; ++dd) kb[dd] = K_lds + KSWZ(r32, (dd * 16 + hi * 8) * 2);
#pragma unroll
    for (int d0 = 0; d0 < 8; ++d0) { const char* a = kb[d0 & 3] + (d0 >> 2) * 128;
        bf16x8 b0 = *reinterpret_cast<const bf16x8*>(a);
        bf16x8 b1 = *reinterpret_cast<const bf16x8*>(a + 32 * 256);
        p0 = __builtin_amdgcn_mfma_f32_32x32x16_bf16(b0, qr[d0], p0, 0, 0, 0);
        p1 = __builtin_amdgcn_mfma_f32_32x32x16_bf16(b1, qr[d0], p1, 0, 0, 0); }
}
__device__ __forceinline__ void pv_tile(f32x16* o, int vb0, bf16x8 pa0, bf16x8 pa1, bf16x8 pa2, bf16x8 pa3) {
#define TRRD(dst, off) asm volatile("ds_read_b64_tr_b16 %0, %1 offset:%2" : "=&v"(dst) : "v"(vb0), "i"(off) : "memory")
#define PV_D0(d0) do { s16x4 l0, l1, l2, l3, h0, h1, h2, h3; constexpr int b_ = v_rd_off(d0, 0, 0);   \
        TRRD(l0, b_); TRRD(h0, b_ + 2048); TRRD(l1, b_ + 4096); TRRD(h1, b_ + 6144); TRRD(l2, b_ + 8192); TRRD(h2, b_ + 10240); TRRD(l3, b_ + 12288); TRRD(h3, b_ + 14336); \
        asm volatile("s_waitcnt lgkmcnt(0)" ::: "memory"); SBAR();                                                       \
        o[d0] = __builtin_amdgcn_mfma_f32_32x32x16_bf16(pa0, (bf16x8){l0[0], l0[1], l0[2], l0[3], h0[0], h0[1], h0[2], h0[3]}, o[d0], 0, 0, 0);   \
        o[d0] = __builtin_amdgcn_mfma_f32_32x32x16_bf16(pa1, (bf16x8){l1[0], l1[1], l1[2], l1[3], h1[0], h1[1], h1[2], h1[3]}, o[d0], 0, 0, 0);   \
        o[d0] = __builtin_amdgcn_mfma_f32_32x32x16_bf16(pa2, (bf16x8){l2[0], l2[1], l2[2], l2[3], h2[0], h2[1], h2[2], h2[3]}, o[d0], 0, 0, 0);   \
        o[d0] = __builtin_amdgcn_mfma_f32_32x32x16_bf16(pa3, (bf16x8){l3[0], l3[1], l3[2], l3[3], h3[0], h3[1], h3[2], h3[3]}, o[d0], 0, 0, 0); } while (0)
    PV_D0(0); PV_D0(1); PV_D0(2); PV_D0(3);
#undef PV_D0
#undef TRRD
}
}

namespace fa2 {
using namespace fa;
constexpr int PIN = NPJ, POUT = 2048, NW = 8;
constexpr int O2_V = 0, O2_K = 2 * SHM_V, O2_W = 2 * SHM_V + 2 * SHM_K, O2_B = O2_W + NW * 64 * 4, O2_Q = O2_B + 2 * 64 * 4, ATT2_LDS = O2_Q + NW * 8192;
__device__ __forceinline__ void mask_causal(f32x16& p0, f32x16& p1, int dq) {
    const float NEG = -__builtin_inff();
#pragma unroll
    for (int r = 0; r < 16; ++r) { const int c = (r & 3) + 8 * (r >> 2); if (dq - c < 0) p0[r] = NEG; if (dq - c - 32 < 0) p1[r] = NEG; }
}
template <int KB>
__device__ __forceinline__ void qkt(f32x16& p0, f32x16& p1, const char* K_lds, const float* b_lds, int r32, int hi, const char* qf) {
    { const float* bb = b_lds + KB * 64;
#pragma unroll
      for (int g = 0; g < 4; ++g) { const f32x4 a = *(const f32x4*)(bb + 8 * g + 4 * hi), b = *(const f32x4*)(bb + 32 + 8 * g + 4 * hi);
#pragma unroll
          for (int i = 0; i < 4; ++i) { p0[4 * g + i] = a[i]; p1[4 * g + i] = b[i]; } } }
    const char* kb[4];
#pragma unroll
    for (int dd = 0; dd < 4; ++dd) kb[dd] = K_lds + KB * SHM_K + KSWZ(r32, (dd * 16 + hi * 8) * 2);
#pragma unroll
    for (int d0 = 0; d0 < 8; ++d0) { const char* a = kb[d0 & 3] + (d0 >> 2) * 128;
        bf16x8 b0 = *reinterpret_cast<const bf16x8*>(a);
        bf16x8 b1 = *reinterpret_cast<const bf16x8*>(a + 32 * 256);
        const bf16x8 q = *reinterpret_cast<const bf16x8*>(qf + d0 * 1024);
        p0 = __builtin_amdgcn_mfma_f32_32x32x16_bf16(b0, q, p0, 0, 0, 0);
        p1 = __builtin_amdgcn_mfma_f32_32x32x16_bf16(b1, q, p1, 0, 0, 0); }
}
template <int VB>
__device__ __forceinline__ void pv_tile(f32x16* o, int vb0, bf16x8 pa0, bf16x8 pa1, bf16x8 pa2, bf16x8 pa3) {
#define TRRD(dst, off) asm volatile("ds_read_b64_tr_b16 %0, %1 offset:%2" : "=&v"(dst) : "v"(vb0), "i"(off) : "memory")
#define PV_D0(d0) do { s16x4 l0, l1, l2, l3, h0, h1, h2, h3; constexpr int b_ = VB * SHM_V + v_rd_off(d0, 0, 0);   \
        TRRD(l0, b_); TRRD(h0, b_ + 2048); TRRD(l1, b_ + 4096); TRRD(h1, b_ + 6144); TRRD(l2, b_ + 8192); TRRD(h2, b_ + 10240); TRRD(l3, b_ + 12288); TRRD(h3, b_ + 14336); \
        asm volatile("s_waitcnt lgkmcnt(0)" ::: "memory"); SBAR();                                                       \
        o[d0] = __builtin_amdgcn_mfma_f32_32x32x16_bf16(pa0, (bf16x8){l0[0], l0[1], l0[2], l0[3], h0[0], h0[1], h0[2], h0[3]}, o[d0], 0, 0, 0);   \
        o[d0] = __builtin_amdgcn_mfma_f32_32x32x16_bf16(pa1, (bf16x8){l1[0], l1[1], l1[2], l1[3], h1[0], h1[1], h1[2], h1[3]}, o[d0], 0, 0, 0);   \
        o[d0] = __builtin_amdgcn_mfma_f32_32x32x16_bf16(pa2, (bf16x8){l2[0], l2[1], l2[2], l2[3], h2[0], h2[1], h2[2], h2[3]}, o[d0], 0, 0, 0);   \
        o[d0] = __builtin_amdgcn_mfma_f32_32x32x16_bf16(pa3, (bf16x8){l3[0], l3[1], l3[2], l3[3], h3[0], h3[1], h3[2], h3[3]}, o[d0], 0, 0, 0); } while (0)
    PV_D0(0); PV_D0(1); PV_D0(2); PV_D0(3);
#undef PV_D0
#undef TRRD
}
struct BlockRef { const bf16* Q; const bf16* K; const bf16* V; bf16* O; const float* C; int P0, jlo; float cf; };
struct Seam { bf16x8 st_v0, st_v1, st_k0, st_k1; float st_b; };
#define A2_LD(p, k0, off32) (*(const bf16x8*)((const char*)(p) + (size_t)(k0) * (PIN * 2) + (off32)))
#define A2_VMW() asm volatile("s_waitcnt vmcnt(0)" ::: "memory")
#define A2_VMWN(n) asm volatile("s_waitcnt vmcnt(%0)" :: "i"(n) : "memory")
#define A2_SLOAD(R_, k0) do { S.st_v0 = A2_LD((R_).V, k0, go0); S.st_v1 = A2_LD((R_).V, k0, go1);              \
                              S.st_k0 = A2_LD((R_).K, k0, go0); S.st_k1 = A2_LD((R_).K, k0, go1); \
                              if (tid < 64) S.st_b = ((R_).cf - (R_).C[(k0) + tid]) * (1.0f / SCALE); } while (0)
#define A2_SWRITE_K(bf) do { *(bf16x8*)(K_lds + (bf) * SHM_K + kws) = S.st_k0; *(bf16x8*)(K_lds + (bf) * SHM_K + kws + 32 * 256) = S.st_k1; if (tid < 64) b_lds[(bf) * 64 + tid] = S.st_b; } while (0)
#define A2_SWRITE_V(bf) do { *(bf16x8*)(V_lds + (bf) * SHM_V + vst0) = S.st_v0; *(bf16x8*)(V_lds + (bf) * SHM_V + vst1) = S.st_v1; } while (0)
#define A2_SWRITE(bf) do { A2_SWRITE_V(bf); A2_SWRITE_K(bf); } while (0)
__device__ __forceinline__ void prime(const BlockRef& cur, char* lds, Seam& S, int tid) {
    const int wid = __builtin_amdgcn_readfirstlane(tid >> 6), lane = tid & 63, r32 = lane & 31, hi = lane >> 5;
    const int sr = tid >> 4, sc = (tid & 15) * 8, kws = KSWZ(sr, sc * 2); char* K_lds = lds + O2_K; float* b_lds = (float*)(lds + O2_B);
    const unsigned go0 = (unsigned)(sr * PIN + sc) * 2u, go1 = go0 + 32u * PIN * 2u, qo = (unsigned)(r32 * PIN + hi * 8) * 2u;
    const int kb0 = cur.jlo * KVBLK;
    { bf16x8 qr[8]; char* qf = lds + O2_Q + wid * 8192 + lane * 16;
#pragma unroll
      for (int d0 = 0; d0 < 8; ++d0) qr[d0] = *(const bf16x8*)((const char*)cur.Q + (size_t)(wid * QBLK) * (PIN * 2) + qo + d0 * 32);
      A2_SLOAD(cur, kb0); A2_VMW(); A2_SWRITE_K(0);
#pragma unroll
      for (int d0 = 0; d0 < 8; ++d0) *(bf16x8*)(qf + d0 * 1024) = qr[d0]; }
    __syncthreads();
}
__device__ __forceinline__ void block(const BlockRef& cur, char* lds, Seam& S, int tid) {
    const int wid = __builtin_amdgcn_readfirstlane(tid >> 6), lane = tid & 63, r32 = lane & 31, hi = lane >> 5;
    const int j_lo = cur.jlo, j_hi = (cur.P0 + QB - 1) / KVBLK + 1;
    const int NT = j_hi - j_lo;
    const int qlo = cur.P0 + wid * QBLK, qm = qlo + r32 - 4 * hi;
    char* V_lds = lds + O2_V; char* K_lds = lds + O2_K; float* b_lds = (float*)(lds + O2_B);
    float* ws = (float*)(lds + O2_W) + wid * 64; float* li_l = ws, * al_l = ws + 32;
    float m_reg = -1e30f, l_reg = 0; f32x16 o[4] = {};
    const int sr = tid >> 4, sc = (tid & 15) * 8, vst0 = v_st(sr, sc), vst1 = v_st(32 + sr, sc), kws = KSWZ(sr, sc * 2);
    const int vb0 = (int)(uintptr_t)V_lds + v_rd_base(lane);
    const unsigned go0 = (unsigned)(sr * PIN + sc) * 2u, go1 = go0 + 32u * PIN * 2u;
    const char* qf = lds + O2_Q + wid * 8192 + lane * 16;
#define RESC(a) do { if (__any((a) < 1.f)) { if (hi == 0) al_l[r32] = (a); asm volatile("s_waitcnt lgkmcnt(0)" ::: "memory");              \
                     for (int d_ = 0; d_ < 4; ++d_) for (int r = 0; r < 16; ++r) o[d_][r] *= al_l[crow(r, hi)]; } } while (0)
#define KBASE(t) ((j_lo + (t)) * KVBLK)
#define MASKT(P0_, P1_, t) do { const int kb_ = KBASE(t); if (kb_ + KVBLK - 1 > qlo) mask_causal(P0_, P1_, qm - kb_); } while (0)
    f32x16 pA0, pA1, pB0, pB1; float mnA, mnB, alA, alB; bf16x8 pa0, pa1, pa2, pa3;
    A2_SWRITE_V(0); SBAR();
    if (NT > 1) A2_SLOAD(cur, KBASE(1));
    SBAR(); qkt<0>(pA0, pA1, K_lds, b_lds, r32, hi, qf);
    MASKT(pA0, pA1, 0); partialSM(pA0, pA1, m_reg, mnA, alA);
    if (NT > 1) { A2_VMW(); A2_SWRITE(1); }
    __syncthreads();
#define HALF_STEP(PX0, PX1, mnX, alX, PY0, PY1, alY, t, KB, VB, SB) do {                                                      \
        SBAR(); qkt<KB>(PX0, PX1, K_lds, b_lds, r32, hi, qf);                                                               \
        finishSM(PY0, PY1, alY, l_reg, pa0, pa1, pa2, pa3); SBAR();                                                           \
        if ((t) + 1 < NT) { A2_SLOAD(cur, KBASE((t) + 1)); SBAR(); }                                                          \
        pv_tile<VB>(o, vb0, pa0, pa1, pa2, pa3); MASKT(PX0, PX1, (t)); partialSM(PX0, PX1, m_reg, mnX, alX);                  \
        __syncthreads();                                                                                                      \
        if ((t) + 1 < NT) { A2_VMW(); A2_SWRITE(SB); }                                                                        \
        RESC(alX); __syncthreads(); } while (0)
    for (int t = 1; t + 1 < NT; t += 2) {
        HALF_STEP(pB0, pB1, mnB, alB, pA0, pA1, alA, t, 1, 0, 0);
        HALF_STEP(pA0, pA1, mnA, alA, pB0, pB1, alB, t + 1, 0, 1, 1);
    }
    const bool even = (NT & 1) == 0;
    if (even) { SBAR(); qkt<1>(pB0, pB1, K_lds, b_lds, r32, hi, qf); SBAR(); }
    finishSM(pA0, pA1, alA, l_reg, pa0, pa1, pa2, pa3); SBAR();
    pv_tile<0>(o, vb0, pa0, pa1, pa2, pa3);
    if (even) { MASKT(pB0, pB1, NT - 1); partialSM(pB0, pB1, m_reg, mnB, alB); __syncthreads(); RESC(alB);
        finishSM(pB0, pB1, alB, l_reg, pa0, pa1, pa2, pa3); SBAR(); pv_tile<1>(o, vb0, pa0, pa1, pa2, pa3); }
    if (hi == 0) li_l[r32] = l_reg; asm volatile("s_waitcnt lgkmcnt(0)" ::: "memory");
    char* Ob = (char*)(cur.O + (size_t)(wid * QBLK) * POUT); const unsigned oo = (unsigned)(4 * hi * POUT + r32) * 2u;
#pragma unroll
    for (int r = 0; r < 16; ++r) { const float rl = __builtin_amdgcn_rcpf(li_l[crow(r, hi)]);
#pragma unroll
        for (int d0 = 0; d0 < 4; ++d0) { const float v = o[d0][r] * rl; const float vn = __shfl_xor(v, 1);
            if ((r32 & 1) == 0) *(unsigned*)(Ob + (size_t)(((r & 3) + 8 * (r >> 2)) * POUT * 2 + d0 * 64) + oo) = cvtpk(v, vn); } }
    __syncthreads();
#undef RESC
#undef KBASE
#undef MASKT
#undef HALF_STEP
}
#undef A2_LD
#undef A2_VMW
#undef A2_VMWN
#undef A2_SLOAD
#undef A2_SWRITE_K
#undef A2_SWRITE_V
#undef A2_SWRITE
}

constexpr size_t MiB = 1u << 20;
constexpr size_t WS_CTL = 0, CTL_ZERO_BYTES = 1 * MiB;
constexpr size_t WS_MODP = 1 * MiB;
constexpr size_t WS_MODF = 2 * MiB;
constexpr size_t WS_LS = 3 * MiB;
constexpr size_t WS_CUM = 4 * MiB;
constexpr size_t WS_MAXQK = 5 * MiB;
constexpr size_t WS_ROUTE = 6 * MiB;
constexpr size_t WS_LOGIT = 1298 * MiB;
constexpr size_t WS_TOKTAB = 1330 * MiB;
constexpr size_t WS_ROT = 1932 * MiB;
constexpr size_t WS_WOUT = 18 * MiB;
constexpr size_t WS_WIN = 34 * MiB;
constexpr size_t WS_WGU = 82 * MiB;
constexpr size_t WS_WD = 594 * MiB;
constexpr size_t WS_H = 850 * MiB;
constexpr size_t WS_PROJ = 914 * MiB;
constexpr size_t WS_MIXED = 1106 * MiB;
constexpr size_t WS_X1 = 1170 * MiB;
constexpr size_t WS_ACT = 1490 * MiB;
constexpr size_t WS_YS = 1538 * MiB;
constexpr size_t WS_KVT = 1730 * MiB;
constexpr size_t WS_PREVT = 1778 * MiB;
constexpr size_t WS_H2X = 1802 * MiB;
constexpr size_t WS_RWT2 = 1930 * MiB;
constexpr size_t WS_END = 1936 * MiB;
constexpr int CW_TMO = 0, CW_CODE = 1;
constexpr int CW_BAR = 4096;
constexpr int CW_CNT = 8192;
constexpr int CW_Q = 8448;
constexpr int CW_QX = 16384 + 1024;
constexpr int RING_OFF = 0, RING_BYTES = 131072;
constexpr int SCR_WAVE = 16640;
constexpr int LDSCTL_OFF = 135168;
constexpr int LDS_TE = LDSCTL_OFF + 256;
constexpr int LDS_OFFS = LDS_TE + 1024;
constexpr int LDS_XT = LDSCTL_OFF + 2048;
constexpr int LDS_TOK = LDSCTL_OFF + 3072;
constexpr int LDS_BYTES = 147456;
constexpr int NWAVES = 8;

#define RLX_AGENT __ATOMIC_RELAXED, __HIP_MEMORY_SCOPE_AGENT
#define LDS_WAIT() asm volatile("s_waitcnt lgkmcnt(0)" ::: "memory")
#define VM_WAIT() asm volatile("s_waitcnt vmcnt(0)" ::: "memory")
__device__ __forceinline__ unsigned pk2(float lo, float hi) { unsigned r; asm volatile("v_cvt_pk_bf16_f32 %0, %1, %2" : "=v"(r) : "v"(lo), "v"(hi)); return r; }
__device__ __forceinline__ float bflo(unsigned w) { return __uint_as_float(w << 16); }
__device__ __forceinline__ float bfhi(unsigned w) { return __uint_as_float(w & 0xffff0000u); }
__device__ __forceinline__ float bf1(bf16 h) { return __uint_as_float((unsigned)h << 16); }
__device__ __forceinline__ bf16 f2bf(float f) { return (bf16)(pk2(f, 0.f) & 0xffffu); }
__device__ __forceinline__ float wave_sum(float v) {
#pragma unroll
    for (int o = 1; o < 64; o <<= 1) v += __shfl_xor(v, o);
    return v;
}
__device__ __forceinline__ float wave_max(float v) {
#pragma unroll
    for (int o = 1; o < 64; o <<= 1) v = fmaxf(v, __shfl_xor(v, o));
    return v;
}
__device__ __forceinline__ int wave_min_i(int v) {
#pragma unroll
    for (int o = 1; o < 64; o <<= 1) { const int w = __shfl_xor(v, o); v = w < v ? w : v; }
    return v;
}

#define XB_TMO      128
#define XB_XCNT(j)  (256  + 64 * (j))
#define XB_XSUB(j)  (1280 + 64 * (j))
#define XB_XGEN(j)  (2304 + 64 * (j))
#define XB_TOP      3328
#define XB_TOPGEN   3392
#define XCD_BAR_WORDS 3456
#define XB_SPIN_CAP (1u << 18)

__device__ __forceinline__ unsigned xb_ld(unsigned* p)              { return __hip_atomic_load(p, __ATOMIC_RELAXED, __HIP_MEMORY_SCOPE_AGENT); }
__device__ __forceinline__ unsigned xb_add(unsigned* p, unsigned v) { return __hip_atomic_fetch_add(p, v, __ATOMIC_RELAXED, __HIP_MEMORY_SCOPE_AGENT); }
__device__ __forceinline__ unsigned xb_xcc_id() { return (unsigned)__builtin_amdgcn_s_getreg((3 << 11) | 20) & 0xFu; }
#define XB_SPIN(cond, bar) do { unsigned _sp = 0; while (cond) { __builtin_amdgcn_s_sleep(1); \
    if ((++_sp & 255u) == 0u) { if (xb_ld(&(bar)[XB_TMO])) break; if (_sp > XB_SPIN_CAP) { atomicAdd(&(bar)[XB_TMO], 1u); break; } } } } while (0)

struct XcdBarrier {
    unsigned* bar; unsigned x;
    volatile LAS unsigned* st;
};

__device__ __forceinline__ XcdBarrier xcd_barrier_post(unsigned* bar, volatile LAS unsigned* st) {
    XcdBarrier b; b.bar = bar; b.x = xb_xcc_id(); b.st = st;
    if (threadIdx.x == 0) (void)xb_add(&bar[XB_XCNT(b.x)], 1u);
    return b;
}
__device__ __forceinline__ void xcd_barrier_complete(unsigned* bar, unsigned x, unsigned& nloc, unsigned& nx) {
    const unsigned G = gridDim.x * gridDim.y * gridDim.z;
    unsigned sum, cnt, mine, sp = 0u;
    for (;;) {
        sum = 0u; cnt = 0u; mine = 0u;
#pragma unroll
        for (unsigned j = 0; j < 16; ++j) { const unsigned c = xb_ld(&bar[XB_XCNT(j)]); sum += c; cnt += (c > 0u) ? 1u : 0u; mine = (j == x) ? c : mine; }
        if (sum == G) break;
        __builtin_amdgcn_s_sleep(1);
        if ((++sp & 255u) == 0u) { if (xb_ld(&bar[XB_TMO])) break; if (sp > XB_SPIN_CAP) { atomicAdd(&bar[XB_TMO], 1u); break; } }
    }
    nloc = mine > 0u ? mine : 1u; nx = cnt > 0u ? cnt : 1u;
}

__device__ __forceinline__ void xcd_barrier(const XcdBarrier& b) {
    asm volatile("s_waitcnt vmcnt(0)" ::: "memory");
    __syncthreads();
    if (threadIdx.x == 0) {
        unsigned* bar = b.bar;
        __builtin_amdgcn_s_waitcnt(0);
        unsigned nloc = b.st[0], nx = b.st[1];
        if (nloc == 0u) { xcd_barrier_complete(bar, b.x, nloc, nx); b.st[0] = nloc; b.st[1] = nx; }
        const unsigned old = xb_add(&bar[XB_XSUB(b.x)], 1u);
        const unsigned gen = old / nloc;
        if (old + 1u == (gen + 1u) * nloc) {
            __builtin_amdgcn_fence(__ATOMIC_RELEASE, "agent");
            asm volatile("s_waitcnt vmcnt(0)" ::: "memory");
            const unsigned og = xb_add(&bar[XB_TOP], 1u);
            const unsigned tg = og / nx;
            if (og + 1u == (tg + 1u) * nx) xb_add(&bar[XB_TOPGEN], 1u);
            else XB_SPIN(xb_ld(&bar[XB_TOPGEN]) == tg, bar);
            __builtin_amdgcn_fence(__ATOMIC_ACQUIRE, "agent");
            xb_add(&bar[XB_XGEN(b.x)], 1u);
            asm volatile("s_waitcnt vmcnt(0)" ::: "memory");
        } else {
            XB_SPIN(xb_ld(&bar[XB_XGEN(b.x)]) == gen, bar);
            __builtin_amdgcn_fence(__ATOMIC_ACQUIRE, "agent");
            asm volatile("s_waitcnt vmcnt(0)" ::: "memory");
        }
    }
    __syncthreads();
}

struct Args { const float* in[17]; float* out; unsigned char* ws; int ph_lo, ph_hi; };
enum { I_X = 0, I_C, I_ADAW, I_ADAB, I_N1G, I_N2G, I_WIN, I_CONVW, I_GNG, I_FB, I_WOUT, I_RW, I_RB, I_WG, I_WU, I_WD, I_FG };
struct Frame {
    unsigned char* lds;
    gu32* ctl;
    unsigned char* ws;
    const Args* a;
    int tid, lane, wave, vcu, G;
};
__device__ __constant__ float INV_TAB[32] = {
    1.000000000e+00f, 7.498942614e-01f, 5.623413324e-01f, 4.216965139e-01f, 3.162277639e-01f, 2.371373773e-01f, 1.778279394e-01f, 1.333521307e-01f,
    1.000000015e-01f, 7.498941571e-02f, 5.623413250e-02f, 4.216965288e-02f, 3.162277490e-02f, 2.371373773e-02f, 1.778279431e-02f, 1.333521493e-02f,
    9.999999776e-03f, 7.498941850e-03f, 5.623413250e-03f, 4.216964822e-03f, 3.162277630e-03f, 2.371373586e-03f, 1.778279431e-03f, 1.333521446e-03f,
    1.000000047e-03f, 7.498942432e-04f, 5.623413017e-04f, 4.216965172e-04f, 3.162277571e-04f, 2.371373703e-04f, 1.778279402e-04f, 1.333521504e-04f};
__device__ __forceinline__ float ret_lg2(int h) { return __log2f(1.f - __builtin_amdgcn_exp2f((float)(-5 - h))); }

template <bool VEC2>
__device__ __forceinline__ void transpose_item(const float* W, int ldw, bf16* dst, int ldd, float* scr, int lane) {
    asm volatile("" : "+v"(lane));
    if (!VEC2) {
        const int kr = lane >> 4, nc = (lane & 15) * 4;
        f32x4 v[16];
#pragma unroll
        for (int i = 0; i < 16; ++i) v[i] = *(const f32x4*)(W + (size_t)(4 * i + kr) * ldw + nc);
#pragma unroll
        for (int i = 0; i < 16; ++i) { float* s = scr + (4 * i + kr) * 65 + nc; s[0] = v[i][0]; s[1] = v[i][1]; s[2] = v[i][2]; s[3] = v[i][3]; }
    } else {
        const int kr = lane >> 5, nc = (lane & 31) * 2;
#pragma unroll
        for (int hb = 0; hb < 2; ++hb) {
            f32x2 v[16];
#pragma unroll
            for (int i = 0; i < 16; ++i) v[i] = *(const f32x2*)(W + (size_t)(32 * hb + 2 * i + kr) * ldw + nc);
#pragma unroll
            for (int i = 0; i < 16; ++i) { float* s = scr + (32 * hb + 2 * i + kr) * 65 + nc; s[0] = v[i][0]; s[1] = v[i][1]; }
        }
    }
    LDS_WAIT();
    const int c = (lane & 3) + 4 * (lane >> 5), nn = (lane >> 2) & 7;
#pragma unroll
    for (int j = 0; j < 8; ++j) { const int n = nn + 8 * j; const float* s = scr + (8 * c) * 65 + n;
        v4u o; o.x = pk2(s[0 * 65], s[1 * 65]); o.y = pk2(s[2 * 65], s[3 * 65]); o.z = pk2(s[4 * 65], s[5 * 65]); o.w = pk2(s[6 * 65], s[7 * 65]);
        *(v4u*)(dst + (size_t)n * ldd + 8 * c) = o; }
    LDS_WAIT();
}
__device__ __forceinline__ void router_item(const float* W, bf16* dst, float* scr, int lane) {
    asm volatile("" : "+v"(lane));
    const int kr = lane >> 4, nc = (lane & 15) * 4;
    f32x4 v[16];
#pragma unroll
    for (int i = 0; i < 16; ++i) v[i] = *(const f32x4*)(W + (size_t)(4 * i + kr) * 64 + nc);
#pragma unroll
    for (int i = 0; i < 16; ++i) { float* s = scr + (4 * i + kr) * 65 + nc; s[0] = v[i][0]; s[1] = v[i][1]; s[2] = v[i][2]; s[3] = v[i][3]; }
    LDS_WAIT();
    const int c = (lane & 3) + 4 * (lane >> 5), nn = (lane >> 2) & 7;
#pragma unroll
    for (int j = 0; j < 8; ++j) { const int n = nn + 8 * j; const float* s = scr + (8 * c) * 65 + n; float x[8], lo[8];
#pragma unroll
        for (int e = 0; e < 8; ++e) { x[e] = s[e * 65]; lo[e] = x[e] - bf1(f2bf(x[e])); }
        const v4u oh = {pk2(x[0], x[1]), pk2(x[2], x[3]), pk2(x[4], x[5]), pk2(x[6], x[7])}, ol = {pk2(lo[0], lo[1]), pk2(lo[2], lo[3]), pk2(lo[4], lo[5]), pk2(lo[6], lo[7])};
        *(v4u*)(dst + (size_t)n * 4096 + 8 * c) = oh; *(v4u*)(dst + (size_t)n * 4096 + 2048 + 8 * c) = oh; *(v4u*)(dst + (size_t)(64 + n) * 4096 + 8 * c) = ol; }
    LDS_WAIT();
}
__device__ __forceinline__ void p0_prologue(Frame& F) {
    const Args& A = *F.a;
    float* scr = (float*)(F.lds + F.wave * SCR_WAVE);
    const int gw = F.wave * F.G + F.vcu, NGW = F.G * NWAVES;
    { const float* cv = A.in[I_C]; const float* W = A.in[I_ADAW]; float* MP = (float*)(F.ws + WS_MODP);
      for (int it = gw; it < 2 * 8 * 48; it += NGW) {
          const int l = it / 384, r = it % 384, ks = r / 48, nb = r % 48;
          const float* wp = W + ((size_t)l * 2048 + ks * 256) * 12288 + nb * 256 + F.lane * 4;
          f32x4 acc = {0.f, 0.f, 0.f, 0.f};
#pragma unroll 8
          for (int k = 0; k < 256; ++k) { const float cx = cv[ks * 256 + k]; const float sl = cx / (1.f + __expf(-cx)); acc += sl * *(const f32x4*)(wp + (size_t)k * 12288); }
          *(f32x4*)(MP + (size_t)(l * 8 + ks) * 12288 + nb * 256 + F.lane * 4) = acc;
      } }
    { float* ROT = (float*)(F.ws + WS_ROT); const int gt = (F.vcu * NWAVES + F.wave) * 64 + F.lane, NT = NGW * 64;
      for (int idx = gt; idx < S_ * 32; idx += NT) { const int pos = idx >> 5, i = idx & 31;
          const float ang = (float)pos * INV_TAB[i]; double rev = (double)ang * 0.15915494309189535; rev -= __builtin_rint(rev); const float fr = (float)rev;
          *(f32x2*)(ROT + (size_t)idx * 2) = (f32x2){__builtin_amdgcn_cosf(fr), __builtin_amdgcn_sinf(fr)}; }
      v4u* z = (v4u*)(F.ws + WS_RWT2); const v4u zero = {0u, 0u, 0u, 0u};
      for (int idx = gt; idx < 64 * 256 + 128 * 512; idx += NT) { const int o = idx < 64 * 256 ? (64 + idx / 256) * 512 + 256 + idx % 256 : 128 * 512 + (idx - 64 * 256); z[o] = zero; } }
    constexpr int N_WIN = 2 * 32 * 96, N_WOUT = 2 * 32 * 32, N_MOE = 128 * 256, N_RW = 32, N_NORM = N_WOUT + 3 * N_MOE;
    for (int it = gw; it < N_WIN; it += NGW) { const int l = it / 3072, q = it % 3072, kb = q / 96, nb = q % 96;
        transpose_item<true>(A.in[I_WIN] + ((size_t)l * 2048 + kb * 64) * NIN + nb * 64, NIN, (bf16*)(F.ws + WS_WIN) + ((size_t)l * NPJ + nb * 64) * 2048 + kb * 64, 2048, scr, F.lane); }
    for (int it = gw; it < N_RW; it += NGW) router_item(A.in[I_RW] + (size_t)(it * 64) * 64, (bf16*)(F.ws + WS_RWT2) + it * 64, scr, F.lane);
#define T_DECODE(r_, src, ldw, dst, ldd) do { int r = (r_); \
        if (r < N_WOUT) { const int l = r / 1024, q = r % 1024, kb = q / 32, nb = q % 32; \
            src = A.in[I_WOUT] + ((size_t)l * 2048 + kb * 64) * 2048 + nb * 64; ldw = 2048; dst = (bf16*)(F.ws + WS_WOUT) + ((size_t)l * 2048 + nb * 64) * 2048 + kb * 64; ldd = 2048; } \
        else if ((r -= N_WOUT) < 2 * N_MOE) { const int s = r / N_MOE, q0 = r % N_MOE, le = q0 / 256, q = q0 % 256, kb = q / 8, nb = q % 8, n0 = nb * 64; \
            const int row = 256 * (n0 >> 7) + 128 * s + (n0 & 127); \
            src = A.in[s ? I_WU : I_WG] + ((size_t)le * 2048 + kb * 64) * 512 + n0; ldw = 512; dst = (bf16*)(F.ws + WS_WGU) + ((size_t)le * 1024 + row) * 2048 + kb * 64; ldd = 2048; } \
        else { r -= 2 * N_MOE; const int le = r / 256, q = r % 256, kb = q / 32, nb = q % 32; \
            src = A.in[I_WD] + ((size_t)le * 512 + kb * 64) * 2048 + nb * 64; ldw = 2048; dst = (bf16*)(F.ws + WS_WD) + ((size_t)le * 2048 + nb * 64) * 512 + kb * 64; ldd = 512; } } while (0)
#define T_LOAD(v, src, ldw) do { _Pragma("unroll") for (int i = 0; i < 16; ++i) v[i] = *(const f32x4*)(src + (size_t)(4 * i + kr) * ldw + nc); } while (0)
#define T_PROC(v, dst, ldd) do { _Pragma("unroll") for (int i = 0; i < 16; ++i) { float* s = scr + (4 * i + kr) * 65 + nc; s[0] = v[i][0]; s[1] = v[i][1]; s[2] = v[i][2]; s[3] = v[i][3]; } \
        LDS_WAIT(); \
        _Pragma("unroll") for (int j = 0; j < 8; ++j) { const int n = nn + 8 * j; const float* s = scr + (8 * cch) * 65 + n; \
            v4u o; o.x = pk2(s[0 * 65], s[1 * 65]); o.y = pk2(s[2 * 65], s[3 * 65]); o.z = pk2(s[4 * 65], s[5 * 65]); o.w = pk2(s[6 * 65], s[7 * 65]); \
            *(v4u*)(dst + (size_t)n * ldd + 8 * cch) = o; } \
        LDS_WAIT(); } while (0)
    { int lane = F.lane; asm volatile("" : "+v"(lane));
      const int kr = lane >> 4, nc = (lane & 15) * 4, cch = (lane & 3) + 4 * (lane >> 5), nn = (lane >> 2) & 7;
      int it = gw;
      if (it < N_NORM) {
          f32x4 va[16], vb[16]; const float* sa; const float* sb; bf16* da; bf16* db; int lwa, lda_, lwb, ldb_;
          T_DECODE(it, sa, lwa, da, lda_); T_LOAD(va, sa, lwa);
          for (;;) {
              const bool hb = it + NGW < N_NORM;
              if (hb) { T_DECODE(it + NGW, sb, lwb, db, ldb_); T_LOAD(vb, sb, lwb); }
              T_PROC(va, da, lda_);
              if (!hb) break;
              it += NGW;
              const bool ha = it + NGW < N_NORM;
              if (ha) { T_DECODE(it + NGW, sa, lwa, da, lda_); T_LOAD(va, sa, lwa); }
              T_PROC(vb, db, ldb_);
              if (!ha) break;
              it += NGW;
          }
      } }
#undef T_DECODE
#undef T_LOAD
#undef T_PROC
}

__device__ __forceinline__ float modv(const Args& A, const unsigned char* ws, int l, int idx) {
    const float* MP = (const float*)(ws + WS_MODP) + (size_t)l * 8 * 12288 + idx; float s = A.in[I_ADAB][l * 12288 + idx];
#pragma unroll
    for (int ks = 0; ks < 8; ++ks) s += MP[(size_t)ks * 12288];
    return s;
}
__device__ __forceinline__ float logsig(float x) { return fminf(x, 0.f) - __logf(1.f + __expf(-fabsf(x))); }
__device__ __forceinline__ int moe_tables(Frame& F, int l);
template <int MODE>
__device__ __forceinline__ void norm_phase(Frame& F, int l) {
    const Args& A = *F.a;
    if (MODE == 1 || MODE == 3) (void)moe_tables(F, MODE == 1 ? l - 1 : l);
    float* Av = (float*)F.lds; float* Bv = Av + 2048; float* Gv = Bv + 2048; float* W6 = Gv + 2048;
    for (int col = F.tid; col < 2048; col += NWAVES * 64) {
        if (MODE == 0 || MODE == 1) {
            const float ng = A.in[I_N1G][l * 2048 + col], sh = modv(A, F.ws, l, col), sc = modv(A, F.ws, l, 2048 + col);
            Av[col] = ng * (1.f + sc); Bv[col] = sh;
            const float* w = A.in[I_WIN] + ((size_t)l * 2048 + col) * NIN + C_FF;
#pragma unroll
            for (int j = 0; j < 6; ++j) W6[j * 2048 + col] = w[j];
        } else if (MODE == 2) {
            const float ng = A.in[I_N2G][l * 2048 + col], sh = modv(A, F.ws, l, 6144 + col), sc = modv(A, F.ws, l, 8192 + col);
            Av[col] = ng * (1.f + sc); Bv[col] = sh;
        } else { Av[col] = A.in[I_FG][col]; Bv[col] = 0.f; }
        if (MODE == 1 || MODE == 3) Gv[col] = modv(A, F.ws, MODE == 1 ? l - 1 : l, 10240 + col);
    }
    if (MODE == 0 || MODE == 1) { if (F.tid < 48) { const int idx = F.vcu * 48 + F.tid; ((float*)(F.ws + WS_MODF))[l * 12288 + idx] = modv(A, F.ws, l, idx); } }
    __syncthreads();
    const float* X1 = (const float*)(F.ws + WS_X1); const bf16* YS = (const bf16*)(F.ws + WS_YS);
    const int* TOPE = (const int*)(F.ws + WS_ROUTE); const int* TOPPOS = (const int*)(F.ws + WS_ROUTE + 2 * 131072); const float* TOPW = (const float*)(F.ws + WS_ROUTE + 131072);
    const int* offs = (const int*)(F.lds + LDS_OFFS);
    bf16* H = (bf16*)(F.ws + WS_H); float* LS = (float*)(F.ws + WS_LS);
    const int gw = F.vcu * NWAVES + F.wave, NGW = F.G * NWAVES;
    int ns0 = 0, ns1 = 0; float nw0 = 0.f, nw1 = 0.f;
    if ((MODE == 1 || MODE == 3) && gw < S_) { ns0 = offs[TOPE[2 * gw]] + TOPPOS[2 * gw]; ns1 = offs[TOPE[2 * gw + 1]] + TOPPOS[2 * gw + 1]; nw0 = TOPW[2 * gw]; nw1 = TOPW[2 * gw + 1]; }
    for (int t = gw; t < S_; t += NGW) {
        int ln_ = F.lane; asm volatile("" : "+v"(ln_)); f32x4 x[8]; const int c0 = ln_ * 4;
        if (MODE == 0) {
#pragma unroll
            for (int j = 0; j < 8; ++j) x[j] = *(const f32x4*)(A.in[I_X] + (size_t)t * 2048 + c0 + 256 * j);
        } else {
#pragma unroll
            for (int j = 0; j < 8; ++j) x[j] = *(const f32x4*)(X1 + (size_t)t * 2048 + c0 + 256 * j);
        }
        if (MODE == 1 || MODE == 3) {
            const int s0 = ns0, s1 = ns1; const float w0 = nw0, w1 = nw1;
            { const int tn = t + NGW; if (tn < S_) { ns0 = offs[TOPE[2 * tn]] + TOPPOS[2 * tn]; ns1 = offs[TOPE[2 * tn + 1]] + TOPPOS[2 * tn + 1]; nw0 = TOPW[2 * tn]; nw1 = TOPW[2 * tn + 1]; } }
#pragma unroll
            for (int j = 0; j < 8; ++j) { const v2u a = *(const v2u*)(YS + (size_t)s0 * 2048 + c0 + 256 * j), b = *(const v2u*)(YS + (size_t)s1 * 2048 + c0 + 256 * j);
                const f32x4 g = *(const f32x4*)(Gv + c0 + 256 * j);
                x[j][0] += g[0] * (w0 * bflo(a.x) + w1 * bflo(b.x)); x[j][1] += g[1] * (w0 * bfhi(a.x) + w1 * bfhi(b.x));
                x[j][2] += g[2] * (w0 * bflo(a.y) + w1 * bflo(b.y)); x[j][3] += g[3] * (w0 * bfhi(a.y) + w1 * bfhi(b.y)); }
            if (MODE == 1) {
#pragma unroll
                for (int j = 0; j < 8; ++j) *(f32x4*)(A.out + (size_t)t * 2048 + c0 + 256 * j) = x[j];
            }
        }
        float ss = 0.f;
#pragma unroll
        for (int j = 0; j < 8; ++j) ss += (x[j][0] * x[j][0] + x[j][1] * x[j][1]) + (x[j][2] * x[j][2] + x[j][3] * x[j][3]);
        const float rs = 1.0f / sqrtf(wave_sum(ss) * (1.f / 2048.f) + EPS_);
        float ff[6] = {0.f, 0.f, 0.f, 0.f, 0.f, 0.f};
#pragma unroll
        for (int j = 0; j < 8; ++j) { const f32x4 av = *(const f32x4*)(Av + c0 + 256 * j), bv = *(const f32x4*)(Bv + c0 + 256 * j);
            const f32x4 hv = x[j] * rs * av + bv;
            if (MODE == 3) *(f32x4*)(A.out + (size_t)t * 2048 + c0 + 256 * j) = hv;
            else if (MODE == 2) { v2u o; o.x = pk2(hv[0], hv[1]); o.y = pk2(hv[2], hv[3]); bf16* hp = (bf16*)(F.ws + WS_H2X) + (size_t)t * 4096 + c0 + 256 * j; *(v2u*)hp = o;
                v2u q; q.x = pk2(hv[0] - bflo(o.x), hv[1] - bfhi(o.x)); q.y = pk2(hv[2] - bflo(o.y), hv[3] - bfhi(o.y)); *(v2u*)(hp + 2048) = q; }
            else { v2u o; o.x = pk2(hv[0], hv[1]); o.y = pk2(hv[2], hv[3]); *(v2u*)(H + (size_t)t * 2048 + c0 + 256 * j) = o; }
            if (MODE == 0 || MODE == 1) {
#pragma unroll
                for (int q = 0; q < 6; ++q) { const f32x4 w = *(const f32x4*)(W6 + q * 2048 + c0 + 256 * j); ff[q] += (hv[0] * w[0] + hv[1] * w[1]) + (hv[2] * w[2] + hv[3] * w[3]); }
            }
            asm volatile("" ::: "memory");
        }
        if (MODE == 0 || MODE == 1) {
#pragma unroll
            for (int q = 0; q < 6; ++q) { const float f = wave_sum(ff[q]); if (F.lane == q) LS[(size_t)t * 8 + q] = logsig(f + A.in[I_FB][l * 6 + q]); }
        }
    }
}

__device__ __forceinline__ void cum_item(Frame& F, int h) {
    const float* LS = (const float*)(F.ws + WS_LS); float* CUM = (float*)(F.ws + WS_CUM) + (size_t)h * S_;
    float* red = (float*)F.lds;
    const int p0 = F.tid * 32; float v[32]; float run = 0.f;
#pragma unroll
    for (int i = 0; i < 32; ++i) { run += LS[(size_t)(p0 + i) * 8 + h]; v[i] = run; }
    float inc = run;
#pragma unroll
    for (int o = 1; o < 64; o <<= 1) { const float u = __shfl_up(inc, o); if (F.lane >= o) inc += u; }
    if (F.lane == 63) red[F.wave] = inc;
    __syncthreads();
    float base = inc - run;
    for (int w = 0; w < F.wave; ++w) base += red[w];
#pragma unroll
    for (int i = 0; i < 32; ++i) CUM[p0 + i] = base + v[i];
    __syncthreads();
}
__device__ __forceinline__ void qknorm_item(Frame& F, int h, int qb) {
    const bf16* PJ = (const bf16*)(F.ws + WS_PROJ); float* MQK = (float*)(F.ws + WS_MAXQK);
    float* red = (float*)F.lds;
    const int row = qb * 256 + (F.tid >> 1), half = F.tid & 1;
    const bf16* qp = PJ + (size_t)row * NPJ + C_FQ + 128 * h + 64 * half; const bf16* kp = PJ + (size_t)row * NPJ + C_FK + 128 * h + 64 * half;
    float sq = 0.f, sk = 0.f;
#pragma unroll
    for (int i = 0; i < 8; ++i) { const v4u a = *(const v4u*)(qp + 8 * i), b = *(const v4u*)(kp + 8 * i);
#pragma unroll
        for (int e = 0; e < 4; ++e) { const float a0 = bflo(a[e]), a1 = bfhi(a[e]), b0 = bflo(b[e]), b1 = bfhi(b[e]); sq += a0 * a0 + a1 * a1; sk += b0 * b0 + b1 * b1; } }
    sq += __shfl_xor(sq, 1); sk += __shfl_xor(sk, 1);
    const float mq = wave_max(sqrtf(sq)), mk = wave_max(sqrtf(sk));
    if (F.lane == 0) { red[F.wave * 2] = mq; red[F.wave * 2 + 1] = mk; }
    __syncthreads();
    if (F.tid == 0) { float a = 0.f, b = 0.f; for (int w = 0; w < 8; ++w) { a = fmaxf(a, red[2 * w]); b = fmaxf(b, red[2 * w + 1]); } MQK[(h * 64 + qb) * 2] = a; MQK[(h * 64 + qb) * 2 + 1] = b; }
    __syncthreads();
}
__device__ __forceinline__ void conv_item(Frame& F, int l, int rb) {
    const Args& A = *F.a; const bf16* PJ = (const bf16*)(F.ws + WS_PROJ); bf16* MX = (bf16*)(F.ws + WS_MIXED);
    int tid = F.tid; asm volatile("" : "+v"(tid));
    const int ch = (tid & 63) * 8, t0 = rb * 64 + (tid >> 6) * 8;
    float w0[8], w1[8], w2[8], z1[8], z2[8];
#pragma unroll
    for (int e = 0; e < 8; ++e) { w0[e] = A.in[I_CONVW][(l * 3 + 0) * 512 + ch + e]; w1[e] = A.in[I_CONVW][(l * 3 + 1) * 512 + ch + e]; w2[e] = A.in[I_CONVW][(l * 3 + 2) * 512 + ch + e]; z1[e] = 0.f; z2[e] = 0.f; }
#pragma unroll
    for (int i = -2; i < 8; ++i) { const int t = t0 + i; if (t < 0) continue;
        const bf16* rp = PJ + (size_t)t * NPJ + ch; const v4u cc = *(const v4u*)(rp + C_CC), cu = *(const v4u*)(rp + C_CU);
        float z[8];
#pragma unroll
        for (int e = 0; e < 4; ++e) { z[2 * e] = bflo(cc[e]) * bflo(cu[e]); z[2 * e + 1] = bfhi(cc[e]) * bfhi(cu[e]); }
        if (i >= 0) { const v4u cb = *(const v4u*)(rp + C_CB); float y[8];
#pragma unroll
            for (int e = 0; e < 4; ++e) { y[2 * e] = bflo(cb[e]) * (w0[2 * e] * z2[2 * e] + w1[2 * e] * z1[2 * e] + w2[2 * e] * z[2 * e]);
                                          y[2 * e + 1] = bfhi(cb[e]) * (w0[2 * e + 1] * z2[2 * e + 1] + w1[2 * e + 1] * z1[2 * e + 1] + w2[2 * e + 1] * z[2 * e + 1]); }
            v4u o; o.x = pk2(y[0], y[1]); o.y = pk2(y[2], y[3]); o.z = pk2(y[4], y[5]); o.w = pk2(y[6], y[7]);
            *(v4u*)(MX + (size_t)t * 2048 + M_CONV + ch) = o; }
#pragma unroll
        for (int e = 0; e < 8; ++e) { z2[e] = z1[e]; z1[e] = z[e]; }
    }
}
__device__ __forceinline__ void rot4(const bf16* rowp, const float* ROT, int pos, int i0, float (&o1)[4], float (&o2)[4]) {
    const v2u a = *(const v2u*)(rowp + i0), b = *(const v2u*)(rowp + 32 + i0);
    const f32x4 c0 = *(const f32x4*)(ROT + ((size_t)pos * 32 + i0) * 2), c1 = *(const f32x4*)(ROT + ((size_t)pos * 32 + i0) * 2 + 4);
    const float x1[4] = {bflo(a.x), bfhi(a.x), bflo(a.y), bfhi(a.y)}, x2[4] = {bflo(b.x), bfhi(b.x), bflo(b.y), bfhi(b.y)};
    const float cs[4] = {c0[0], c0[2], c1[0], c1[2]}, sn[4] = {c0[1], c0[3], c1[1], c1[3]};
#pragma unroll
    for (int e = 0; e < 4; ++e) { o1[e] = x1[e] * cs[e] - x2[e] * sn[e]; o2[e] = x2[e] * cs[e] + x1[e] * sn[e]; }
}
constexpr int RP = 72;
constexpr int PVR = 160, PKR = 96;
typedef short v4i16_t __attribute__((ext_vector_type(4)));
__device__ __forceinline__ s16x4 trrd(const bf16* p) { return __builtin_bit_cast(s16x4, __builtin_amdgcn_ds_read_tr16_b64_v4i16((LAS v4i16_t*)p)); }
__device__ __forceinline__ bf16x8 tr_frag(const bf16* T, int pitch, int rowA, int rowB, int col0, int lane) {
    const int blk = (lane >> 4) & 1, q = (lane & 15) >> 2, p = lane & 3; const bf16* b = T + q * pitch + col0 + 16 * blk + 4 * p;
    const s16x4 lo = trrd(b + rowA * pitch), hi = trrd(b + rowB * pitch);
    return (bf16x8){lo[0], lo[1], lo[2], lo[3], hi[0], hi[1], hi[2], hi[3]};
}
__device__ __forceinline__ void stage_vr(unsigned char* ws, int tid, bf16* VR, int c, int h) {
    const bf16* PJ = (const bf16*)(ws + WS_PROJ);
    const int m = tid >> 3, v0 = (tid & 7) * 16; const bf16* vp = PJ + (size_t)(64 * c + m) * NPJ + C_RV + 128 * h + v0;
    const v4u a = *(const v4u*)vp, b = *(const v4u*)(vp + 8);
    *(v4u*)(VR + m * PVR + v0) = a; *(v4u*)(VR + m * PVR + v0 + 8) = b;
}
__device__ __forceinline__ void r1_item(Frame& FF, int c, int h) {
    struct { unsigned char* lds; unsigned char* ws; int tid, lane, wave; } F; F.lds = FF.lds; F.ws = FF.ws; F.wave = FF.wave;
    { int t_ = FF.tid; asm volatile("" : "+v"(t_)); F.tid = t_; F.lane = t_ & 63; }
    const bf16* PJ = (const bf16*)(F.ws + WS_PROJ); const float* ROT = (const float*)(F.ws + WS_ROT);
    bf16* KR = (bf16*)F.lds; bf16* VR = KR + 64 * PKR;
    const float lg2 = ret_lg2(h);
    { const int m = F.tid >> 3, i0 = (F.tid & 7) * 4, pos = 64 * c + m; float o1[4], o2[4];
      rot4(PJ + (size_t)pos * NPJ + C_RK + 64 * h, ROT, pos, i0, o1, o2);
      const float sc = 0.125f * __builtin_amdgcn_exp2f(lg2 * (float)(63 - m));
      *(v2u*)(KR + m * PKR + i0) = (v2u){pk2(o1[0] * sc, o1[1] * sc), pk2(o1[2] * sc, o1[3] * sc)}; *(v2u*)(KR + m * PKR + 32 + i0) = (v2u){pk2(o2[0] * sc, o2[1] * sc), pk2(o2[2] * sc, o2[3] * sc)}; }
    stage_vr(F.ws, F.tid, VR, c, h);
    __syncthreads();
    const int r32 = F.lane & 31, hh = F.lane >> 5, vi = F.wave >> 1, di = F.wave & 1;
    f32x16 acc = {};
#pragma unroll
    for (int s = 0; s < 4; ++s) { const bf16x8 a = tr_frag(VR, PVR, 16 * s + 8 * hh, 16 * s + 8 * hh + 4, 32 * vi, F.lane), b = tr_frag(KR, PKR, 16 * s + 8 * hh, 16 * s + 8 * hh + 4, 32 * di, F.lane);
        acc = __builtin_amdgcn_mfma_f32_32x32x16_bf16(a, b, acc, 0, 0, 0); }
    float* KVT = (float*)(F.ws + WS_KVT) + (size_t)(c * 6 + h) * 8192;
#pragma unroll
    for (int r = 0; r < 16; ++r) KVT[(32 * vi + fa::crow(r, hh)) * 64 + 32 * di + r32] = acc[r];
    __syncthreads();
}
__device__ __forceinline__ void mixa0_phase(Frame& F) {
    constexpr int N_CUM = 6, N_QK = 384;
    for (int it = F.vcu; it < N_CUM + N_QK; it += F.G) { if (it < N_CUM) cum_item(F, it); else qknorm_item(F, (it - N_CUM) % 6, (it - N_CUM) / 6); }
}
__device__ __forceinline__ void mixb_phase(Frame& F) {
    const float* KVT = (const float*)(F.ws + WS_KVT); bf16* PV = (bf16*)(F.ws + WS_PREVT);
    const int gt = (F.vcu * NWAVES + F.wave) * 64 + F.lane;
    if (gt < 6 * 8192) { const int h = gt / 8192; const float dec = __builtin_amdgcn_exp2f(ret_lg2(h) * 64.f); float st = 0.f;
        for (int c0 = 0; c0 < 256; c0 += 16) { float kv[16];
#pragma unroll
            for (int i = 0; i < 16; ++i) kv[i] = KVT[(size_t)(c0 + i) * 49152 + gt];
#pragma unroll
            for (int i = 0; i < 16; ++i) { PV[(size_t)(c0 + i) * 49152 + gt] = f2bf(st); st = st * dec + kv[i]; } } }
}
struct R3In { v2u qa, qb, ka, kb; f32x4 r0, r1; v4u va, vb, g0, g1; bf16x8 pvf[4]; };
__device__ __forceinline__ void r3_load(Frame& FF, int c, int h, R3In& I) {
    int tid = FF.tid; asm volatile("" : "+v"(tid)); const int lane = tid & 63;
    const bf16* PJ = (const bf16*)(FF.ws + WS_PROJ); const float* ROT = (const float*)(FF.ws + WS_ROT);
    const int m = tid >> 3, i0 = (tid & 7) * 4, pos = 64 * c + m; const bf16* rp = PJ + (size_t)pos * NPJ;
    I.qa = *(const v2u*)(rp + C_RQ + 64 * h + i0); I.qb = *(const v2u*)(rp + C_RQ + 64 * h + 32 + i0); I.ka = *(const v2u*)(rp + C_RK + 64 * h + i0); I.kb = *(const v2u*)(rp + C_RK + 64 * h + 32 + i0);
    I.r0 = *(const f32x4*)(ROT + ((size_t)pos * 32 + i0) * 2); I.r1 = *(const f32x4*)(ROT + ((size_t)pos * 32 + i0) * 2 + 4);
    { const bf16* vp = rp + C_RV + 128 * h + (tid & 7) * 16; I.va = *(const v4u*)vp; I.vb = *(const v4u*)(vp + 8); }
    { const bf16* gp = rp + C_RG + 128 * h + 16 * (tid & 7); I.g0 = *(const v4u*)gp; I.g1 = *(const v4u*)(gp + 8); }
    { const int r32_ = lane & 31, hh_ = lane >> 5, vi_ = FF.wave >> 1; const bf16* PV = (const bf16*)(FF.ws + WS_PREVT) + ((size_t)(c * 6 + h) * 128 + 32 * vi_ + r32_) * 64;
#pragma unroll
      for (int s = 0; s < 4; ++s) I.pvf[s] = *(const bf16x8*)(PV + 16 * s + 8 * hh_); }
}
__device__ __forceinline__ void rot4v(v2u a, v2u b, f32x4 c0, f32x4 c1, float (&o1)[4], float (&o2)[4]) {
    const float x1[4] = {bflo(a.x), bfhi(a.x), bflo(a.y), bfhi(a.y)}, x2[4] = {bflo(b.x), bfhi(b.x), bflo(b.y), bfhi(b.y)};
    const float cs[4] = {c0[0], c0[2], c1[0], c1[2]}, sn[4] = {c0[1], c0[3], c1[1], c1[3]};
#pragma unroll
    for (int e = 0; e < 4; ++e) { o1[e] = x1[e] * cs[e] - x2[e] * sn[e]; o2[e] = x2[e] * cs[e] + x1[e] * sn[e]; }
}
__device__ __forceinline__ void r3_compute(Frame& FF, int l, int c, int h, const R3In& I) {
    struct { unsigned char* lds; unsigned char* ws; const Args* a; int tid, lane, wave; } F; F.lds = FF.lds; F.ws = FF.ws; F.a = FF.a; F.wave = FF.wave;
    { int t_ = FF.tid; asm volatile("" : "+v"(t_)); F.tid = t_; F.lane = t_ & 63; }
    const Args& A = *F.a;
    bf16* QS = (bf16*)F.lds; bf16* KS = QS + 64 * RP; bf16* VR = KS + 64 * RP; float* OS = (float*)(VR + 64 * PVR);
    const float lg2 = ret_lg2(h);
    { const int m = F.tid >> 3, i0 = (F.tid & 7) * 4; float o1[4], o2[4];
      rot4v(I.qa, I.qb, I.r0, I.r1, o1, o2);
      *(v2u*)(QS + m * RP + i0) = (v2u){pk2(o1[0], o1[1]), pk2(o1[2], o1[3])}; *(v2u*)(QS + m * RP + 32 + i0) = (v2u){pk2(o2[0], o2[1]), pk2(o2[2], o2[3])};
      rot4v(I.ka, I.kb, I.r0, I.r1, o1, o2);
      *(v2u*)(KS + m * RP + i0) = (v2u){pk2(o1[0] * 0.125f, o1[1] * 0.125f), pk2(o1[2] * 0.125f, o1[3] * 0.125f)};
      *(v2u*)(KS + m * RP + 32 + i0) = (v2u){pk2(o2[0] * 0.125f, o2[1] * 0.125f), pk2(o2[2] * 0.125f, o2[3] * 0.125f)};
      const int v0 = (F.tid & 7) * 16; *(v4u*)(VR + m * PVR + v0) = I.va; *(v4u*)(VR + m * PVR + v0 + 8) = I.vb; }
    __syncthreads();
    const int r32 = F.lane & 31, hh = F.lane >> 5, ni = F.wave & 1, vi = F.wave >> 1;
    f32x16 oacc = {}, cacc = {};
#pragma unroll
    for (int mj = 0; mj < 2; ++mj) {
        f32x16 X = {};
#pragma unroll
        for (int s = 0; s < 4; ++s) { const bf16x8 a = *(const bf16x8*)(KS + (32 * mj + r32) * RP + 16 * s + 8 * hh), b = *(const bf16x8*)(QS + (32 * ni + r32) * RP + 16 * s + 8 * hh);
            X = __builtin_amdgcn_mfma_f32_32x32x16_bf16(a, b, X, 0, 0, 0); }
#pragma unroll
        for (int r = 0; r < 16; ++r) { const int dm = (32 * ni + r32) - (32 * mj + fa::crow(r, hh)); X[r] *= __builtin_amdgcn_exp2f(lg2 * (float)(dm < 0 ? -dm : dm)); }
#pragma unroll
        for (int s2 = 0; s2 < 2; ++s2) {
            v4u pw; pw.x = pk2(X[8 * s2 + 0], X[8 * s2 + 1]); pw.y = pk2(X[8 * s2 + 2], X[8 * s2 + 3]); pw.z = pk2(X[8 * s2 + 4], X[8 * s2 + 5]); pw.w = pk2(X[8 * s2 + 6], X[8 * s2 + 7]);
            const bf16x8 bwf = tr_frag(VR, PVR, 32 * mj + 16 * s2 + 4 * hh, 32 * mj + 16 * s2 + 8 + 4 * hh, 32 * vi, F.lane);
            oacc = __builtin_amdgcn_mfma_f32_32x32x16_bf16(*(const bf16x8*)&pw, bwf, oacc, 0, 0, 0); }
    }
    {
#pragma unroll
      for (int s = 0; s < 4; ++s) { const bf16x8 a = *(const bf16x8*)(QS + (32 * ni + r32) * RP + 16 * s + 8 * hh), b = I.pvf[s];
          cacc = __builtin_amdgcn_mfma_f32_32x32x16_bf16(a, b, cacc, 0, 0, 0); } }
#pragma unroll
    for (int r = 0; r < 16; ++r) { const int n = 32 * ni + fa::crow(r, hh); OS[n * 132 + 32 * vi + r32] = oacc[r] + __builtin_amdgcn_exp2f(lg2 * (float)(n + 1)) * cacc[r]; }
    __syncthreads();
    { const int n = F.tid >> 3, part = F.tid & 7, pos = 64 * c + n; float x[16]; float s = 0.f;
#pragma unroll
      for (int q = 0; q < 4; ++q) { const f32x4 v = *(const f32x4*)(OS + n * 132 + 16 * part + 4 * q); x[4 * q] = v[0]; x[4 * q + 1] = v[1]; x[4 * q + 2] = v[2]; x[4 * q + 3] = v[3]; s += (v[0] + v[1]) + (v[2] + v[3]); }
      s += __shfl_xor(s, 1); s += __shfl_xor(s, 2); s += __shfl_xor(s, 4);
      const float mu = s * (1.f / 128.f); float q2 = 0.f;
#pragma unroll
      for (int e = 0; e < 16; ++e) { x[e] -= mu; q2 += x[e] * x[e]; }
      q2 += __shfl_xor(q2, 1); q2 += __shfl_xor(q2, 2); q2 += __shfl_xor(q2, 4);
      const float rstd = 1.0f / sqrtf(q2 * (1.f / 128.f) + EPS_);
      const v4u g0 = I.g0, g1 = I.g1;
      const float* gn = A.in[I_GNG] + l * 768 + 128 * h + 16 * part; float y[16];
#pragma unroll
      for (int e = 0; e < 8; ++e) { const unsigned gw_ = e < 4 ? g0[e] : g1[e - 4];
          const float ga = bflo(gw_), gb = bfhi(gw_);
          y[2 * e] = x[2 * e] * rstd * gn[2 * e] * (ga / (1.f + __expf(-ga))); y[2 * e + 1] = x[2 * e + 1] * rstd * gn[2 * e + 1] * (gb / (1.f + __expf(-gb))); }
      bf16* op = (bf16*)(F.ws + WS_MIXED) + (size_t)pos * 2048 + M_RET + 128 * h + 16 * part;
      *(v4u*)op = (v4u){pk2(y[0], y[1]), pk2(y[2], y[3]), pk2(y[4], y[5]), pk2(y[6], y[7])};
      *(v4u*)(op + 8) = (v4u){pk2(y[8], y[9]), pk2(y[10], y[11]), pk2(y[12], y[13]), pk2(y[14], y[15])}; }
    __syncthreads();
}
__device__ __forceinline__ void attn_unit(Frame& F, int h, int qb) {
    using namespace fa;
    const bf16* PJ = (const bf16*)(F.ws + WS_PROJ); const float* CUM = (const float*)(F.ws + WS_CUM) + (size_t)h * S_; const float* MQK = (const float*)(F.ws + WS_MAXQK);
    char* lds = (char*)F.lds; char* V_lds = lds + OFF_V; char* K_lds = lds + OFF_K; float* b_lds = (float*)(lds + OFF_B);
    float* wsm = (float*)(lds + OFF_W) + F.wave * 64; float* li_l = wsm; float* al_l = wsm + 32;
    int tid = F.tid; asm volatile("" : "+v"(tid));
    const int wid = F.wave, lane = tid & 63, r32 = lane & 31, hi = lane >> 5;
    const int qlo = qb * QB + wid * QBLK;
    bf16x8 qr[8];
#pragma unroll
    for (int d0 = 0; d0 < 8; ++d0) qr[d0] = *(const bf16x8*)(PJ + (size_t)(qlo + r32) * NPJ + C_FQ + 128 * h + d0 * 16 + hi * 8);
    const int j_hi = 4 * qb + 4;
    const float cfirst = CUM[qb * QB];
    int j_lo;
    { const float kmx = wave_max(lane <= qb ? MQK[(h * 64 + lane) * 2 + 1] : 0.f);
      const float Dn = MQK[(h * 64 + qb) * 2] * (kmx + MQK[(h * 64 + qb) * 2 + 1]) * SCALE + 30.f;
      int cand = 4 * qb;
#pragma unroll
      for (int i = 0; i < 4; ++i) { const int j = lane + 64 * i; if (j < 4 * qb) { const bool skip = (cfirst - CUM[64 * j + 63]) < -Dn; if (!skip && j < cand) cand = j; } }
      j_lo = wave_min_i(cand); }
    float m_reg = -1e30f, l_reg = 0.f; f32x16 o[4] = {};
    const int sr = tid >> 4, sc = (tid & 15) * 8, vst0 = v_st(sr, sc), vst1 = v_st(32 + sr, sc), kws = KSWZ(sr, sc * 2);
    const int vb0 = (int)(uintptr_t)V_lds + v_rd_base(lane);
    const bf16* Kg = PJ + C_FK + 128 * h + sc; const bf16* Vg = PJ + C_FV + 128 * h + sc;
    v4u k0, k1, v0, v1; float bia = 0.f;
#define ATT_LOAD(t_) do { const int kb_ = (t_) * KVBLK; k0 = *(const v4u*)(Kg + (size_t)(kb_ + sr) * NPJ); k1 = *(const v4u*)(Kg + (size_t)(kb_ + 32 + sr) * NPJ); \
        v0 = *(const v4u*)(Vg + (size_t)(kb_ + sr) * NPJ); v1 = *(const v4u*)(Vg + (size_t)(kb_ + 32 + sr) * NPJ); if (tid < 64) bia = (cfirst - CUM[kb_ + tid]) * (1.0f / SCALE); } while (0)
    ATT_LOAD(j_lo);
    for (int t = j_lo; t < j_hi; ++t) {
        const int kb = t * KVBLK, bo = ((t - j_lo) & 1) * ATT_BUF;
        *(v4u*)(K_lds + bo + kws) = k0; *(v4u*)(K_lds + bo + kws + 32 * 256) = k1; *(v4u*)(V_lds + bo + vst0) = v0; *(v4u*)(V_lds + bo + vst1) = v1;
        if (tid < 64) b_lds[bo / 4 + tid] = bia;
        if (t + 1 < j_hi) ATT_LOAD(t + 1);
        __syncthreads();
        if (kb <= qlo + QBLK - 1) {
            f32x16 p0, p1; float mn, alpha; bf16x8 pa0, pa1, pa2, pa3;
            qkt(p0, p1, K_lds + bo, b_lds + bo / 4, r32, hi, qr);
            if (kb + KVBLK - 1 > qlo) mask_tile(p0, p1, qlo + r32 - 4 * hi - kb);
            partialSM(p0, p1, m_reg, mn, alpha);
            if (__any(alpha < 1.f)) { if (hi == 0) al_l[r32] = alpha; asm volatile("s_waitcnt lgkmcnt(0)" ::: "memory");
#pragma unroll
                for (int d_ = 0; d_ < 4; ++d_)
#pragma unroll
                    for (int r = 0; r < 16; ++r) o[d_][r] *= al_l[crow(r, hi)]; }
            finishSM(p0, p1, alpha, l_reg, pa0, pa1, pa2, pa3);
            pv_tile(o, vb0 + bo, pa0, pa1, pa2, pa3);
        }
    }
#undef ATT_LOAD
    if (hi == 0) li_l[r32] = l_reg; asm volatile("s_waitcnt lgkmcnt(0)" ::: "memory");
    float rli[16];
#pragma unroll
    for (int r = 0; r < 16; ++r) rli[r] = __builtin_amdgcn_rcpf(li_l[crow(r, hi)]);
    bf16* Ow = (bf16*)(F.ws + WS_MIXED) + (size_t)qlo * 2048 + M_FOX + 128 * h;
#pragma unroll
    for (int r = 0; r < 16; ++r) { const int orow = crow(r, hi);
#pragma unroll
        for (int d0 = 0; d0 < 4; ++d0) { const float v = o[d0][r] * rli[r]; const float vn = __shfl_xor(v, 1);
            if ((r32 & 1) == 0) *(unsigned*)(Ow + (size_t)orow * 2048 + d0 * 32 + r32) = cvtpk(v, vn); } }
    __syncthreads();
}
__device__ __forceinline__ int att_jlo(Frame& F, int h, int qb, int lane, float& cfirst) {
    const float* CUM = (const float*)(F.ws + WS_CUM) + (size_t)h * S_; const float* MQK = (const float*)(F.ws + WS_MAXQK);
    cfirst = CUM[qb * 256];
    const float kmx = wave_max(lane <= qb ? MQK[(h * 64 + lane) * 2 + 1] : 0.f);
    const float Dn = MQK[(h * 64 + qb) * 2] * (kmx + MQK[(h * 64 + qb) * 2 + 1]) * fa::SCALE + 30.f;
    int cand = 4 * qb;
#pragma unroll
    for (int i = 0; i < 4; ++i) { const int j = lane + 64 * i; if (j < 4 * qb) { const bool skip = (cfirst - CUM[64 * j + 63]) < -Dn; if (!skip && j < cand) cand = j; } }
    return wave_min_i(cand);
}
__device__ __forceinline__ void att_ref(Frame& F, int id, int lane, fa2::BlockRef& r) {
    const int h = id >> 6, qb = id & 63; const bf16* PJ = (const bf16*)(F.ws + WS_PROJ);
    r.Q = PJ + (size_t)(qb * 256) * NPJ + C_FQ + 128 * h; r.K = PJ + C_FK + 128 * h; r.V = PJ + C_FV + 128 * h;
    r.O = (bf16*)(F.ws + WS_MIXED) + (size_t)(qb * 256) * 2048 + M_FOX + 128 * h; r.C = (const float*)(F.ws + WS_CUM) + (size_t)h * S_; r.P0 = qb * 256;
    float cf; const int jl = att_jlo(F, h, qb, lane, cf); r.jlo = __builtin_amdgcn_readfirstlane(jl); r.cf = __builtin_bit_cast(float, __builtin_amdgcn_readfirstlane(__builtin_bit_cast(int, cf)));
}
#ifndef REPATT
#define REPATT 1
#endif
#ifndef REPR3
#define REPR3 1
#endif
__device__ __forceinline__ void mixa1_phase(Frame& F, int l, int rep) {
    volatile unsigned* nxt = (volatile unsigned*)(F.lds + LDSCTL_OFF + 64);
    unsigned* head = (unsigned*)(F.ctl + CW_Q + 128 * l + 16 * rep);
#pragma unroll 1
    for (int ra = 0; ra < REPATT; ++ra) {
        int tid = F.tid; asm volatile("" : "+v"(tid)); const int lane = tid & 63;
        unsigned* xh = (unsigned*)(F.ctl + CW_QX + (((l * 2 + rep) * 2 + ra) * 8 + (int)(blockIdx.x & 7)) * 16);
        const int ubase = 48 * (int)(blockIdx.x & 7);
        if (F.tid == 0) *nxt = __hip_atomic_fetch_add(xh, 1u, RLX_AGENT);
        __syncthreads();
        int k = __builtin_amdgcn_readfirstlane((int)*nxt);
        __syncthreads();
        while (k < 48) {
            fa2::Seam S; fa2::BlockRef cur;
            att_ref(F, ubase + k, lane, cur);
            fa2::prime(cur, (char*)F.lds, S, tid);
            fa2::block(cur, (char*)F.lds, S, tid);
            if (F.tid == 0) *nxt = __hip_atomic_fetch_add(xh, 1u, RLX_AGENT);
            __syncthreads();
            k = __builtin_amdgcn_readfirstlane((int)*nxt);
            __syncthreads();
        }
    }
    constexpr int N_CONV = 256, N_R1 = 1536;
#pragma unroll 1
    for (int rr = 0; rr < REPR3; ++rr)
    for (;;) {
        if (F.tid == 0) *nxt = __hip_atomic_fetch_add(head + 64 + 4 * rr, 1u, RLX_AGENT);
        __syncthreads();
        const int id = __builtin_amdgcn_readfirstlane((int)*nxt);
        __syncthreads();
        if (id >= N_CONV + N_R1 / 4) break;
        if (id < N_CONV) conv_item(F, l, id);
        else {
#pragma unroll 1
            for (int q = 0; q < 4; ++q) { const int it = (id - N_CONV) * 4 + q; r1_item(F, it / 6, it % 6); } }
    }
}
__device__ __forceinline__ void mixr3_phase(Frame& F, int l) {
    int it = F.vcu;
    if (it < 1536) {
        R3In a, b;
        r3_load(F, it / 6, it % 6, a);
        for (;;) {
            const bool hb = it + F.G < 1536;
            if (hb) r3_load(F, (it + F.G) / 6, (it + F.G) % 6, b);
            r3_compute(F, l, it / 6, it % 6, a);
            if (!hb) break;
            it += F.G;
            const bool ha = it + F.G < 1536;
            if (ha) r3_load(F, (it + F.G) / 6, (it + F.G) % 6, a);
            r3_compute(F, l, it / 6, it % 6, b);
            if (!ha) break;
            it += F.G;
        }
    }
}

__device__ __forceinline__ void route_phase(Frame& F, int l) {
    const Args& A = *F.a; const float* rb = A.in[I_RB];
    const int t = (F.vcu * NWAVES + F.wave) * 64 + F.lane;
    if (t >= S_) return;
    const float* lg = (const float*)(F.ws + WS_LOGIT) + (size_t)t * 128;
    float bgs = -__builtin_inff(); int be0 = 0, be1 = 0; float ba0 = 0.f, ba1 = 0.f;
#pragma unroll
    for (int g = 0; g < 8; ++g) {
        f32x4 v0 = {0.f, 0.f, 0.f, 0.f}, v1 = {0.f, 0.f, 0.f, 0.f};
#pragma unroll
        for (int ks = 0; ks < 4; ++ks) { const float* p = lg + (size_t)ks * S_ * 128; v0 += *(const f32x4*)(p + 8 * g) + *(const f32x4*)(p + 64 + 8 * g); v1 += *(const f32x4*)(p + 8 * g + 4) + *(const f32x4*)(p + 64 + 8 * g + 4); }
        float s1 = -__builtin_inff(), s2 = -__builtin_inff(), a1 = 0.f, a2 = 0.f; int i1 = 0, i2 = 0;
#pragma unroll
        for (int i = 0; i < 8; ++i) { const float x = i < 4 ? v0[i] : v1[i - 4]; const float aff = 1.f / (1.f + __expf(-x)); const float sel = aff + rb[8 * g + i];
            if (sel > s1) { s2 = s1; i2 = i1; a2 = a1; s1 = sel; i1 = i; a1 = aff; } else if (sel > s2) { s2 = sel; i2 = i; a2 = aff; } }
        const float gs = s1 + s2;
        if (gs > bgs) { bgs = gs; be0 = 8 * g + i1; be1 = 8 * g + i2; ba0 = a1; ba1 = a2; }
    }
    const float inv = 1.f / (ba0 + ba1);
    unsigned* cnt = (unsigned*)(F.ctl + CW_CNT + 64 * l);
    const int p0 = (int)__hip_atomic_fetch_add(cnt + be0, 1u, RLX_AGENT), p1 = (int)__hip_atomic_fetch_add(cnt + be1, 1u, RLX_AGENT);
    int* TOPE = (int*)(F.ws + WS_ROUTE); float* TOPW = (float*)(F.ws + WS_ROUTE + 131072); int* TOPPOS = (int*)(F.ws + WS_ROUTE + 2 * 131072); int* TOKTAB = (int*)(F.ws + WS_TOKTAB);
    TOPE[2 * t] = be0; TOPE[2 * t + 1] = be1; TOPW[2 * t] = ba0 * inv; TOPW[2 * t + 1] = ba1 * inv; TOPPOS[2 * t] = p0; TOPPOS[2 * t + 1] = p1;
    TOKTAB[be0 * 16384 + p0] = t; TOKTAB[be1 * 16384 + p1] = t;
}
__device__ __forceinline__ void normb_route_phase(Frame& F, int l) {
    const Args& A = *F.a;
    constexpr int AP = 2056;
    bf16* Ahi = (bf16*)F.lds; bf16* Alo = Ahi + 16 * AP; float* red = (float*)F.lds; float* fin = red + 8 * 1024;
    const float* MODF = (const float*)(F.ws + WS_MODF) + l * 12288; const float* X1 = (const float*)(F.ws + WS_X1); bf16* H = (bf16*)(F.ws + WS_H);
    const bf16* RW = (const bf16*)(F.ws + WS_RWT2);
    const int lane = F.lane, c0 = lane * 4;
    f32x4 av[8], bv[8];
#pragma unroll
    for (int j = 0; j < 8; ++j) { const int col = c0 + 256 * j; const f32x4 ng = *(const f32x4*)(A.in[I_N2G] + l * 2048 + col), sc = *(const f32x4*)(MODF + 8192 + col); av[j] = ng * (1.f + sc); bv[j] = *(const f32x4*)(MODF + 6144 + col); }
    const int w = F.wave, mr = lane & 15, kq = lane >> 4;
    for (int blk = F.vcu; blk < S_ / 16; blk += F.G) {
        const int R0 = blk * 16;
#pragma unroll
        for (int q = 0; q < 2; ++q) { const int rl = 2 * w + q, t = R0 + rl; f32x4 x[8]; float ss = 0.f;
#pragma unroll
            for (int j = 0; j < 8; ++j) { x[j] = *(const f32x4*)(X1 + (size_t)t * 2048 + c0 + 256 * j); ss += (x[j][0] * x[j][0] + x[j][1] * x[j][1]) + (x[j][2] * x[j][2] + x[j][3] * x[j][3]); }
            const float rs = 1.0f / sqrtf(wave_sum(ss) * (1.f / 2048.f) + EPS_);
#pragma unroll
            for (int j = 0; j < 8; ++j) { const f32x4 hv = x[j] * rs * av[j] + bv[j]; v2u o; o.x = pk2(hv[0], hv[1]); o.y = pk2(hv[2], hv[3]);
                v2u ql; ql.x = pk2(hv[0] - bflo(o.x), hv[1] - bfhi(o.x)); ql.y = pk2(hv[2] - bflo(o.y), hv[3] - bfhi(o.y));
                *(v2u*)(H + (size_t)t * 2048 + c0 + 256 * j) = o; *(v2u*)(Ahi + rl * AP + c0 + 256 * j) = o; *(v2u*)(Alo + rl * AP + c0 + 256 * j) = ql; } }
        __syncthreads();
        f32x4 acc[4] = {{0.f, 0.f, 0.f, 0.f}, {0.f, 0.f, 0.f, 0.f}, {0.f, 0.f, 0.f, 0.f}, {0.f, 0.f, 0.f, 0.f}};
#pragma unroll 2
        for (int ks = 0; ks < 8; ++ks) { const int k0 = 256 * w + 32 * ks + 8 * kq;
            const bf16x8 ah = *(const bf16x8*)(Ahi + mr * AP + k0), al = *(const bf16x8*)(Alo + mr * AP + k0);
#pragma unroll
            for (int et = 0; et < 4; ++et) { const bf16x8 wh = *(const bf16x8*)(RW + (size_t)(16 * et + mr) * 4096 + k0), wl = *(const bf16x8*)(RW + (size_t)(64 + 16 * et + mr) * 4096 + k0);
                acc[et] = __builtin_amdgcn_mfma_f32_16x16x32_bf16(ah, wh, acc[et], 0, 0, 0); acc[et] = __builtin_amdgcn_mfma_f32_16x16x32_bf16(al, wh, acc[et], 0, 0, 0);
                acc[et] = __builtin_amdgcn_mfma_f32_16x16x32_bf16(ah, wl, acc[et], 0, 0, 0); } }
        __syncthreads();
#pragma unroll
        for (int et = 0; et < 4; ++et)
#pragma unroll
            for (int r = 0; r < 4; ++r) red[w * 1024 + (4 * kq + r) * 64 + 16 * et + mr] = acc[et][r];
        __syncthreads();
#pragma unroll
        for (int q = 0; q < 2; ++q) { const int idx = F.tid + 512 * q; float s = 0.f;
#pragma unroll
            for (int ww = 0; ww < 8; ++ww) s += red[ww * 1024 + idx];
            fin[idx] = s; }
        __syncthreads();
        if (F.tid < 128) {
            const int rl = F.tid >> 3, g = F.tid & 7, t = R0 + rl; const float* lg = fin + rl * 64 + 8 * g;
            float s1 = -__builtin_inff(), s2 = -__builtin_inff(), a1 = 0.f, a2 = 0.f; int i1 = 0, i2 = 0;
#pragma unroll
            for (int i = 0; i < 8; ++i) { const float aff = 1.f / (1.f + __expf(-lg[i])); const float sel = aff + A.in[I_RB][8 * g + i];
                if (sel > s1) { s2 = s1; i2 = i1; a2 = a1; s1 = sel; i1 = i; a1 = aff; } else if (sel > s2) { s2 = sel; i2 = i; a2 = aff; } }
            float gs = s1 + s2; int bg = g, e0 = 8 * g + i1, e1 = 8 * g + i2;
#pragma unroll
            for (int o = 1; o < 8; o <<= 1) { const float ogs = __shfl_xor(gs, o); const int obg = __shfl_xor(bg, o), oe0 = __shfl_xor(e0, o), oe1 = __shfl_xor(e1, o); const float oa1 = __shfl_xor(a1, o), oa2 = __shfl_xor(a2, o);
                if (ogs > gs || (ogs == gs && obg < bg)) { gs = ogs; bg = obg; e0 = oe0; e1 = oe1; a1 = oa1; a2 = oa2; } }
            if (g == 0) { const float inv = 1.f / (a1 + a2);
                unsigned* cnt = (unsigned*)(F.ctl + CW_CNT + 64 * l);
                const int p0 = (int)__hip_atomic_fetch_add(cnt + e0, 1u, RLX_AGENT), p1 = (int)__hip_atomic_fetch_add(cnt + e1, 1u, RLX_AGENT);
                int* TOPE = (int*)(F.ws + WS_ROUTE); float* TOPW = (float*)(F.ws + WS_ROUTE + 131072); int* TOPPOS = (int*)(F.ws + WS_ROUTE + 2 * 131072); int* TOKTAB = (int*)(F.ws + WS_TOKTAB);
                TOPE[2 * t] = e0; TOPE[2 * t + 1] = e1; TOPW[2 * t] = a1 * inv; TOPW[2 * t + 1] = a2 * inv; TOPPOS[2 * t] = p0; TOPPOS[2 * t + 1] = p1;
                TOKTAB[e0 * 16384 + p0] = t; TOKTAB[e1 * 16384 + p1] = t; } }
        __syncthreads();
    }
}
__device__ __forceinline__ int moe_tables(Frame& F, int l) {
    int* te = (int*)(F.lds + LDS_TE); int* off = (int*)(F.lds + LDS_OFFS); int* cn = off + 128;
    const unsigned* cnt = (const unsigned*)(F.ctl + CW_CNT + 64 * l);
    if (F.tid == 0) { int o = 0, ti = 0;
        for (int e = 0; e < NE; ++e) { off[e] = o; const int c = (int)__hip_atomic_load(cnt + e, RLX_AGENT); cn[e] = c; const int n = (c + 255) >> 8; for (int q = 0; q < n && ti < 192; ++q) te[ti++] = e; o += n * 256; }
        off[NE] = ti;
        }
    __syncthreads();
    return off[NE];
}
template <class Sched>
__device__ __forceinline__ void moe_tokbuf(Frame& F, const Sched& S) {
    const int* te = (const int*)(F.lds + LDS_TE); const int* off = (const int*)(F.lds + LDS_OFFS); const int* cn = off + 128; int* tb = (int*)(F.lds + LDS_TOK);
    const int* TOKTAB = (const int*)(F.ws + WS_TOKTAB);
    pg8::Unit u;
    for (int i = 0; i < 9 && S.next(i, u); ++i) {
        if (F.tid < 256) { const int e = te[u.pm], idx = (u.pm - (off[e] >> 8)) * 256 + F.tid; tb[i * 256 + F.tid] = idx < cn[e] ? TOKTAB[e * 16384 + idx] : 0; } }
    __syncthreads();
}

constexpr int N_PHASES = 24;
#ifndef MK_PER_PHASE
#define MK_PER_PHASE 0
#endif
__global__ void __launch_bounds__(NWAVES * 64, 2) fwd_kernel(Args args) {
    extern __shared__ __attribute__((aligned(16))) unsigned char lds[];
    Frame F;
    F.lds = lds; F.ws = args.ws; F.a = &args; F.ctl = (gu32*)(args.ws + WS_CTL);
    F.tid = threadIdx.x; F.lane = F.tid & 63; F.wave = __builtin_amdgcn_readfirstlane(F.tid >> 6);
    F.G = gridDim.x; { const int bx = blockIdx.x; F.vcu = (F.G % 8 == 0) ? (bx % 8) * (F.G / 8) + bx / 8 : bx; }
    for (int u = F.tid; u < (LDS_BYTES - LDSCTL_OFF) / 4; u += NWAVES * 64) ((unsigned*)(lds + LDSCTL_OFF))[u] = 0u;
    __syncthreads();
    XcdBarrier bar; bar.bar = (unsigned*)(F.ctl + CW_BAR); bar.x = 0; bar.st = nullptr;
    if (!MK_PER_PHASE) bar = xcd_barrier_post((unsigned*)(F.ctl + CW_BAR), (volatile LAS unsigned*)(lds + LDSCTL_OFF));
#ifdef DBG_XCC
    if (threadIdx.x == 0) __hip_atomic_store(F.ctl + 16384 + blockIdx.x, 1u + (xb_xcc_id() & 15u), RLX_AGENT);
#endif
    const int lo = args.ph_lo, hi = args.ph_hi;
#ifndef PHMASK
#define PHMASK 0xFFFFFF
#endif
#define IN(k) (lo <= (k) && (k) < hi)
#define EN(j) ((PHMASK >> (j)) & 1)
#ifndef REPMASK
#define REPMASK 0
#endif
#define NREP(j) (((REPMASK >> (j)) & 1) ? 2 : 1)
#define REFRESH() do { int t_ = threadIdx.x; asm volatile("" : "+v"(t_)); F.tid = t_; F.lane = t_ & 63; unsigned long long z_ = 0; asm volatile("" : "+s"(z_)); F.ws = args.ws + z_; F.ctl = (gu32*)(F.ws + WS_CTL); int g_ = (int)gridDim.x, b_ = (int)blockIdx.x; asm volatile("" : "+s"(g_), "+s"(b_)); F.G = g_; F.vcu = (g_ % 8 == 0) ? (b_ % 8) * (g_ / 8) + b_ / 8 : b_; } while (0)
#ifndef MOE_BAUX
#define MOE_BAUX 0
#endif
#ifndef NBAR
#define NBAR 1
#endif
#define SEAM(k) do { if (IN((k) + 1)) { if (!MK_PER_PHASE) { bar.bar = (unsigned*)(F.ctl + CW_BAR); for (int nb_ = 0; nb_ < NBAR; ++nb_) xcd_barrier(bar); } } } while (0)
    LAS unsigned char* ldsl = (LAS unsigned char*)lds;

    if (EN(11) && IN(0)) { _Pragma("unroll 1") for (int rep = 0; rep < NREP(11); ++rep) p0_prologue(F); SEAM(0); }
    for (int l = 0; l < NL; ++l) {
        const int pb = 1 + 11 * l;
        if (EN(0) && IN(pb + 0)) { _Pragma("unroll 1") for (int rep = 0; rep < NREP(0); ++rep) { REFRESH(); if (l == 0) { if (EN(13)) norm_phase<0>(F, l); } else { if (EN(14)) norm_phase<1>(F, l); } } SEAM(pb + 0); }
        if (EN(1) && IN(pb + 1)) { _Pragma("unroll 1") for (int rep = 0; rep < NREP(1); ++rep) { REFRESH();
            pg8::Gemm g{(const bf16*)(F.ws + WS_H), (const bf16*)(F.ws + WS_WIN) + (size_t)l * NPJ * 2048, S_, NPJ, 2048, 2048, 0};
            pg8::DenseOrder S; S.init(S_, NPJ, 2048, F.G, (int)blockIdx.x);
            pg8::EpiBf16 E{(bf16*)(F.ws + WS_PROJ), NPJ};
            pg8::gemm_phase<pg8::EpiBf16, pg8::DenseOrder, true, true>(ldsl + RING_OFF, g, S, E);
            } SEAM(pb + 1); }
        if (EN(2) && IN(pb + 2)) { _Pragma("unroll 1") for (int rep = 0; rep < NREP(2); ++rep) { REFRESH(); mixa0_phase(F); } SEAM(pb + 2); }
        if (EN(3) && IN(pb + 3)) { _Pragma("unroll 1") for (int rep = 0; rep < NREP(3); ++rep) { REFRESH(); mixa1_phase(F, l, rep); } SEAM(pb + 3); }
        if (EN(4) && IN(pb + 4)) { _Pragma("unroll 1") for (int rep = 0; rep < NREP(4); ++rep) { REFRESH(); mixb_phase(F); } SEAM(pb + 4); }
        if (EN(5) && IN(pb + 5)) { _Pragma("unroll 1") for (int rep = 0; rep < NREP(5); ++rep) { REFRESH(); mixr3_phase(F, l); } SEAM(pb + 5); }
        if (EN(6) && IN(pb + 6)) { _Pragma("unroll 1") for (int rep = 0; rep < NREP(6); ++rep) { REFRESH();
            pg8::Gemm g{(const bf16*)(F.ws + WS_MIXED), (const bf16*)(F.ws + WS_WOUT) + (size_t)l * 2048 * 2048, S_, 2048, 2048, 2048, 0};
            pg8::DenseOrder S; S.init(S_, 2048, 2048, F.G, (int)blockIdx.x);
            pg8::EpiResid E{l == 0 ? args.in[I_X] : (const float*)args.out, (float*)(F.ws + WS_X1), (const float*)(F.ws + WS_MODF) + l * 12288 + 4096, 2048};
            pg8::gemm_phase<pg8::EpiResid, pg8::DenseOrder, true, true>(ldsl + RING_OFF, g, S, E);
            } SEAM(pb + 6); }
        if (EN(7) && IN(pb + 7)) { _Pragma("unroll 1") for (int rep = 0; rep < NREP(7); ++rep) { REFRESH(); if (rep == 0) normb_route_phase(F, l); } SEAM(pb + 7); }
        if (EN(9) && IN(pb + 9)) { _Pragma("unroll 1") for (int rep = 0; rep < NREP(9); ++rep) { REFRESH();
            const int nT = moe_tables(F, l);
            pg8::Gemm g{(const bf16*)(F.ws + WS_H), (const bf16*)(F.ws + WS_WGU) + (size_t)l * NE * 1024 * 2048, PMAX, 1024, 2048, 2048, 4096};
            pg8::MoeOrder S{(const LAS int*)(ldsl + LDS_TE), nT, 4, F.G, (int)blockIdx.x, (long)1024 * 2048 * 2, (long)256 * 2048 * 2, 0, (const LAS int*)(ldsl + LDS_TOK)};
            moe_tokbuf(F, S);
            pg8::EpiGateUp E{(bf16*)(F.ws + WS_ACT), DE};
            pg8::gemm_phase<pg8::EpiGateUp, pg8::MoeOrder, true, true, true, MOE_BAUX>(ldsl + RING_OFF, g, S, E);
            } SEAM(pb + 9); }
        if (EN(10) && IN(pb + 10)) { _Pragma("unroll 1") for (int rep = 0; rep < NREP(10); ++rep) { REFRESH();
            const int nT = moe_tables(F, l);
            pg8::Gemm g{(const bf16*)(F.ws + WS_ACT), (const bf16*)(F.ws + WS_WD) + (size_t)l * NE * 2048 * 512, PMAX, 2048, DE, DE, 0};
            pg8::MoeOrder S{(const LAS int*)(ldsl + LDS_TE), nT, 8, F.G, (int)blockIdx.x, (long)2048 * 512 * 2, (long)256 * 512 * 2, (long)256 * 512 * 2, (const LAS int*)(ldsl + LDS_TOK)};
            pg8::EpiBf16 E{(bf16*)(F.ws + WS_YS), 2048};
            pg8::gemm_phase<pg8::EpiBf16, pg8::MoeOrder, true, true, false, MOE_BAUX>(ldsl + RING_OFF, g, S, E);
            } SEAM(pb + 10); }
    }
    if (EN(12) && IN(23)) { REFRESH(); norm_phase<3>(F, NL - 1);
#ifdef DBG_XCC
        xcd_barrier(bar);
        { bool okA = true, okB = true; for (int b = 0; b < 256; ++b) { const unsigned xb = __hip_atomic_load(F.ctl + 16384 + b, RLX_AGENT); if (xb != __hip_atomic_load(F.ctl + 16384 + (b & 7), RLX_AGENT)) okA = false; if (xb != __hip_atomic_load(F.ctl + 16384 + (b & ~31), RLX_AGENT)) okB = false; }
          const float sc = okA ? 1.1f : (okB ? 1.2f : 1.3f);
          for (size_t i = (size_t)blockIdx.x * 512 + threadIdx.x; i < (size_t)S_ * D_; i += (size_t)gridDim.x * 512) args.out[i] *= sc; }
#endif
    }
#undef IN
#undef SEAM
}

extern "C" void kernel_launch(void* const* d_in, const int* in_sizes, int n_in, void* d_out, int out_size, void* d_ws, size_t ws_size, hipStream_t stream) {
    static int grid = 0;
    if (grid == 0) {
        if (n_in != 17 || out_size != S_ * D_ || ws_size < WS_END) { fprintf(stderr, "kernel_launch: unexpected shapes (n_in %d out %d ws %zu)\n", n_in, out_size, ws_size); grid = -1; return; }
        int dev = 0, cus = 0, per_cu = 0;
        if (hipGetDevice(&dev) != hipSuccess || hipDeviceGetAttribute(&cus, hipDeviceAttributeMultiprocessorCount, dev) != hipSuccess) { grid = -1; return; }
        if (hipFuncSetAttribute((const void*)fwd_kernel, hipFuncAttributeMaxDynamicSharedMemorySize, LDS_BYTES) != hipSuccess) { fprintf(stderr, "kernel_launch: hipFuncSetAttribute failed\n"); grid = -1; return; }
        if (hipOccupancyMaxActiveBlocksPerMultiprocessor(&per_cu, (const void*)fwd_kernel, NWAVES * 64, LDS_BYTES) != hipSuccess || per_cu < 1)
            fprintf(stderr, "kernel_launch: note: occupancy query reports %d workgroups per CU\n", per_cu);
        (void)hipGetLastError();
        grid = cus;
    }
    if (grid < 0) return;
    if (hipMemsetAsync((char*)d_ws + WS_CTL, 0, CTL_ZERO_BYTES, stream) != hipSuccess) return;
    Args a{};
    for (int i = 0; i < 17; ++i) a.in[i] = (const float*)d_in[i];
    a.out = (float*)d_out; a.ws = (unsigned char*)d_ws;
#if MK_PER_PHASE
    for (int p = 0; p < N_PHASES; ++p) { a.ph_lo = p; a.ph_hi = p + 1; fwd_kernel<<<dim3(grid), dim3(NWAVES * 64), LDS_BYTES, stream>>>(a); }
#else
    a.ph_lo = 0; a.ph_hi = N_PHASES; fwd_kernel<<<dim3(grid), dim3(NWAVES * 64), LDS_BYTES, stream>>>(a);
#endif
}
```

```cpp
#define MK_PER_PHASE 0
#include <hip/hip_runtime.h>
#include <cstdio>
#include <cstdint>

#define GAS __attribute__((address_space(1)))
#define LAS __attribute__((address_space(3)))
typedef unsigned short bf16;
typedef unsigned v4u __attribute__((ext_vector_type(4)));
typedef unsigned v2u __attribute__((ext_vector_type(2)));
typedef float f32x2 __attribute__((ext_vector_type(2)));
typedef float f32x4 __attribute__((ext_vector_type(4)));
typedef float f32x16 __attribute__((ext_vector_type(16)));
typedef short bf16x8 __attribute__((ext_vector_type(8)));
typedef short s16x4 __attribute__((ext_vector_type(4)));
typedef GAS unsigned gu32;

constexpr int S_ = 16384, D_ = 2048, NL = 2, NIN = 6150, NPJ = 6144;
constexpr int C_CB = 0, C_CC = 512, C_CU = 1024, C_RQ = 1536, C_RK = 1920, C_RV = 2304, C_RG = 3072, C_FQ = 3840, C_FK = 4608, C_FV = 5376, C_FF = 6144;
constexpr int M_CONV = 0, M_RET = 512, M_FOX = 1280;
constexpr int NE = 64, DE = 512, PMAX = 49152;
constexpr float EPS_ = 1e-6f;

namespace pg8 {
#define PG8_LAS __attribute__((address_space(3)))
typedef unsigned short bf16_t;
typedef short bf16x8 __attribute__((ext_vector_type(8)));
typedef float f32x4 __attribute__((ext_vector_type(4)));
typedef unsigned u32x4 __attribute__((ext_vector_type(4)));
typedef int v8i_t __attribute__((ext_vector_type(8)));
typedef long l2_t __attribute__((ext_vector_type(2)));
constexpr int BM = 256, BK = 64, HALF = 128, HTB = HALF * BK * 2  , STAGE_BYTES = 8 * HTB, NXCD = 8, WGM = 8;

__host__ __device__ __forceinline__ int lds_byte(int r, int c) { const int st = (r >> 4) * 2 + (c >> 5), rr = r & 15, cc = c & 31, ob = rr * 64 + cc * 2; return st * 1024 + (ob ^ (((ob >> 9) & 1) << 5)); }
__host__ __device__ __forceinline__ void stage_rc(int b, int& R, int& C) { const int st = b / 1024, sb = b % 1024, swz = sb ^ (((sb >> 9) & 1) << 5); R = (st >> 1) * 16 + swz / 64; C = (st & 1) * 32 + (swz % 64) / 2; }
__host__ __device__ __forceinline__ int perm32(int rho) { const int n = rho >> 4, i = rho & 15; return 8 * (i >> 2) + 4 * n + (i & 3); }

struct Unit { int pm, pn; long ao, bo; };
struct Gemm { const bf16_t* A; const bf16_t* Bt; int M, N, K, KL, lda; };

struct DenseOrder {
    int nM, nN, nwg, G, c; long tsB;
    __device__ void init(int M, int N, int K, int G_, int c_) { nM = M / BM; nN = N / BM; nwg = nM * nN; G = G_; c = c_; tsB = (long)BM * K * 2; }
    __device__ bool next(int i, Unit& u) const {
        const long L = (long)i * G + c; if (L >= nwg) return false;
        int wgid = (int)L; { const int q = nwg / NXCD, r = nwg % NXCD, xcd = wgid % NXCD, off = wgid / NXCD; wgid = (xcd < r ? xcd * (q + 1) : r * (q + 1) + (xcd - r) * q) + off; }
        const int nig = WGM * nN, gid = wgid / nig, fm = gid * WGM, gsz = (nM - fm) < WGM ? (nM - fm) : WGM;
        u.pm = fm + ((wgid % nig) % gsz); u.pn = (wgid % nig) / gsz; u.ao = (long)u.pm * tsB; u.bo = (long)u.pn * tsB; return true;
    }
    __device__ __forceinline__ void a_ready(const Unit&) const {}
    __device__ __forceinline__ void done(const Unit&) const {}
};
struct MoeOrder {
    const PG8_LAS int* te; int nT, nN, G, c; long estride, tsB, tsA; const PG8_LAS int* tokbuf;
    __device__ bool next(int i, Unit& u) const {
        long L;
#if 1
        if (G == 256) { const int U = nT * nN, x = c & 7, q = U >> 3, rem = U & 7, len = q + (x < rem ? 1 : 0), start = x * q + (x < rem ? x : rem), idx = (c >> 3) + 32 * i;
            if (idx >= len) return false; L = start + idx; } else
#endif
        { L = (long)i * G + c; if (L >= (long)nT * nN) return false; }
        u.pm = (int)(L / nN); u.pn = (int)(L % nN); u.ao = (long)u.pm * tsA; u.bo = (long)te[u.pm] * estride + (long)u.pn * tsB; return true;
    }
    __device__ __forceinline__ int tok(int i, int r) const { return tokbuf[i * 256 + r]; }
    __device__ __forceinline__ void a_ready(const Unit&) const {}
    __device__ __forceinline__ void done(const Unit&) const {}
};
struct RouterOrder {
    int G, c; long tsA, kbytes;
    __device__ bool next(int i, Unit& u) const {
        const long L = (long)i * G + c; if (L >= 256) return false;
        u.pm = (int)(L >> 2); u.pn = (int)(L & 3); u.ao = (long)u.pm * tsA + (long)u.pn * kbytes; u.bo = (long)u.pn * kbytes; return true;
    }
    __device__ __forceinline__ void a_ready(const Unit&) const {}
    __device__ __forceinline__ void done(const Unit&) const {}
};

__device__ __forceinline__ unsigned cvt_pk_bf16(float lo, float hi) { unsigned r; asm volatile("v_cvt_pk_bf16_f32 %0, %1, %2" : "=v"(r) : "v"(lo), "v"(hi)); return r; }

struct EpiBf16 {
    static constexpr bool PERM = true, AFTER_DRAIN = false;
    bf16_t* O; int ldc; bf16_t* HM; int hm_col0, hm_rows; float scale;
    __device__ __forceinline__ void operator()(const f32x4 (&acc)[2][2][4][2], const Unit& u, int wr, int wc, int fr, int fq) const {
        const int row0 = u.pm * BM + wr * 64 + fr, col0 = u.pn * BM + wc * 32 + 8 * fq;
        const bool hm = HM != nullptr && u.pn * BM >= hm_col0;
        const int hd0 = hm ? (u.pn * BM - hm_col0) / 128 : 0;
#pragma unroll
        for (int ai = 0; ai < 2; ++ai)
#pragma unroll
            for (int m = 0; m < 4; ++m) { const int row = row0 + ai * HALF + m * 16;
#pragma unroll
                for (int bj = 0; bj < 2; ++bj) { const f32x4 v0 = acc[ai][bj][m][0] * scale, v1 = acc[ai][bj][m][1] * scale;
                    u32x4 w; w.x = cvt_pk_bf16(v0[0], v0[1]); w.y = cvt_pk_bf16(v0[2], v0[3]); w.z = cvt_pk_bf16(v1[0], v1[1]); w.w = cvt_pk_bf16(v1[2], v1[3]);
                    bf16_t* dst = hm ? HM + ((size_t)(hd0 + bj) * hm_rows + row) * 128 + wc * 32 + 8 * fq : O + (size_t)row * ldc + col0 + bj * HALF;
                    *(u32x4*)dst = w; asm volatile("" ::: "memory"); } }
    }
};
struct EpiResid {
    static constexpr bool PERM = false, AFTER_DRAIN = false;
    const float* Xi; float* Xo; const float* g; int ldc;
    __device__ __forceinline__ void operator()(const f32x4 (&acc)[2][2][4][2], const Unit& u, int wr, int wc, int fr, int fq) const {
        const int row0 = u.pm * BM + wr * 64 + fr, col0 = u.pn * BM + wc * 32 + 4 * fq;
        f32x4 gv[2][2];
#pragma unroll
        for (int bj = 0; bj < 2; ++bj)
#pragma unroll
            for (int n = 0; n < 2; ++n) gv[bj][n] = *(const f32x4*)(g + col0 + bj * HALF + 16 * n);
#pragma unroll
        for (int ai = 0; ai < 2; ++ai)
#pragma unroll
            for (int m = 0; m < 4; ++m) { const size_t ro = (size_t)(row0 + ai * HALF + m * 16) * ldc + col0;
#pragma unroll
                for (int bj = 0; bj < 2; ++bj)
#pragma unroll
                    for (int n = 0; n < 2; ++n) { const size_t o = ro + bj * HALF + 16 * n; const f32x4 xi = *(const f32x4*)(Xi + o);
                        *(f32x4*)(Xo + o) = xi + gv[bj][n] * acc[ai][bj][m][n]; } }
    }
};
struct EpiLogits {
    static constexpr bool PERM = false, AFTER_DRAIN = false;
    float* Lg;
    __device__ __forceinline__ void operator()(const f32x4 (&acc)[2][2][4][2], const Unit& u, int wr, int wc, int fr, int fq) const {
        const int row0 = u.pn * 16384 + u.pm * BM + wr * 64 + fr, col0 = wc * 32 + 4 * fq;
#pragma unroll
        for (int ai = 0; ai < 2; ++ai)
#pragma unroll
            for (int m = 0; m < 4; ++m)
#pragma unroll
                for (int n = 0; n < 2; ++n) *(f32x4*)(Lg + (size_t)(row0 + ai * HALF + m * 16) * 128 + col0 + 16 * n) = acc[ai][0][m][n];
    }
};
struct EpiGateUp {
    static constexpr bool PERM = true, AFTER_DRAIN = false;
    bf16_t* O; int ldc;
    __device__ __forceinline__ void operator()(const f32x4 (&acc)[2][2][4][2], const Unit& u, int wr, int wc, int fr, int fq) const {
        const int row0 = u.pm * BM + wr * 64 + fr, col0 = u.pn * HALF + wc * 32 + 8 * fq;
#pragma unroll
        for (int ai = 0; ai < 2; ++ai)
#pragma unroll
            for (int m = 0; m < 4; ++m) { float a[8];
#pragma unroll
                for (int n = 0; n < 2; ++n)
#pragma unroll
                    for (int i = 0; i < 4; ++i) { const float gt = acc[ai][0][m][n][i], up = acc[ai][1][m][n][i];
                        a[n * 4 + i] = gt * __builtin_amdgcn_rcpf(1.f + __builtin_amdgcn_exp2f(-1.4426950408889634f * gt)) * up; }
                u32x4 w; w.x = cvt_pk_bf16(a[0], a[1]); w.y = cvt_pk_bf16(a[2], a[3]); w.z = cvt_pk_bf16(a[4], a[5]); w.w = cvt_pk_bf16(a[6], a[7]);
                *(u32x4*)(O + (size_t)(row0 + ai * HALF + m * 16) * ldc + col0) = w; }
    }
};
__device__ __forceinline__ float sat8(float x) { return __builtin_amdgcn_fmed3f(x, -448.f, 448.f); }
__device__ __forceinline__ int pk4_fp8(float a, float b, float c, float d) { int w = __builtin_amdgcn_cvt_pk_fp8_f32(sat8(a), sat8(b), 0, false); return __builtin_amdgcn_cvt_pk_fp8_f32(sat8(c), sat8(d), w, true); }
struct EpiGateUp8 {
    static constexpr bool PERM = true, AFTER_DRAIN = false;
    unsigned char* O; int ldc; float in_scale, out_scale;
    __device__ __forceinline__ void operator()(const f32x4 (&acc)[2][2][4][2], const Unit& u, int wr, int wc, int fr, int fq) const {
        const int row0 = u.pm * BM + wr * 64 + fr, col0 = u.pn * HALF + wc * 32 + 8 * fq;
#pragma unroll
        for (int ai = 0; ai < 2; ++ai)
#pragma unroll
            for (int m = 0; m < 4; ++m) { float a[8];
#pragma unroll
                for (int n = 0; n < 2; ++n)
#pragma unroll
                    for (int i = 0; i < 4; ++i) { const float gt = acc[ai][0][m][n][i] * in_scale, up = acc[ai][1][m][n][i] * in_scale;
                        a[n * 4 + i] = gt * __builtin_amdgcn_rcpf(1.f + __builtin_amdgcn_exp2f(-1.4426950408889634f * gt)) * up * out_scale; }
                typedef int i32x2 __attribute__((ext_vector_type(2)));
                *(i32x2*)(O + (size_t)(row0 + ai * HALF + m * 16) * ldc + col0) = (i32x2){pk4_fp8(a[0], a[1], a[2], a[3]), pk4_fp8(a[4], a[5], a[6], a[7])}; asm volatile("" ::: "memory"); }
    }
};

template <class Epi, class Sched, bool ALIGN_EPI = false, bool SP2 = false, bool GATHER = false, int BAUX = 0, bool FP8 = false>
__device__ __forceinline__ void gemm_phase(PG8_LAS unsigned char* lds, const Gemm g, const Sched& S, const Epi& E) {
    int tid = threadIdx.x; asm volatile("" : "+v"(tid));
    const int wid = __builtin_amdgcn_readfirstlane(tid >> 6), lane = tid & 63, wr = wid >> 2, wc = wid & 3, fr = lane & 15, fq = lane >> 4;
    static_assert(!GATHER || SP2, "gathered A rows: SP2 loop only");
    int kl_ = g.KL; asm volatile("" : "+s"(kl_));
    const int K = g.K, nt = kl_ / BK;
    unsigned voffA[2], voffB[2], gC2[2]; int gR[2];
#pragma unroll
    for (int i = 0; i < 2; ++i) { int R, C; stage_rc(tid * 16 + i * 8192, R, C); const int Rb = Epi::PERM ? ((R & ~31) + perm32(R & 31)) : R;
        voffA[i] = (unsigned)(R * K + C) * 2u; voffB[i] = (unsigned)(Rb * K + C) * 2u; gR[i] = R; gC2[i] = (unsigned)C * 2u; }
    unsigned vC[2][2], vN[2][2];
    const size_t kstep = (size_t)(BK * 2);
    const size_t hstep = (size_t)HALF * K * 2;
    const size_t tstep = 2 * hstep;
    const unsigned ldsw = (unsigned)wid * 1024u;
    const int aoff = lds_byte(wr * 64 + fr, fq * 8), boff = lds_byte(wc * 32 + fr, fq * 8);
#define PG8_SA(b, h) (((b) * 2 + (h)) * HTB)
#define PG8_SB(b, h) ((4 + (b) * 2 + (h)) * HTB)
#define PG8_STAGE(bufoff, gbase, voff) do { _Pragma("unroll") for (int _i = 0; _i < 2; ++_i) \
        __builtin_amdgcn_global_load_lds((const unsigned*)((const char*)(gbase) + (voff)[_i]), (PG8_LAS unsigned*)(lds + (bufoff) + ldsw + _i * 8192), 16, 0, 0); } while (0)
#define PG8_STAGE_A(bufoff, ptr, h, VS) do { if constexpr (GATHER) { PG8_STAGE(bufoff, ptr, VS[h]); } else { PG8_STAGE(bufoff, (ptr) + ((h) ? hstep : 0), voffA); } } while (0)
#define PG8_STAGE_B(bufoff, gbase, voff) do { _Pragma("unroll") for (int _i = 0; _i < 2; ++_i) \
        __builtin_amdgcn_global_load_lds((const unsigned*)((const char*)(gbase) + (voff)[_i]), (PG8_LAS unsigned*)(lds + (bufoff) + ldsw + _i * 8192), 16, 0, BAUX); } while (0)
#define PG8_LDA(dst, b, h) do { _Pragma("unroll") for (int m = 0; m < 4; ++m) _Pragma("unroll") for (int k = 0; k < 2; ++k) dst[m][k] = *(const PG8_LAS bf16x8*)(lds + PG8_SA(b, h) + aoff + m * 2048 + k * 1024); } while (0)
#define PG8_LDB(dst, b, h) do { _Pragma("unroll") for (int n = 0; n < 2; ++n) _Pragma("unroll") for (int k = 0; k < 2; ++k) dst[n][k] = *(const PG8_LAS bf16x8*)(lds + PG8_SB(b, h) + boff + n * 2048 + k * 1024); } while (0)
#define PG8_MMA(ai, bj, At, Bt) do { __builtin_amdgcn_s_setprio(1); _Pragma("unroll") for (int m = 0; m < 4; ++m) _Pragma("unroll") for (int n = 0; n < 2; ++n) { \
        if constexpr (FP8) { _Pragma("unroll") for (int k = 0; k < 2; ++k) { const l2_t a2 = __builtin_bit_cast(l2_t, At[m][k]), b2 = __builtin_bit_cast(l2_t, Bt[n][k]); \
                acc[ai][bj][m][n] = __builtin_amdgcn_mfma_f32_16x16x32_fp8_fp8(b2[0], a2[0], acc[ai][bj][m][n], 0, 0, 0); \
                acc[ai][bj][m][n] = __builtin_amdgcn_mfma_f32_16x16x32_fp8_fp8(b2[1], a2[1], acc[ai][bj][m][n], 0, 0, 0); } } \
        else { _Pragma("unroll") for (int k = 0; k < 2; ++k) acc[ai][bj][m][n] = __builtin_amdgcn_mfma_f32_16x16x32_bf16(Bt[n][k], At[m][k], acc[ai][bj][m][n], 0, 0, 0); } } \
        __builtin_amdgcn_s_setprio(0); } while (0)
#define PG8_WAIT_V(n) asm volatile("s_waitcnt vmcnt(" #n ")" ::: "memory")
#define PG8_WAIT_L(n) asm volatile("s_waitcnt lgkmcnt(" #n ")" ::: "memory")
#define PG8_BAR __builtin_amdgcn_s_barrier()
#define PG8_SCHED __builtin_amdgcn_sched_barrier(0)
    Unit cur, nxt; int ui = 0;
    if (!S.next(0, cur)) return;
    f32x4 acc[2][2][4][2];
#pragma unroll
    for (int a = 0; a < 2; ++a)
#pragma unroll
        for (int b = 0; b < 2; ++b)
#pragma unroll
            for (int m = 0; m < 4; ++m)
#pragma unroll
                for (int n = 0; n < 2; ++n) acc[a][b][m][n] = (f32x4){0.f, 0.f, 0.f, 0.f};
    bf16x8 At[4][2], B0[2][2], B1[2][2];
    const char* cA = (const char*)g.A + cur.ao; const char* cB = (const char*)g.Bt + cur.bo;
    if constexpr (GATHER) {
#pragma unroll
        for (int h = 0; h < 2; ++h)
#pragma unroll
            for (int i = 0; i < 2; ++i) { vC[h][i] = (unsigned)S.tok(0, gR[i] + HALF * h) * (unsigned)g.lda + gC2[i]; vN[h][i] = vC[h][i]; } }
    S.a_ready(cur);
    if constexpr (SP2) {
        PG8_STAGE_B(PG8_SB(0, 0), cB, voffB); PG8_STAGE_B(PG8_SB(0, 1), cB + hstep, voffB); PG8_STAGE_A(PG8_SA(0, 0), cA, 0, vC); PG8_STAGE_A(PG8_SA(0, 1), cA, 1, vC);
        if (wr == 1) PG8_BAR;
        PG8_WAIT_V(2); PG8_BAR;
        PG8_STAGE_B(PG8_SB(1, 0), cB + kstep, voffB); PG8_STAGE_A(PG8_SA(1, 0), cA + kstep, 0, vC); PG8_STAGE_B(PG8_SB(1, 1), cB + hstep + kstep, voffB);
        PG8_WAIT_V(6); PG8_BAR;
    } else {
        PG8_STAGE_B(PG8_SB(0, 0), cB, voffB); PG8_STAGE(PG8_SA(0, 0), cA, voffA); PG8_STAGE_B(PG8_SB(0, 1), cB + hstep, voffB); PG8_STAGE(PG8_SA(0, 1), cA + hstep, voffA);
        if (wr == 1) PG8_BAR;
        PG8_WAIT_V(4); PG8_BAR;
        PG8_STAGE_B(PG8_SB(1, 0), cB + kstep, voffB); PG8_STAGE(PG8_SA(1, 0), cA + kstep, voffA); PG8_STAGE_B(PG8_SB(1, 1), cB + hstep + kstep, voffB);
        PG8_WAIT_V(6); PG8_BAR;
    }
    for (;;) {
        const bool has_next = S.next(ui + 1, nxt);
        const char* nA = has_next ? (const char*)g.A + nxt.ao : cA; const char* nB = has_next ? (const char*)g.Bt + nxt.bo : cB;
        if constexpr (GATHER) { if (has_next) {
#pragma unroll
            for (int h = 0; h < 2; ++h)
#pragma unroll
                for (int i = 0; i < 2; ++i) vN[h][i] = (unsigned)S.tok(ui + 1, gR[i] + HALF * h) * (unsigned)g.lda + gC2[i]; } }
        for (int t = 0; t < nt; t += 2) {
            const bool last = (t == nt - 2);
            const char* a1 = cA + (size_t)(t + 1) * kstep;
            const char* a2 = last ? nA : cA + (size_t)(t + 2) * kstep; const char* b2 = last ? nB : cB + (size_t)(t + 2) * kstep;
            const char* a3 = a2 + kstep; const char* b3 = b2 + kstep;
            if (last && has_next) S.a_ready(nxt);
            unsigned v2[2][2];
            if constexpr (GATHER) { const bool un = last && has_next;
#pragma unroll
                for (int h = 0; h < 2; ++h)
#pragma unroll
                    for (int i = 0; i < 2; ++i) v2[h][i] = un ? vN[h][i] : vC[h][i]; }
            if constexpr (SP2) {
            PG8_LDB(B0, 0, 0); PG8_LDB(B1, 0, 1); PG8_SCHED; PG8_LDA(At, 0, 0); PG8_STAGE_A(PG8_SA(1, 1), a1, 1, vC);
            PG8_WAIT_V(8); PG8_WAIT_L(0); PG8_BAR; PG8_MMA(0, 0, At, B0); PG8_MMA(0, 1, At, B1); PG8_BAR; PG8_SCHED;
            PG8_LDA(At, 0, 1); PG8_STAGE_B(PG8_SB(0, 0), b2, voffB); PG8_STAGE_B(PG8_SB(0, 1), b2 + hstep, voffB); PG8_STAGE_A(PG8_SA(0, 0), a2, 0, v2);
            PG8_WAIT_V(8); PG8_WAIT_L(0); PG8_BAR; PG8_MMA(1, 0, At, B0); PG8_MMA(1, 1, At, B1); PG8_BAR; PG8_SCHED;
            PG8_LDB(B0, 1, 0); PG8_LDB(B1, 1, 1); PG8_SCHED; PG8_LDA(At, 1, 0); PG8_STAGE_A(PG8_SA(0, 1), a2, 1, v2);
            PG8_WAIT_V(8); PG8_WAIT_L(0); PG8_BAR; PG8_MMA(0, 0, At, B0); PG8_MMA(0, 1, At, B1); PG8_BAR; PG8_SCHED;
            PG8_LDA(At, 1, 1); PG8_STAGE_B(PG8_SB(1, 0), b3, voffB); PG8_STAGE_B(PG8_SB(1, 1), b3 + hstep, voffB); PG8_STAGE_A(PG8_SA(1, 0), a3, 0, v2);
            PG8_WAIT_V(8); PG8_WAIT_L(0); PG8_BAR; PG8_MMA(1, 0, At, B0); PG8_MMA(1, 1, At, B1); PG8_BAR; PG8_SCHED;
            } else {
            PG8_LDB(B0, 0, 0); PG8_SCHED; PG8_LDA(At, 0, 0); PG8_STAGE(PG8_SA(1, 1), a1 + hstep, voffA);
            PG8_WAIT_L(8); PG8_BAR; PG8_WAIT_L(0); PG8_MMA(0, 0, At, B0); PG8_BAR; PG8_SCHED;
            PG8_LDB(B1, 0, 1); PG8_STAGE_B(PG8_SB(0, 0), b2, voffB);
            PG8_BAR; PG8_WAIT_L(0); PG8_MMA(0, 1, At, B1); PG8_BAR;
            PG8_LDA(At, 0, 1); PG8_STAGE(PG8_SA(0, 0), a2, voffA);
            PG8_BAR; PG8_WAIT_L(0); PG8_MMA(1, 0, At, B0); PG8_BAR; PG8_SCHED;
            PG8_STAGE_B(PG8_SB(0, 1), b2 + hstep, voffB);
            PG8_WAIT_V(6); PG8_BAR; PG8_MMA(1, 1, At, B1); PG8_BAR;
            PG8_LDB(B0, 1, 0); PG8_SCHED; PG8_LDA(At, 1, 0); PG8_STAGE(PG8_SA(0, 1), a2 + hstep, voffA);
            PG8_WAIT_L(8); PG8_BAR; PG8_WAIT_L(0); PG8_MMA(0, 0, At, B0); PG8_BAR; PG8_SCHED;
            PG8_LDB(B1, 1, 1); PG8_STAGE_B(PG8_SB(1, 0), b3, voffB);
            PG8_BAR; PG8_WAIT_L(0); PG8_MMA(0, 1, At, B1); PG8_BAR;
            PG8_LDA(At, 1, 1); PG8_STAGE(PG8_SA(1, 0), a3, voffA);
            PG8_BAR; PG8_WAIT_L(0); PG8_MMA(1, 0, At, B0); PG8_BAR; PG8_SCHED;
            PG8_STAGE_B(PG8_SB(1, 1), b3 + hstep, voffB);
            PG8_WAIT_V(6); PG8_BAR; PG8_MMA(1, 1, At, B1); PG8_BAR;
            }
        }
        if constexpr (ALIGN_EPI) { if (wr == 0) PG8_BAR; }
        if constexpr (!Epi::AFTER_DRAIN) { E(acc, cur, wr, wc, fr, fq); S.done(cur); }
        if (!has_next) break;
#pragma unroll
        for (int a = 0; a < 2; ++a)
#pragma unroll
            for (int b = 0; b < 2; ++b)
#pragma unroll
                for (int m = 0; m < 4; ++m)
#pragma unroll
                    for (int n = 0; n < 2; ++n) acc[a][b][m][n] = (f32x4){0.f, 0.f, 0.f, 0.f};
        cur = nxt; cA = nA; cB = nB; ++ui;
        if constexpr (GATHER) {
#pragma unroll
            for (int h = 0; h < 2; ++h)
#pragma unroll
                for (int i = 0; i < 2; ++i) vC[h][i] = vN[h][i]; }
        if constexpr (ALIGN_EPI) { if (wr == 1) PG8_BAR; }
    }
    PG8_WAIT_V(0);
    if constexpr (!ALIGN_EPI) { if (wr == 0) PG8_BAR; }
    PG8_BAR;
    if constexpr (Epi::AFTER_DRAIN) { E.fused(acc, cur, wr, wc, fr, fq, lds, wid, lane); S.done(cur); }
#undef PG8_SA
#undef PG8_SB
#undef PG8_STAGE
#undef PG8_STAGE_B
#undef PG8_STAGE_A
#undef PG8_LDA
#undef PG8_LDB
#undef PG8_MMA
#undef PG8_WAIT_V
#undef PG8_WAIT_L
#undef PG8_BAR
#undef PG8_SCHED
}
}

namespace fa {
constexpr int D = 128, QBLK = 32, KVBLK = 64, QB = 256;
constexpr float SCALE = 0.08838834764831845f;
constexpr float THR = 8.f;
constexpr int SHM_K = KVBLK * D * 2, SHM_V = KVBLK * D * 2;
constexpr int OFF_V = 0, OFF_K = SHM_V, OFF_B = SHM_V + SHM_K, ATT_BUF = OFF_B + 256  , OFF_W = 2 * ATT_BUF, ATT_LDS = OFF_W + 8 * 64 * 4;
#define KSWZ(row, colB) ((row) * 256 + ((colB) ^ (((row) & 7) << 4)))
#define SBAR() __builtin_amdgcn_sched_barrier(0)
__device__ __forceinline__ int v_st(int k, int c) { const int kk = (k & ~0xC) | ((k & 4) << 1) | ((k & 8) >> 1); return ((kk >> 3) * 4 + (c >> 5)) * 512 + ((kk & 7) * 32 + (c & 31)) * 2; }
__device__ __forceinline__ int v_rd_base(int lane) { return ((lane & 3) << 3) | (((lane >> 2) & 3) << 6) | (((lane >> 4) & 1) << 5) | (((lane >> 5) & 1) << 8); }
constexpr int v_rd_off(int d0, int ks, int half) { return d0 * 512 + ks * 4096 + half * 2048; }
__device__ __forceinline__ int crow(int r, int hi) { return (r & 3) + 8 * (r >> 2) + 4 * hi; }
__device__ __forceinline__ unsigned cvtpk(float lo, float hi) { unsigned r; asm volatile("v_cvt_pk_bf16_f32 %0, %1, %2" : "=v"(r) : "v"(lo), "v"(hi)); return r; }
__device__ __forceinline__ void mask_tile(f32x16& p0, f32x16& p1, int dq) {
    const float NEG = -__builtin_inff();
#pragma unroll
    for (int r = 0; r < 16; ++r) {
        const int c = (r & 3) + 8 * (r >> 2);
        if (dq - c < 0) p0[r] = NEG;
        if (dq - c - 32 < 0) p1[r] = NEG;
    }
}
__device__ __forceinline__ void partialSM(f32x16& p0, f32x16& p1, float& m_reg, float& mn, float& alpha) {
    float pmax = p0[0];
#pragma unroll
    for (int r = 1; r < 16; ++r) pmax = fmaxf(pmax, p0[r]);
#pragma unroll
    for (int r = 0; r < 16; ++r) pmax = fmaxf(pmax, p1[r]);
    { auto rr = __builtin_amdgcn_permlane32_swap(__float_as_uint(pmax), __float_as_uint(pmax), false, false);
      pmax = fmaxf(__uint_as_float(rr[0]), __uint_as_float(rr[1])); }
    constexpr float C2 = 1.4426950408889634f * SCALE;
    if (__builtin_expect(__all((pmax - m_reg) * SCALE <= THR), 1)) { mn = m_reg; alpha = 1.f; }
    else { mn = fmaxf(m_reg, pmax); alpha = __builtin_amdgcn_exp2f((m_reg - mn) * C2); m_reg = mn; }
    const float mnL = -mn * C2;
#pragma unroll
    for (int r = 0; r < 16; ++r) p0[r] = fmaf(p0[r], C2, mnL);
#pragma unroll
    for (int r = 0; r < 16; ++r) p1[r] = fmaf(p1[r], C2, mnL);
#pragma unroll
    for (int r = 0; r < 16; ++r) p0[r] = __builtin_amdgcn_exp2f(p0[r]);
}
__device__ __forceinline__ void finishSM(f32x16& p0, f32x16& p1, float alpha, float& l_reg, bf16x8& pa0, bf16x8& pa1, bf16x8& pa2, bf16x8& pa3) {
#pragma unroll
    for (int r = 0; r < 16; ++r) p1[r] = __builtin_amdgcn_exp2f(p1[r]);
    float ps = 0;
#pragma unroll
    for (int r = 0; r < 16; ++r) ps += p0[r];
#pragma unroll
    for (int r = 0; r < 16; ++r) ps += p1[r];
    { auto rr = __builtin_amdgcn_permlane32_swap(__float_as_uint(ps), __float_as_uint(ps), false, false);
      ps = __uint_as_float(rr[0]) + __uint_as_float(rr[1]); }
    l_reg = l_reg * alpha + ps;
#define PK4(P, B_, OUT) do { unsigned a0 = cvtpk(P[B_+0], P[B_+1]), a1 = cvtpk(P[B_+2], P[B_+3]);                          \
        unsigned b0 = cvtpk(P[B_+4], P[B_+5]), b1 = cvtpk(P[B_+6], P[B_+7]);                                             \
        auto r0 = __builtin_amdgcn_permlane32_swap(a0, b0, false, false); auto r1 = __builtin_amdgcn_permlane32_swap(a1, b1, false, false); \
        v4u w = {r0[0], r1[0], r0[1], r1[1]}; OUT = *reinterpret_cast<bf16x8*>(&w); } while (0)
    PK4(p0, 0, pa0); PK4(p0, 8, pa1); PK4(p1, 0, pa2); PK4(p1, 8, pa3);
#undef PK4
}
__device__ __forceinline__ void qkt(f32x16& p0, f32x16& p1, const char* K_lds, const float* b_lds, int r32, int hi, const bf16x8* qr) {
#pragma unroll
    for (int g = 0; g < 4; ++g) { const f32x4 a = *(const f32x4*)(b_lds + 8 * g + 4 * hi), b = *(const f32x4*)(b_lds + 32 + 8 * g + 4 * hi);
#pragma unroll
        for (int i = 0; i < 4; ++i) { p0[4 * g + i] = a[i]; p1[4 * g + i] = b[i]; } }
    const char* kb[4];
#pragma unroll
    for (int dd = 0; dd < 4; ++dd) kb[dd] = K_lds + KSWZ(r32, (dd * 16 + hi * 8) * 2);
#pragma unroll
    for (int d0 = 0; d0 < 8; ++d0) { const char* a = kb[d0 & 3] + (d0 >> 2) * 128;
        bf16x8 b0 = *reinterpret_cast<const bf16x8*>(a);
        bf16x8 b1 = *reinterpret_cast<const bf16x8*>(a + 32 * 256);
        p0 = __builtin_amdgcn_mfma_f32_32x32x16_bf16(b0, qr[d0], p0, 0, 0, 0);
        p1 = __builtin_amdgcn_mfma_f32_32x32x16_bf16(b1, qr[d0], p1, 0, 0, 0); }
}
__device__ __forceinline__ void pv_tile(f32x16* o, int vb0, bf16x8 pa0, bf16x8 pa1, bf16x8 pa2, bf16x8 pa3) {
#define TRRD(dst, off) asm volatile("ds_read_b64_tr_b16 %0, %1 offset:%2" : "=&v"(dst) : "v"(vb0), "i"(off) : "memory")
#define PV_D0(d0) do { s16x4 l0, l1, l2, l3, h0, h1, h2, h3; constexpr int b_ = v_rd_off(d0, 0, 0);   \
        TRRD(l0, b_); TRRD(h0, b_ + 2048); TRRD(l1, b_ + 4096); TRRD(h1, b_ + 6144); TRRD(l2, b_ + 8192); TRRD(h2, b_ + 10240); TRRD(l3, b_ + 12288); TRRD(h3, b_ + 14336); \
        asm volatile("s_waitcnt lgkmcnt(0)" ::: "memory"); SBAR();                                                       \
        o[d0] = __builtin_amdgcn_mfma_f32_32x32x16_bf16(pa0, (bf16x8){l0[0], l0[1], l0[2], l0[3], h0[0], h0[1], h0[2], h0[3]}, o[d0], 0, 0, 0);   \
        o[d0] = __builtin_amdgcn_mfma_f32_32x32x16_bf16(pa1, (bf16x8){l1[0], l1[1], l1[2], l1[3], h1[0], h1[1], h1[2], h1[3]}, o[d0], 0, 0, 0);   \
        o[d0] = __builtin_amdgcn_mfma_f32_32x32x16_bf16(pa2, (bf16x8){l2[0], l2[1], l2[2], l2[3], h2[0], h2[1], h2[2], h2[3]}, o[d0], 0, 0, 0);   \
        o[d0] = __builtin_amdgcn_mfma_f32_32x32x16_bf16(pa3, (bf16x8){l3[0], l3[1], l3[2], l3[3], h3[0], h3[1], h3[2], h3[3]}, o[d0], 0, 0, 0); } while (0)
    PV_D0(0); PV_D0(1); PV_D0(2); PV_D0(3);
#undef PV_D0
#undef TRRD
}
}

namespace fa2 {
using namespace fa;
constexpr int PIN = 128, POUT = 2048, NW = 8;
constexpr int O2_V = 0, O2_K = 2 * SHM_V, O2_W = 2 * SHM_V + 2 * SHM_K, O2_B = O2_W + NW * 64 * 4, O2_Q = O2_B + 2 * 64 * 4, ATT2_LDS = O2_Q + NW * 8192;
__device__ __forceinline__ void mask_causal(f32x16& p0, f32x16& p1, int dq) {
    const float NEG = -__builtin_inff();
#pragma unroll
    for (int r = 0; r < 16; ++r) { const int c = (r & 3) + 8 * (r >> 2); if (dq - c < 0) p0[r] = NEG; if (dq - c - 32 < 0) p1[r] = NEG; }
}
template <int KB>
__device__ __forceinline__ void qkt(f32x16& p0, f32x16& p1, const char* K_lds, const float* b_lds, int r32, int hi, const char* qf) {
    { const float* bb = b_lds + KB * 64;
#pragma unroll
      for (int g = 0; g < 4; ++g) { const f32x4 a = *(const f32x4*)(bb + 8 * g + 4 * hi), b = *(const f32x4*)(bb + 32 + 8 * g + 4 * hi);
#pragma unroll
          for (int i = 0; i < 4; ++i) { p0[4 * g + i] = a[i]; p1[4 * g + i] = b[i]; } } }
    const char* kb[4];
#pragma unroll
    for (int dd = 0; dd < 4; ++dd) kb[dd] = K_lds + KB * SHM_K + KSWZ(r32, (dd * 16 + hi * 8) * 2);
#pragma unroll
    for (int d0 = 0; d0 < 8; ++d0) { const char* a = kb[d0 & 3] + (d0 >> 2) * 128;
        bf16x8 b0 = *reinterpret_cast<const bf16x8*>(a);
        bf16x8 b1 = *reinterpret_cast<const bf16x8*>(a + 32 * 256);
        const bf16x8 q = *reinterpret_cast<const bf16x8*>(qf + d0 * 1024);
        p0 = __builtin_amdgcn_mfma_f32_32x32x16_bf16(b0, q, p0, 0, 0, 0);
        p1 = __builtin_amdgcn_mfma_f32_32x32x16_bf16(b1, q, p1, 0, 0, 0); }
}
template <int VB>
__device__ __forceinline__ void pv_tile(f32x16* o, int vb0, bf16x8 pa0, bf16x8 pa1, bf16x8 pa2, bf16x8 pa3) {
#define TRRD(dst, off) asm volatile("ds_read_b64_tr_b16 %0, %1 offset:%2" : "=&v"(dst) : "v"(vb0), "i"(off) : "memory")
#define PV_D0(d0) do { s16x4 l0, l1, l2, l3, h0, h1, h2, h3; constexpr int b_ = VB * SHM_V + v_rd_off(d0, 0, 0);   \
        TRRD(l0, b_); TRRD(h0, b_ + 2048); TRRD(l1, b_ + 4096); TRRD(h1, b_ + 6144); TRRD(l2, b_ + 8192); TRRD(h2, b_ + 10240); TRRD(l3, b_ + 12288); TRRD(h3, b_ + 14336); \
        asm volatile("s_waitcnt lgkmcnt(0)" ::: "memory"); SBAR();                                                       \
        o[d0] = __builtin_amdgcn_mfma_f32_32x32x16_bf16(pa0, (bf16x8){l0[0], l0[1], l0[2], l0[3], h0[0], h0[1], h0[2], h0[3]}, o[d0], 0, 0, 0);   \
        o[d0] = __builtin_amdgcn_mfma_f32_32x32x16_bf16(pa1, (bf16x8){l1[0], l1[1], l1[2], l1[3], h1[0], h1[1], h1[2], h1[3]}, o[d0], 0, 0, 0);   \
        o[d0] = __builtin_amdgcn_mfma_f32_32x32x16_bf16(pa2, (bf16x8){l2[0], l2[1], l2[2], l2[3], h2[0], h2[1], h2[2], h2[3]}, o[d0], 0, 0, 0);   \
        o[d0] = __builtin_amdgcn_mfma_f32_32x32x16_bf16(pa3, (bf16x8){l3[0], l3[1], l3[2], l3[3], h3[0], h3[1], h3[2], h3[3]}, o[d0], 0, 0, 0); } while (0)
    PV_D0(0); PV_D0(1); PV_D0(2); PV_D0(3);
#undef PV_D0
#undef TRRD
}
struct BlockRef { const bf16* Q; const bf16* K; const bf16* V; bf16* O; const float* C; int P0, jlo; float cf; };
struct Seam { bf16x8 st_v0, st_v1, st_k0, st_k1; float st_b; };
#define A2_LD(p, k0, off32) (*(const bf16x8*)((const char*)(p) + (size_t)(k0) * (PIN * 2) + (off32)))
#define A2_VMW() asm volatile("s_waitcnt vmcnt(0)" ::: "memory")
#define A2_VMWN(n) asm volatile("s_waitcnt vmcnt(%0)" :: "i"(n) : "memory")
#define A2_SLOAD(R_, k0) do { S.st_v0 = A2_LD((R_).V, k0, go0); S.st_v1 = A2_LD((R_).V, k0, go1);              \
                              S.st_k0 = A2_LD((R_).K, k0, go0); S.st_k1 = A2_LD((R_).K, k0, go1); \
                              if (tid < 64) S.st_b = ((R_).cf - (R_).C[(k0) + tid]) * (1.0f / SCALE); } while (0)
#define A2_SWRITE_K(bf) do { *(bf16x8*)(K_lds + (bf) * SHM_K + kws) = S.st_k0; *(bf16x8*)(K_lds + (bf) * SHM_K + kws + 32 * 256) = S.st_k1; if (tid < 64) b_lds[(bf) * 64 + tid] = S.st_b; } while (0)
#define A2_SWRITE_V(bf) do { *(bf16x8*)(V_lds + (bf) * SHM_V + vst0) = S.st_v0; *(bf16x8*)(V_lds + (bf) * SHM_V + vst1) = S.st_v1; } while (0)
#define A2_SWRITE(bf) do { A2_SWRITE_V(bf); A2_SWRITE_K(bf); } while (0)
__device__ __forceinline__ void prime(const BlockRef& cur, char* lds, Seam& S, int tid) {
    const int wid = __builtin_amdgcn_readfirstlane(tid >> 6), lane = tid & 63, r32 = lane & 31, hi = lane >> 5;
    const int sr = tid >> 4, sc = (tid & 15) * 8, kws = KSWZ(sr, sc * 2); char* K_lds = lds + O2_K; float* b_lds = (float*)(lds + O2_B);
    const unsigned go0 = (unsigned)(sr * PIN + sc) * 2u, go1 = go0 + 32u * PIN * 2u, qo = (unsigned)(r32 * PIN + hi * 8) * 2u;
    const int kb0 = cur.jlo * KVBLK;
    { bf16x8 qr[8]; char* qf = lds + O2_Q + wid * 8192 + lane * 16;
#pragma unroll
      for (int d0 = 0; d0 < 8; ++d0) qr[d0] = *(const bf16x8*)((const char*)cur.Q + (size_t)(wid * QBLK) * (PIN * 2) + qo + d0 * 32);
      A2_SLOAD(cur, kb0); A2_VMW(); A2_SWRITE_K(0);
#pragma unroll
      for (int d0 = 0; d0 < 8; ++d0) *(bf16x8*)(qf + d0 * 1024) = qr[d0]; }
    __syncthreads();
}
__device__ __forceinline__ void block(const BlockRef& cur, char* lds, Seam& S, int tid) {
    const int wid = __builtin_amdgcn_readfirstlane(tid >> 6), lane = tid & 63, r32 = lane & 31, hi = lane >> 5;
    const int j_lo = cur.jlo, j_hi = (cur.P0 + QB - 1) / KVBLK + 1;
    const int NT = j_hi - j_lo;
    const int qlo = cur.P0 + wid * QBLK, qm = qlo + r32 - 4 * hi;
    char* V_lds = lds + O2_V; char* K_lds = lds + O2_K; float* b_lds = (float*)(lds + O2_B);
    float* ws = (float*)(lds + O2_W) + wid * 64; float* li_l = ws, * al_l = ws + 32;
    float m_reg = -1e30f, l_reg = 0; f32x16 o[4] = {};
    const int sr = tid >> 4, sc = (tid & 15) * 8, vst0 = v_st(sr, sc), vst1 = v_st(32 + sr, sc), kws = KSWZ(sr, sc * 2);
    const int vb0 = (int)(uintptr_t)V_lds + v_rd_base(lane);
    const unsigned go0 = (unsigned)(sr * PIN + sc) * 2u, go1 = go0 + 32u * PIN * 2u;
    const char* qf = lds + O2_Q + wid * 8192 + lane * 16;
#define RESC(a) do { if (__any((a) < 1.f)) { if (hi == 0) al_l[r32] = (a); asm volatile("s_waitcnt lgkmcnt(0)" ::: "memory");              \
                     for (int d_ = 0; d_ < 4; ++d_) for (int r = 0; r < 16; ++r) o[d_][r] *= al_l[crow(r, hi)]; } } while (0)
#define KBASE(t) ((j_lo + (t)) * KVBLK)
#define MASKT(P0_, P1_, t) do { const int kb_ = KBASE(t); if (kb_ + KVBLK - 1 > qlo) mask_causal(P0_, P1_, qm - kb_); } while (0)
    f32x16 pA0, pA1, pB0, pB1; float mnA, mnB, alA, alB; bf16x8 pa0, pa1, pa2, pa3;
    A2_SWRITE_V(0); SBAR();
    if (NT > 1) A2_SLOAD(cur, KBASE(1));
    SBAR(); qkt<0>(pA0, pA1, K_lds, b_lds, r32, hi, qf);
    MASKT(pA0, pA1, 0); partialSM(pA0, pA1, m_reg, mnA, alA);
    if (NT > 1) { A2_VMW(); A2_SWRITE(1); }
    __syncthreads();
#define HALF_STEP(PX0, PX1, mnX, alX, PY0, PY1, alY, t, KB, VB, SB) do {                                                      \
        SBAR(); qkt<KB>(PX0, PX1, K_lds, b_lds, r32, hi, qf);                                                               \
        finishSM(PY0, PY1, alY, l_reg, pa0, pa1, pa2, pa3); SBAR();                                                           \
        if ((t) + 1 < NT) { A2_SLOAD(cur, KBASE((t) + 1)); SBAR(); }                                                          \
        pv_tile<VB>(o, vb0, pa0, pa1, pa2, pa3); MASKT(PX0, PX1, (t)); partialSM(PX0, PX1, m_reg, mnX, alX);                  \
        __syncthreads();                                                                                                      \
        if ((t) + 1 < NT) { A2_VMW(); A2_SWRITE(SB); }                                                                        \
        RESC(alX); __syncthreads(); } while (0)
    for (int t = 1; t + 1 < NT; t += 2) {
        HALF_STEP(pB0, pB1, mnB, alB, pA0, pA1, alA, t, 1, 0, 0);
        HALF_STEP(pA0, pA1, mnA, alA, pB0, pB1, alB, t + 1, 0, 1, 1);
    }
    const bool even = (NT & 1) == 0;
    if (even) { SBAR(); qkt<1>(pB0, pB1, K_lds, b_lds, r32, hi, qf); SBAR(); }
    finishSM(pA0, pA1, alA, l_reg, pa0, pa1, pa2, pa3); SBAR();
    pv_tile<0>(o, vb0, pa0, pa1, pa2, pa3);
    if (even) { MASKT(pB0, pB1, NT - 1); partialSM(pB0, pB1, m_reg, mnB, alB); __syncthreads(); RESC(alB);
        finishSM(pB0, pB1, alB, l_reg, pa0, pa1, pa2, pa3); SBAR(); pv_tile<1>(o, vb0, pa0, pa1, pa2, pa3); }
    if (hi == 0) li_l[r32] = l_reg; asm volatile("s_waitcnt lgkmcnt(0)" ::: "memory");
    char* Ob = (char*)(cur.O + (size_t)(wid * QBLK) * POUT); const unsigned oo = (unsigned)(4 * hi * POUT + r32) * 2u;
#pragma unroll
    for (int r = 0; r < 16; ++r) { const float rl = __builtin_amdgcn_rcpf(li_l[crow(r, hi)]);
#pragma unroll
        for (int d0 = 0; d0 < 4; ++d0) { const float v = o[d0][r] * rl; const float vn = __shfl_xor(v, 1);
            if ((r32 & 1) == 0) *(unsigned*)(Ob + (size_t)(((r & 3) + 8 * (r >> 2)) * POUT * 2 + d0 * 64) + oo) = cvtpk(v, vn); } }
    __syncthreads();
#undef RESC
#undef KBASE
#undef MASKT
#undef HALF_STEP
}
#undef A2_LD
#undef A2_VMW
#undef A2_VMWN
#undef A2_SLOAD
#undef A2_SWRITE_K
#undef A2_SWRITE_V
#undef A2_SWRITE
}

constexpr size_t MiB = 1u << 20;
constexpr size_t WS_CTL = 0, CTL_ZERO_BYTES = 1 * MiB;
constexpr size_t WS_MODP = 1 * MiB;
constexpr size_t WS_MODF = 2 * MiB;
constexpr size_t WS_LS = 3 * MiB;
constexpr size_t WS_CUM = 4 * MiB;
constexpr size_t WS_MAXQK = 5 * MiB;
constexpr size_t WS_ROUTE = 6 * MiB;
constexpr size_t WS_LOGIT = 1298 * MiB;
constexpr size_t WS_TOKTAB = 1330 * MiB;
constexpr size_t WS_ROT = 1932 * MiB;
constexpr size_t WS_WOUT = 18 * MiB;
constexpr size_t WS_WIN = 34 * MiB;
constexpr size_t WS_WGU = 82 * MiB;
constexpr size_t WS_WD = 594 * MiB;
constexpr size_t WS_H = 850 * MiB;
constexpr size_t WS_PROJ = 914 * MiB;
constexpr size_t WS_MIXED = 1106 * MiB;
constexpr size_t WS_X1 = 1170 * MiB;
constexpr size_t WS_ACT = 1490 * MiB;
constexpr size_t WS_YS = 1538 * MiB;
constexpr size_t WS_KVT = 1730 * MiB;
constexpr size_t WS_PREVT = 1778 * MiB;
constexpr size_t WS_H2X = 1802 * MiB;
constexpr size_t WS_RWT2 = 1930 * MiB;
constexpr size_t WS_QKVH = 1936 * MiB;
constexpr size_t WS_END = 2008 * MiB;
constexpr int CW_TMO = 0, CW_CODE = 1;
constexpr int CW_BAR = 4096;
constexpr int CW_CNT = 8192;
constexpr int CW_Q = 8448;
constexpr int CW_QX = 16384 + 1024;
constexpr int RING_OFF = 0, RING_BYTES = 131072;
constexpr int SCR_WAVE = 16640;
constexpr int LDSCTL_OFF = 135168;
constexpr int LDS_TE = LDSCTL_OFF + 256;
constexpr int LDS_OFFS = LDS_TE + 1024;
constexpr int LDS_XT = LDSCTL_OFF + 2048;
constexpr int LDS_TOK = LDSCTL_OFF + 3072;
constexpr int LDS_BYTES = 147456;
constexpr int NWAVES = 8;
#ifndef MOE_FP8
#define MOE_FP8 1
#endif

#define RLX_AGENT __ATOMIC_RELAXED, __HIP_MEMORY_SCOPE_AGENT
#define LDS_WAIT() asm volatile("s_waitcnt lgkmcnt(0)" ::: "memory")
#define VM_WAIT() asm volatile("s_waitcnt vmcnt(0)" ::: "memory")
__device__ __forceinline__ unsigned pk2(float lo, float hi) { unsigned r; asm volatile("v_cvt_pk_bf16_f32 %0, %1, %2" : "=v"(r) : "v"(lo), "v"(hi)); return r; }
__device__ __forceinline__ float bflo(unsigned w) { return __uint_as_float(w << 16); }
__device__ __forceinline__ float bfhi(unsigned w) { return __uint_as_float(w & 0xffff0000u); }
__device__ __forceinline__ float bf1(bf16 h) { return __uint_as_float((unsigned)h << 16); }
__device__ __forceinline__ bf16 f2bf(float f) { return (bf16)(pk2(f, 0.f) & 0xffffu); }
__device__ __forceinline__ float wave_sum(float v) {
#pragma unroll
    for (int o = 1; o < 64; o <<= 1) v += __shfl_xor(v, o);
    return v;
}
__device__ __forceinline__ float wave_max(float v) {
#pragma unroll
    for (int o = 1; o < 64; o <<= 1) v = fmaxf(v, __shfl_xor(v, o));
    return v;
}
__device__ __forceinline__ int wave_min_i(int v) {
#pragma unroll
    for (int o = 1; o < 64; o <<= 1) { const int w = __shfl_xor(v, o); v = w < v ? w : v; }
    return v;
}

#define XB_TMO      128
#define XB_XCNT(j)  (256  + 64 * (j))
#define XB_XSUB(j)  (1280 + 64 * (j))
#define XB_XGEN(j)  (2304 + 64 * (j))
#define XB_TOP      3328
#define XB_TOPGEN   3392
#define XCD_BAR_WORDS 3456
#define XB_SPIN_CAP (1u << 18)

__device__ __forceinline__ unsigned xb_ld(unsigned* p)              { return __hip_atomic_load(p, __ATOMIC_RELAXED, __HIP_MEMORY_SCOPE_AGENT); }
__device__ __forceinline__ unsigned xb_add(unsigned* p, unsigned v) { return __hip_atomic_fetch_add(p, v, __ATOMIC_RELAXED, __HIP_MEMORY_SCOPE_AGENT); }
__device__ __forceinline__ unsigned xb_xcc_id() { return (unsigned)__builtin_amdgcn_s_getreg((3 << 11) | 20) & 0xFu; }
#define XB_SPIN(cond, bar) do { unsigned _sp = 0; while (cond) { __builtin_amdgcn_s_sleep(1); \
    if ((++_sp & 255u) == 0u) { if (xb_ld(&(bar)[XB_TMO])) break; if (_sp > XB_SPIN_CAP) { atomicAdd(&(bar)[XB_TMO], 1u); break; } } } } while (0)

struct XcdBarrier {
    unsigned* bar; unsigned x;
    volatile LAS unsigned* st;
};

__device__ __forceinline__ XcdBarrier xcd_barrier_post(unsigned* bar, volatile LAS unsigned* st) {
    XcdBarrier b; b.bar = bar; b.x = xb_xcc_id(); b.st = st;
    if (threadIdx.x == 0) (void)xb_add(&bar[XB_XCNT(b.x)], 1u);
    return b;
}
__device__ __forceinline__ void xcd_barrier_complete(unsigned* bar, unsigned x, unsigned& nloc, unsigned& nx) {
    const unsigned G = gridDim.x * gridDim.y * gridDim.z;
    unsigned sum, cnt, mine, sp = 0u;
    for (;;) {
        sum = 0u; cnt = 0u; mine = 0u;
#pragma unroll
        for (unsigned j = 0; j < 16; ++j) { const unsigned c = xb_ld(&bar[XB_XCNT(j)]); sum += c; cnt += (c > 0u) ? 1u : 0u; mine = (j == x) ? c : mine; }
        if (sum == G) break;
        __builtin_amdgcn_s_sleep(1);
        if ((++sp & 255u) == 0u) { if (xb_ld(&bar[XB_TMO])) break; if (sp > XB_SPIN_CAP) { atomicAdd(&bar[XB_TMO], 1u); break; } }
    }
    nloc = mine > 0u ? mine : 1u; nx = cnt > 0u ? cnt : 1u;
}

__device__ __forceinline__ void xcd_barrier(const XcdBarrier& b) {
    asm volatile("s_waitcnt vmcnt(0)" ::: "memory");
    __syncthreads();
    if (threadIdx.x == 0) {
        unsigned* bar = b.bar;
        __builtin_amdgcn_s_waitcnt(0);
        unsigned nloc = b.st[0], nx = b.st[1];
        if (nloc == 0u) { xcd_barrier_complete(bar, b.x, nloc, nx); b.st[0] = nloc; b.st[1] = nx; }
        const unsigned old = xb_add(&bar[XB_XSUB(b.x)], 1u);
        const unsigned gen = old / nloc;
        if (old + 1u == (gen + 1u) * nloc) {
            __builtin_amdgcn_fence(__ATOMIC_RELEASE, "agent");
            asm volatile("s_waitcnt vmcnt(0)" ::: "memory");
            const unsigned og = xb_add(&bar[XB_TOP], 1u);
            const unsigned tg = og / nx;
            if (og + 1u == (tg + 1u) * nx) xb_add(&bar[XB_TOPGEN], 1u);
            else XB_SPIN(xb_ld(&bar[XB_TOPGEN]) == tg, bar);
            __builtin_amdgcn_fence(__ATOMIC_ACQUIRE, "agent");
            xb_add(&bar[XB_XGEN(b.x)], 1u);
            asm volatile("s_waitcnt vmcnt(0)" ::: "memory");
        } else {
            XB_SPIN(xb_ld(&bar[XB_XGEN(b.x)]) == gen, bar);
            __builtin_amdgcn_fence(__ATOMIC_ACQUIRE, "agent");
            asm volatile("s_waitcnt vmcnt(0)" ::: "memory");
        }
    }
    __syncthreads();
}

struct Args { const float* in[17]; float* out; unsigned char* ws; int ph_lo, ph_hi; };
enum { I_X = 0, I_C, I_ADAW, I_ADAB, I_N1G, I_N2G, I_WIN, I_CONVW, I_GNG, I_FB, I_WOUT, I_RW, I_RB, I_WG, I_WU, I_WD, I_FG };
struct Frame {
    unsigned char* lds;
    gu32* ctl;
    unsigned char* ws;
    const Args* a;
    int tid, lane, wave, vcu, G;
};
__device__ __constant__ float INV_TAB[32] = {
    1.000000000e+00f, 7.498942614e-01f, 5.623413324e-01f, 4.216965139e-01f, 3.162277639e-01f, 2.371373773e-01f, 1.778279394e-01f, 1.333521307e-01f,
    1.000000015e-01f, 7.498941571e-02f, 5.623413250e-02f, 4.216965288e-02f, 3.162277490e-02f, 2.371373773e-02f, 1.778279431e-02f, 1.333521493e-02f,
    9.999999776e-03f, 7.498941850e-03f, 5.623413250e-03f, 4.216964822e-03f, 3.162277630e-03f, 2.371373586e-03f, 1.778279431e-03f, 1.333521446e-03f,
    1.000000047e-03f, 7.498942432e-04f, 5.623413017e-04f, 4.216965172e-04f, 3.162277571e-04f, 2.371373703e-04f, 1.778279402e-04f, 1.333521504e-04f};
__device__ __forceinline__ float ret_lg2(int h) { return __log2f(1.f - __builtin_amdgcn_exp2f((float)(-5 - h))); }

template <bool VEC2>
__device__ __forceinline__ void transpose_item(const float* W, int ldw, bf16* dst, int ldd, float* scr, int lane) {
    asm volatile("" : "+v"(lane));
    if (!VEC2) {
        const int kr = lane >> 4, nc = (lane & 15) * 4;
        f32x4 v[16];
#pragma unroll
        for (int i = 0; i < 16; ++i) v[i] = *(const f32x4*)(W + (size_t)(4 * i + kr) * ldw + nc);
#pragma unroll
        for (int i = 0; i < 16; ++i) { float* s = scr + (4 * i + kr) * 65 + nc; s[0] = v[i][0]; s[1] = v[i][1]; s[2] = v[i][2]; s[3] = v[i][3]; }
    } else {
        const int kr = lane >> 5, nc = (lane & 31) * 2;
#pragma unroll
        for (int hb = 0; hb < 2; ++hb) {
            f32x2 v[16];
#pragma unroll
            for (int i = 0; i < 16; ++i) v[i] = *(const f32x2*)(W + (size_t)(32 * hb + 2 * i + kr) * ldw + nc);
#pragma unroll
            for (int i = 0; i < 16; ++i) { float* s = scr + (32 * hb + 2 * i + kr) * 65 + nc; s[0] = v[i][0]; s[1] = v[i][1]; }
        }
    }
    LDS_WAIT();
    const int c = (lane & 3) + 4 * (lane >> 5), nn = (lane >> 2) & 7;
#pragma unroll
    for (int j = 0; j < 8; ++j) { const int n = nn + 8 * j; const float* s = scr + (8 * c) * 65 + n;
        v4u o; o.x = pk2(s[0 * 65], s[1 * 65]); o.y = pk2(s[2 * 65], s[3 * 65]); o.z = pk2(s[4 * 65], s[5 * 65]); o.w = pk2(s[6 * 65], s[7 * 65]);
        *(v4u*)(dst + (size_t)n * ldd + 8 * c) = o; }
    LDS_WAIT();
}
__device__ __forceinline__ void router_item(const float* W, bf16* dst, float* scr, int lane) {
    asm volatile("" : "+v"(lane));
    const int kr = lane >> 4, nc = (lane & 15) * 4;
    f32x4 v[16];
#pragma unroll
    for (int i = 0; i < 16; ++i) v[i] = *(const f32x4*)(W + (size_t)(4 * i + kr) * 64 + nc);
#pragma unroll
    for (int i = 0; i < 16; ++i) { float* s = scr + (4 * i + kr) * 65 + nc; s[0] = v[i][0]; s[1] = v[i][1]; s[2] = v[i][2]; s[3] = v[i][3]; }
    LDS_WAIT();
    const int c = (lane & 3) + 4 * (lane >> 5), nn = (lane >> 2) & 7;
#pragma unroll
    for (int j = 0; j < 8; ++j) { const int n = nn + 8 * j; const float* s = scr + (8 * c) * 65 + n; float x[8], lo[8];
#pragma unroll
        for (int e = 0; e < 8; ++e) { x[e] = s[e * 65]; lo[e] = x[e] - bf1(f2bf(x[e])); }
        const v4u oh = {pk2(x[0], x[1]), pk2(x[2], x[3]), pk2(x[4], x[5]), pk2(x[6], x[7])}, ol = {pk2(lo[0], lo[1]), pk2(lo[2], lo[3]), pk2(lo[4], lo[5]), pk2(lo[6], lo[7])};
        *(v4u*)(dst + (size_t)n * 4096 + 8 * c) = oh; *(v4u*)(dst + (size_t)n * 4096 + 2048 + 8 * c) = oh; *(v4u*)(dst + (size_t)(64 + n) * 4096 + 8 * c) = ol; }
    LDS_WAIT();
}
__device__ __forceinline__ void p0_prologue(Frame& F) {
    const Args& A = *F.a;
    float* scr = (float*)(F.lds + F.wave * SCR_WAVE);
    const int gw = F.wave * F.G + F.vcu, NGW = F.G * NWAVES;
    { const float* cv = A.in[I_C]; const float* W = A.in[I_ADAW]; float* MP = (float*)(F.ws + WS_MODP);
      for (int it = gw; it < 2 * 8 * 48; it += NGW) {
          const int l = it / 384, r = it % 384, ks = r / 48, nb = r % 48;
          const float* wp = W + ((size_t)l * 2048 + ks * 256) * 12288 + nb * 256 + F.lane * 4;
          f32x4 acc = {0.f, 0.f, 0.f, 0.f};
#pragma unroll 8
          for (int k = 0; k < 256; ++k) { const float cx = cv[ks * 256 + k]; const float sl = cx / (1.f + __expf(-cx)); acc += sl * *(const f32x4*)(wp + (size_t)k * 12288); }
          *(f32x4*)(MP + (size_t)(l * 8 + ks) * 12288 + nb * 256 + F.lane * 4) = acc;
      } }
    { float* ROT = (float*)(F.ws + WS_ROT); const int gt = (F.vcu * NWAVES + F.wave) * 64 + F.lane, NT = NGW * 64;
      for (int idx = gt; idx < S_ * 32; idx += NT) { const int pos = idx >> 5, i = idx & 31;
          const float ang = (float)pos * INV_TAB[i]; double rev = (double)ang * 0.15915494309189535; rev -= __builtin_rint(rev); const float fr = (float)rev;
          *(f32x2*)(ROT + (size_t)idx * 2) = (f32x2){__builtin_amdgcn_cosf(fr), __builtin_amdgcn_sinf(fr)}; }
      v4u* z = (v4u*)(F.ws + WS_RWT2); const v4u zero = {0u, 0u, 0u, 0u};
      for (int idx = gt; idx < 64 * 256 + 128 * 512; idx += NT) { const int o = idx < 64 * 256 ? (64 + idx / 256) * 512 + 256 + idx % 256 : 128 * 512 + (idx - 64 * 256); z[o] = zero; } }
    constexpr int N_WIN = 2 * 32 * 96, N_WOUT = 2 * 32 * 32, N_MOE = 128 * 256, N_RW = 32, N_NORM = N_WOUT + 3 * N_MOE;
    for (int it = gw; it < N_WIN; it += NGW) { const int l = it / 3072, q = it % 3072, kb = q / 96, nb = q % 96;
        transpose_item<true>(A.in[I_WIN] + ((size_t)l * 2048 + kb * 64) * NIN + nb * 64, NIN, (bf16*)(F.ws + WS_WIN) + ((size_t)l * NPJ + nb * 64) * 2048 + kb * 64, 2048, scr, F.lane); }
    for (int it = gw; it < N_RW; it += NGW) router_item(A.in[I_RW] + (size_t)(it * 64) * 64, (bf16*)(F.ws + WS_RWT2) + it * 64, scr, F.lane);
#define T_DECODE(r_, src, ldw, dst, ldd) do { int r = (r_); \
        if (r < N_WOUT) { const int l = r / 1024, q = r % 1024, kb = q / 32, nb = q % 32; \
            src = A.in[I_WOUT] + ((size_t)l * 2048 + kb * 64) * 2048 + nb * 64; ldw = 2048; dst = (bf16*)(F.ws + WS_WOUT) + ((size_t)l * 2048 + nb * 64) * 2048 + kb * 64; ldd = 2048; } \
        else if ((r -= N_WOUT) < 2 * N_MOE) { const int s = r / N_MOE, q0 = r % N_MOE, le = q0 / 256, q = q0 % 256, kb = q / 8, nb = q % 8, n0 = nb * 64; \
            const int row = 256 * (n0 >> 7) + 128 * s + (n0 & 127); \
            src = A.in[s ? I_WU : I_WG] + ((size_t)le * 2048 + kb * 64) * 512 + n0; ldw = 512; ldd = 2048; \
            dst = MOE_FP8 ? (bf16*)(F.ws + WS_WGU + ((size_t)le * 1024 + row) * 2048 + kb * 64) : (bf16*)(F.ws + WS_WGU) + ((size_t)le * 1024 + row) * 2048 + kb * 64; } \
        else { r -= 2 * N_MOE; const int le = r / 256, q = r % 256, kb = q / 32, nb = q % 32; \
            src = A.in[I_WD] + ((size_t)le * 512 + kb * 64) * 2048 + nb * 64; ldw = 2048; ldd = 512; \
            dst = MOE_FP8 ? (bf16*)(F.ws + WS_WD + ((size_t)le * 2048 + nb * 64) * 512 + kb * 64) : (bf16*)(F.ws + WS_WD) + ((size_t)le * 2048 + nb * 64) * 512 + kb * 64; } } while (0)
#define T_LOAD(v, src, ldw) do { _Pragma("unroll") for (int i = 0; i < 16; ++i) v[i] = *(const f32x4*)(src + (size_t)(4 * i + kr) * ldw + nc); } while (0)
#define T_PROC(v, dst, ldd, is8) do { _Pragma("unroll") for (int i = 0; i < 16; ++i) { float* s = scr + (4 * i + kr) * 65 + nc; s[0] = v[i][0]; s[1] = v[i][1]; s[2] = v[i][2]; s[3] = v[i][3]; } \
        LDS_WAIT(); \
        if (is8) { const int c4 = lane & 3, n4 = lane >> 2;                    \
            _Pragma("unroll") for (int j = 0; j < 4; ++j) { const int n = n4 + 16 * j; const float* s = scr + (16 * c4) * 65 + n; v4u o; \
                o.x = (unsigned)pg8::pk4_fp8(32.f * s[0 * 65], 32.f * s[1 * 65], 32.f * s[2 * 65], 32.f * s[3 * 65]); o.y = (unsigned)pg8::pk4_fp8(32.f * s[4 * 65], 32.f * s[5 * 65], 32.f * s[6 * 65], 32.f * s[7 * 65]); \
                o.z = (unsigned)pg8::pk4_fp8(32.f * s[8 * 65], 32.f * s[9 * 65], 32.f * s[10 * 65], 32.f * s[11 * 65]); o.w = (unsigned)pg8::pk4_fp8(32.f * s[12 * 65], 32.f * s[13 * 65], 32.f * s[14 * 65], 32.f * s[15 * 65]); \
                *(v4u*)((unsigned char*)dst + (size_t)n * ldd + 16 * c4) = o; asm volatile("" ::: "memory"); } } \
        else { _Pragma("unroll") for (int j = 0; j < 8; ++j) { const int n = nn + 8 * j; const float* s = scr + (8 * cch) * 65 + n; \
            v4u o; o.x = pk2(s[0 * 65], s[1 * 65]); o.y = pk2(s[2 * 65], s[3 * 65]); o.z = pk2(s[4 * 65], s[5 * 65]); o.w = pk2(s[6 * 65], s[7 * 65]); \
            *(v4u*)(dst + (size_t)n * ldd + 8 * cch) = o; } } \
        LDS_WAIT(); } while (0)
    { int lane = F.lane; asm volatile("" : "+v"(lane));
      const int kr = lane >> 4, nc = (lane & 15) * 4, cch = (lane & 3) + 4 * (lane >> 5), nn = (lane >> 2) & 7;
      int it = F.vcu * NWAVES + F.wave;
      if (it < N_NORM) {
          f32x4 va[16], vb[16]; const float* sa; const float* sb; bf16* da; bf16* db; int lwa, lda_, lwb, ldb_;
          T_DECODE(it, sa, lwa, da, lda_); T_LOAD(va, sa, lwa);
          for (;;) {
              const bool hb = it + NGW < N_NORM;
              if (hb) { T_DECODE(it + NGW, sb, lwb, db, ldb_); T_LOAD(vb, sb, lwb); }
              T_PROC(va, da, lda_, MOE_FP8 && it >= N_WOUT);
              if (!hb) break;
              it += NGW;
              const bool ha = it + NGW < N_NORM;
              if (ha) { T_DECODE(it + NGW, sa, lwa, da, lda_); T_LOAD(va, sa, lwa); }
              T_PROC(vb, db, ldb_, MOE_FP8 && it >= N_WOUT);
              if (!ha) break;
              it += NGW;
          }
      } }
#undef T_DECODE
#undef T_LOAD
#undef T_PROC
}

__device__ __forceinline__ float modv(const Args& A, const unsigned char* ws, int l, int idx) {
    const float* MP = (const float*)(ws + WS_MODP) + (size_t)l * 8 * 12288 + idx; float s = A.in[I_ADAB][l * 12288 + idx];
#pragma unroll
    for (int ks = 0; ks < 8; ++ks) s += MP[(size_t)ks * 12288];
    return s;
}
__device__ __forceinline__ float logsig(float x) { return fminf(x, 0.f) - __logf(1.f + __expf(-fabsf(x))); }
__device__ __forceinline__ int moe_tables(Frame& F, int l);
template <int MODE>
__device__ __forceinline__ void norm_phase(Frame& F, int l) {
    const Args& A = *F.a;
    if (MODE == 1 || MODE == 3) (void)moe_tables(F, MODE == 1 ? l - 1 : l);
    float* Av = (float*)F.lds; float* Bv = Av + 2048; float* Gv = Bv + 2048; float* W6 = Gv + 2048;
    for (int col = F.tid; col < 2048; col += NWAVES * 64) {
        if (MODE == 0 || MODE == 1) {
            const float ng = A.in[I_N1G][l * 2048 + col], sh = modv(A, F.ws, l, col), sc = modv(A, F.ws, l, 2048 + col);
            Av[col] = ng * (1.f + sc); Bv[col] = sh;
            const float* w = A.in[I_WIN] + ((size_t)l * 2048 + col) * NIN + C_FF;
#pragma unroll
            for (int j = 0; j < 6; ++j) W6[j * 2048 + col] = w[j];
        } else if (MODE == 2) {
            const float ng = A.in[I_N2G][l * 2048 + col], sh = modv(A, F.ws, l, 6144 + col), sc = modv(A, F.ws, l, 8192 + col);
            Av[col] = ng * (1.f + sc); Bv[col] = sh;
        } else { Av[col] = A.in[I_FG][col]; Bv[col] = 0.f; }
        if (MODE == 1 || MODE == 3) Gv[col] = modv(A, F.ws, MODE == 1 ? l - 1 : l, 10240 + col);
    }
    if (MODE == 0 || MODE == 1) { if (F.tid < 48) { const int idx = F.vcu * 48 + F.tid; ((float*)(F.ws + WS_MODF))[l * 12288 + idx] = modv(A, F.ws, l, idx); } }
    __syncthreads();
    const float* X1 = (const float*)(F.ws + WS_X1); const bf16* YS = (const bf16*)(F.ws + WS_YS);
    const int* TOPE = (const int*)(F.ws + WS_ROUTE); const int* TOPPOS = (const int*)(F.ws + WS_ROUTE + 2 * 131072); const float* TOPW = (const float*)(F.ws + WS_ROUTE + 131072);
    const int* offs = (const int*)(F.lds + LDS_OFFS);
    bf16* H = (bf16*)(F.ws + WS_H); float* LS = (float*)(F.ws + WS_LS);
    const int gw = F.vcu * NWAVES + F.wave, NGW = F.G * NWAVES;
    int ns0 = 0, ns1 = 0; float nw0 = 0.f, nw1 = 0.f;
    if ((MODE == 1 || MODE == 3) && gw < S_) { ns0 = offs[TOPE[2 * gw]] + TOPPOS[2 * gw]; ns1 = offs[TOPE[2 * gw + 1]] + TOPPOS[2 * gw + 1]; nw0 = TOPW[2 * gw]; nw1 = TOPW[2 * gw + 1]; }
    for (int t = gw; t < S_; t += NGW) {
        int ln_ = F.lane; asm volatile("" : "+v"(ln_)); f32x4 x[8]; const int c0 = ln_ * 4;
        if (MODE == 0) {
#pragma unroll
            for (int j = 0; j < 8; ++j) x[j] = *(const f32x4*)(A.in[I_X] + (size_t)t * 2048 + c0 + 256 * j);
        } else {
#pragma unroll
            for (int j = 0; j < 8; ++j) x[j] = *(const f32x4*)(X1 + (size_t)t * 2048 + c0 + 256 * j);
        }
        if (MODE == 1 || MODE == 3) {
            const int s0 = ns0, s1 = ns1; const float w0 = nw0, w1 = nw1;
            { const int tn = t + NGW; if (tn < S_) { ns0 = offs[TOPE[2 * tn]] + TOPPOS[2 * tn]; ns1 = offs[TOPE[2 * tn + 1]] + TOPPOS[2 * tn + 1]; nw0 = TOPW[2 * tn]; nw1 = TOPW[2 * tn + 1]; } }
#pragma unroll
            for (int j = 0; j < 8; ++j) { const v2u a = *(const v2u*)(YS + (size_t)s0 * 2048 + c0 + 256 * j), b = *(const v2u*)(YS + (size_t)s1 * 2048 + c0 + 256 * j);
                const f32x4 g = *(const f32x4*)(Gv + c0 + 256 * j);
                x[j][0] += g[0] * (w0 * bflo(a.x) + w1 * bflo(b.x)); x[j][1] += g[1] * (w0 * bfhi(a.x) + w1 * bfhi(b.x));
                x[j][2] += g[2] * (w0 * bflo(a.y) + w1 * bflo(b.y)); x[j][3] += g[3] * (w0 * bfhi(a.y) + w1 * bfhi(b.y)); }
            if (MODE == 1) {
#pragma unroll
                for (int j = 0; j < 8; ++j) *(f32x4*)(A.out + (size_t)t * 2048 + c0 + 256 * j) = x[j];
            }
        }
        float ss = 0.f;
#pragma unroll
        for (int j = 0; j < 8; ++j) ss += (x[j][0] * x[j][0] + x[j][1] * x[j][1]) + (x[j][2] * x[j][2] + x[j][3] * x[j][3]);
        const float rs = 1.0f / sqrtf(wave_sum(ss) * (1.f / 2048.f) + EPS_);
        float ff[6] = {0.f, 0.f, 0.f, 0.f, 0.f, 0.f};
#pragma unroll
        for (int j = 0; j < 8; ++j) { const f32x4 av = *(const f32x4*)(Av + c0 + 256 * j), bv = *(const f32x4*)(Bv + c0 + 256 * j);
            const f32x4 hv = x[j] * rs * av + bv;
            if (MODE == 3) *(f32x4*)(A.out + (size_t)t * 2048 + c0 + 256 * j) = hv;
            else if (MODE == 2) { v2u o; o.x = pk2(hv[0], hv[1]); o.y = pk2(hv[2], hv[3]); bf16* hp = (bf16*)(F.ws + WS_H2X) + (size_t)t * 4096 + c0 + 256 * j; *(v2u*)hp = o;
                v2u q; q.x = pk2(hv[0] - bflo(o.x), hv[1] - bfhi(o.x)); q.y = pk2(hv[2] - bflo(o.y), hv[3] - bfhi(o.y)); *(v2u*)(hp + 2048) = q; }
            else { v2u o; o.x = pk2(hv[0], hv[1]); o.y = pk2(hv[2], hv[3]); *(v2u*)(H + (size_t)t * 2048 + c0 + 256 * j) = o; }
            if (MODE == 0 || MODE == 1) {
#pragma unroll
                for (int q = 0; q < 6; ++q) { const f32x4 w = *(const f32x4*)(W6 + q * 2048 + c0 + 256 * j); ff[q] += (hv[0] * w[0] + hv[1] * w[1]) + (hv[2] * w[2] + hv[3] * w[3]); }
            }
            asm volatile("" ::: "memory");
        }
        if (MODE == 0 || MODE == 1) {
#pragma unroll
            for (int q = 0; q < 6; ++q) { const float f = wave_sum(ff[q]); if (F.lane == q) LS[(size_t)t * 8 + q] = logsig(f + A.in[I_FB][l * 6 + q]); }
        }
    }
}

__device__ __forceinline__ void cum_item(Frame& F, int h) {
    const float* LS = (const float*)(F.ws + WS_LS); float* CUM = (float*)(F.ws + WS_CUM) + (size_t)h * S_;
    float* red = (float*)F.lds;
    const int p0 = F.tid * 32; float v[32]; float run = 0.f;
#pragma unroll
    for (int i = 0; i < 32; ++i) { run += LS[(size_t)(p0 + i) * 8 + h]; v[i] = run; }
    float inc = run;
#pragma unroll
    for (int o = 1; o < 64; o <<= 1) { const float u = __shfl_up(inc, o); if (F.lane >= o) inc += u; }
    if (F.lane == 63) red[F.wave] = inc;
    __syncthreads();
    float base = inc - run;
    for (int w = 0; w < F.wave; ++w) base += red[w];
#pragma unroll
    for (int i = 0; i < 32; ++i) CUM[p0 + i] = base + v[i];
    __syncthreads();
}
__device__ __forceinline__ void qknorm_item(Frame& F, int h, int qb) {
    const bf16* PJ = (const bf16*)(F.ws + WS_PROJ); float* MQK = (float*)(F.ws + WS_MAXQK);
    float* red = (float*)F.lds;
    const int row = qb * 256 + (F.tid >> 1), half = F.tid & 1;
    const bf16* QH = (const bf16*)(F.ws + WS_QKVH); const bf16* qp = QH + ((size_t)h * S_ + row) * 128 + 64 * half; const bf16* kp = QH + ((size_t)(6 + h) * S_ + row) * 128 + 64 * half;
    float sq = 0.f, sk = 0.f;
#pragma unroll
    for (int i = 0; i < 8; ++i) { const v4u a = *(const v4u*)(qp + 8 * i), b = *(const v4u*)(kp + 8 * i);
#pragma unroll
        for (int e = 0; e < 4; ++e) { const float a0 = bflo(a[e]), a1 = bfhi(a[e]), b0 = bflo(b[e]), b1 = bfhi(b[e]); sq += a0 * a0 + a1 * a1; sk += b0 * b0 + b1 * b1; } }
    sq += __shfl_xor(sq, 1); sk += __shfl_xor(sk, 1);
    const float mq = wave_max(sqrtf(sq)), mk = wave_max(sqrtf(sk));
    if (F.lane == 0) { red[F.wave * 2] = mq; red[F.wave * 2 + 1] = mk; }
    __syncthreads();
    if (F.tid == 0) { float a = 0.f, b = 0.f; for (int w = 0; w < 8; ++w) { a = fmaxf(a, red[2 * w]); b = fmaxf(b, red[2 * w + 1]); } MQK[(h * 64 + qb) * 2] = a; MQK[(h * 64 + qb) * 2 + 1] = b; }
    __syncthreads();
}
__device__ __forceinline__ void conv_item(Frame& F, int l, int rb) {
    const Args& A = *F.a; const bf16* PJ = (const bf16*)(F.ws + WS_PROJ); bf16* MX = (bf16*)(F.ws + WS_MIXED);
    int tid = F.tid; asm volatile("" : "+v"(tid));
    const int ch = (tid & 63) * 8, t0 = rb * 64 + (tid >> 6) * 8;
    float w0[8], w1[8], w2[8], z1[8], z2[8];
#pragma unroll
    for (int e = 0; e < 8; ++e) { w0[e] = A.in[I_CONVW][(l * 3 + 0) * 512 + ch + e]; w1[e] = A.in[I_CONVW][(l * 3 + 1) * 512 + ch + e]; w2[e] = A.in[I_CONVW][(l * 3 + 2) * 512 + ch + e]; z1[e] = 0.f; z2[e] = 0.f; }
#pragma unroll
    for (int i = -2; i < 8; ++i) { const int t = t0 + i; if (t < 0) continue;
        const bf16* rp = PJ + (size_t)t * NPJ + ch; const v4u cc = *(const v4u*)(rp + C_CC), cu = *(const v4u*)(rp + C_CU);
        float z[8];
#pragma unroll
        for (int e = 0; e < 4; ++e) { z[2 * e] = bflo(cc[e]) * bflo(cu[e]); z[2 * e + 1] = bfhi(cc[e]) * bfhi(cu[e]); }
        if (i >= 0) { const v4u cb = *(const v4u*)(rp + C_CB); float y[8];
#pragma unroll
            for (int e = 0; e < 4; ++e) { y[2 * e] = bflo(cb[e]) * (w0[2 * e] * z2[2 * e] + w1[2 * e] * z1[2 * e] + w2[2 * e] * z[2 * e]);
                                          y[2 * e + 1] = bfhi(cb[e]) * (w0[2 * e + 1] * z2[2 * e + 1] + w1[2 * e + 1] * z1[2 * e + 1] + w2[2 * e + 1] * z[2 * e + 1]); }
            v4u o; o.x = pk2(y[0], y[1]); o.y = pk2(y[2], y[3]); o.z = pk2(y[4], y[5]); o.w = pk2(y[6], y[7]);
            *(v4u*)(MX + (size_t)t * 2048 + M_CONV + ch) = o; }
#pragma unroll
        for (int e = 0; e < 8; ++e) { z2[e] = z1[e]; z1[e] = z[e]; }
    }
}
__device__ __forceinline__ void rot4(const bf16* rowp, const float* ROT, int pos, int i0, float (&o1)[4], float (&o2)[4]) {
    const v2u a = *(const v2u*)(rowp + i0), b = *(const v2u*)(rowp + 32 + i0);
    const f32x4 c0 = *(const f32x4*)(ROT + ((size_t)pos * 32 + i0) * 2), c1 = *(const f32x4*)(ROT + ((size_t)pos * 32 + i0) * 2 + 4);
    const float x1[4] = {bflo(a.x), bfhi(a.x), bflo(a.y), bfhi(a.y)}, x2[4] = {bflo(b.x), bfhi(b.x), bflo(b.y), bfhi(b.y)};
    const float cs[4] = {c0[0], c0[2], c1[0], c1[2]}, sn[4] = {c0[1], c0[3], c1[1], c1[3]};
#pragma unroll
    for (int e = 0; e < 4; ++e) { o1[e] = x1[e] * cs[e] - x2[e] * sn[e]; o2[e] = x2[e] * cs[e] + x1[e] * sn[e]; }
}
constexpr int RP = 72;
constexpr int PVR = 160, PKR = 96;
typedef short v4i16_t __attribute__((ext_vector_type(4)));
__device__ __forceinline__ s16x4 trrd(const bf16* p) { return __builtin_bit_cast(s16x4, __builtin_amdgcn_ds_read_tr16_b64_v4i16((LAS v4i16_t*)p)); }
__device__ __forceinline__ bf16x8 tr_frag(const bf16* T, int pitch, int rowA, int rowB, int col0, int lane) {
    const int blk = (lane >> 4) & 1, q = (lane & 15) >> 2, p = lane & 3; const bf16* b = T + q * pitch + col0 + 16 * blk + 4 * p;
    const s16x4 lo = trrd(b + rowA * pitch), hi = trrd(b + rowB * pitch);
    return (bf16x8){lo[0], lo[1], lo[2], lo[3], hi[0], hi[1], hi[2], hi[3]};
}
__device__ __forceinline__ void stage_vr(unsigned char* ws, int tid, bf16* VR, int c, int h) {
    const bf16* PJ = (const bf16*)(ws + WS_PROJ);
    const int m = tid >> 3, v0 = (tid & 7) * 16; const bf16* vp = PJ + (size_t)(64 * c + m) * NPJ + C_RV + 128 * h + v0;
    const v4u a = *(const v4u*)vp, b = *(const v4u*)(vp + 8);
    *(v4u*)(VR + m * PVR + v0) = a; *(v4u*)(VR + m * PVR + v0 + 8) = b;
}
__device__ __forceinline__ void r1_item(Frame& FF, int c, int h) {
    struct { unsigned char* lds; unsigned char* ws; int tid, lane, wave; } F; F.lds = FF.lds; F.ws = FF.ws; F.wave = FF.wave;
    { int t_ = FF.tid; asm volatile("" : "+v"(t_)); F.tid = t_; F.lane = t_ & 63; }
    const bf16* PJ = (const bf16*)(F.ws + WS_PROJ); const float* ROT = (const float*)(F.ws + WS_ROT);
    bf16* KR = (bf16*)F.lds; bf16* VR = KR + 64 * PKR;
    const float lg2 = ret_lg2(h);
    { const int m = F.tid >> 3, i0 = (F.tid & 7) * 4, pos = 64 * c + m; float o1[4], o2[4];
      rot4(PJ + (size_t)pos * NPJ + C_RK + 64 * h, ROT, pos, i0, o1, o2);
      const float sc = 0.125f * __builtin_amdgcn_exp2f(lg2 * (float)(63 - m));
      *(v2u*)(KR + m * PKR + i0) = (v2u){pk2(o1[0] * sc, o1[1] * sc), pk2(o1[2] * sc, o1[3] * sc)}; *(v2u*)(KR + m * PKR + 32 + i0) = (v2u){pk2(o2[0] * sc, o2[1] * sc), pk2(o2[2] * sc, o2[3] * sc)}; }
    stage_vr(F.ws, F.tid, VR, c, h);
    __syncthreads();
    const int r32 = F.lane & 31, hh = F.lane >> 5, vi = F.wave >> 1, di = F.wave & 1;
    f32x16 acc = {};
#pragma unroll
    for (int s = 0; s < 4; ++s) { const bf16x8 a = tr_frag(VR, PVR, 16 * s + 8 * hh, 16 * s + 8 * hh + 4, 32 * vi, F.lane), b = tr_frag(KR, PKR, 16 * s + 8 * hh, 16 * s + 8 * hh + 4, 32 * di, F.lane);
        acc = __builtin_amdgcn_mfma_f32_32x32x16_bf16(a, b, acc, 0, 0, 0); }
    float* KVT = (float*)(F.ws + WS_KVT) + (size_t)(c * 6 + h) * 8192;
#pragma unroll
    for (int r = 0; r < 16; ++r) KVT[(32 * vi + fa::crow(r, hh)) * 64 + 32 * di + r32] = acc[r];
    __syncthreads();
}
__device__ __forceinline__ void mixa0_phase(Frame& F) {
    constexpr int N_CUM = 6, N_QK = 384;
    for (int it = F.vcu; it < N_CUM + N_QK; it += F.G) { if (it < N_CUM) cum_item(F, it); else qknorm_item(F, (it - N_CUM) % 6, (it - N_CUM) / 6); }
}
__device__ __forceinline__ void mixb_phase(Frame& F) {
    const float* KVT = (const float*)(F.ws + WS_KVT); bf16* PV = (bf16*)(F.ws + WS_PREVT);
    const int gt = (F.vcu * NWAVES + F.wave) * 64 + F.lane;
    if (gt < 6 * 8192) { const int h = gt / 8192; const float dec = __builtin_amdgcn_exp2f(ret_lg2(h) * 64.f); float st = 0.f;
        for (int c0 = 0; c0 < 256; c0 += 16) { float kv[16];
#pragma unroll
            for (int i = 0; i < 16; ++i) kv[i] = KVT[(size_t)(c0 + i) * 49152 + gt];
#pragma unroll
            for (int i = 0; i < 16; ++i) { PV[(size_t)(c0 + i) * 49152 + gt] = f2bf(st); st = st * dec + kv[i]; } } }
}
struct R3In { v2u qa, qb, ka, kb; f32x4 r0, r1; v4u va, vb, g0, g1; bf16x8 pvf[4]; };
__device__ __forceinline__ void r3_load(Frame& FF, int c, int h, R3In& I) {
    int tid = FF.tid; asm volatile("" : "+v"(tid)); const int lane = tid & 63;
    const bf16* PJ = (const bf16*)(FF.ws + WS_PROJ); const float* ROT = (const float*)(FF.ws + WS_ROT);
    const int m = tid >> 3, i0 = (tid & 7) * 4, pos = 64 * c + m; const bf16* rp = PJ + (size_t)pos * NPJ;
    I.qa = *(const v2u*)(rp + C_RQ + 64 * h + i0); I.qb = *(const v2u*)(rp + C_RQ + 64 * h + 32 + i0); I.ka = *(const v2u*)(rp + C_RK + 64 * h + i0); I.kb = *(const v2u*)(rp + C_RK + 64 * h + 32 + i0);
    I.r0 = *(const f32x4*)(ROT + ((size_t)pos * 32 + i0) * 2); I.r1 = *(const f32x4*)(ROT + ((size_t)pos * 32 + i0) * 2 + 4);
    { const bf16* vp = rp + C_RV + 128 * h + (tid & 7) * 16; I.va = *(const v4u*)vp; I.vb = *(const v4u*)(vp + 8); }
    { const bf16* gp = rp + C_RG + 128 * h + 16 * (tid & 7); I.g0 = *(const v4u*)gp; I.g1 = *(const v4u*)(gp + 8); }
    { const int r32_ = lane & 31, hh_ = lane >> 5, vi_ = FF.wave >> 1; const bf16* PV = (const bf16*)(FF.ws + WS_PREVT) + ((size_t)(c * 6 + h) * 128 + 32 * vi_ + r32_) * 64;
#pragma unroll
      for (int s = 0; s < 4; ++s) I.pvf[s] = *(const bf16x8*)(PV + 16 * s + 8 * hh_); }
}
__device__ __forceinline__ void rot4v(v2u a, v2u b, f32x4 c0, f32x4 c1, float (&o1)[4], float (&o2)[4]) {
    const float x1[4] = {bflo(a.x), bfhi(a.x), bflo(a.y), bfhi(a.y)}, x2[4] = {bflo(b.x), bfhi(b.x), bflo(b.y), bfhi(b.y)};
    const float cs[4] = {c0[0], c0[2], c1[0], c1[2]}, sn[4] = {c0[1], c0[3], c1[1], c1[3]};
#pragma unroll
    for (int e = 0; e < 4; ++e) { o1[e] = x1[e] * cs[e] - x2[e] * sn[e]; o2[e] = x2[e] * cs[e] + x1[e] * sn[e]; }
}
__device__ __forceinline__ void r3_compute(Frame& FF, int l, int c, int h, const R3In& I) {
    struct { unsigned char* lds; unsigned char* ws; const Args* a; int tid, lane, wave; } F; F.lds = FF.lds; F.ws = FF.ws; F.a = FF.a; F.wave = FF.wave;
    { int t_ = FF.tid; asm volatile("" : "+v"(t_)); F.tid = t_; F.lane = t_ & 63; }
    const Args& A = *F.a;
    bf16* QS = (bf16*)F.lds; bf16* KS = QS + 64 * RP; bf16* VR = KS + 64 * RP; float* OS = (float*)(VR + 64 * PVR);
    const float lg2 = ret_lg2(h);
    { const int m = F.tid >> 3, i0 = (F.tid & 7) * 4; float o1[4], o2[4];
      rot4v(I.qa, I.qb, I.r0, I.r1, o1, o2);
      *(v2u*)(QS + m * RP + i0) = (v2u){pk2(o1[0], o1[1]), pk2(o1[2], o1[3])}; *(v2u*)(QS + m * RP + 32 + i0) = (v2u){pk2(o2[0], o2[1]), pk2(o2[2], o2[3])};
      rot4v(I.ka, I.kb, I.r0, I.r1, o1, o2);
      *(v2u*)(KS + m * RP + i0) = (v2u){pk2(o1[0] * 0.125f, o1[1] * 0.125f), pk2(o1[2] * 0.125f, o1[3] * 0.125f)};
      *(v2u*)(KS + m * RP + 32 + i0) = (v2u){pk2(o2[0] * 0.125f, o2[1] * 0.125f), pk2(o2[2] * 0.125f, o2[3] * 0.125f)};
      const int v0 = (F.tid & 7) * 16; *(v4u*)(VR + m * PVR + v0) = I.va; *(v4u*)(VR + m * PVR + v0 + 8) = I.vb; }
    __syncthreads();
    const int r32 = F.lane & 31, hh = F.lane >> 5, ni = F.wave & 1, vi = F.wave >> 1;
    f32x16 oacc = {}, cacc = {};
#pragma unroll
    for (int mj = 0; mj < 2; ++mj) {
        f32x16 X = {};
#pragma unroll
        for (int s = 0; s < 4; ++s) { const bf16x8 a = *(const bf16x8*)(KS + (32 * mj + r32) * RP + 16 * s + 8 * hh), b = *(const bf16x8*)(QS + (32 * ni + r32) * RP + 16 * s + 8 * hh);
            X = __builtin_amdgcn_mfma_f32_32x32x16_bf16(a, b, X, 0, 0, 0); }
#pragma unroll
        for (int r = 0; r < 16; ++r) { const int dm = (32 * ni + r32) - (32 * mj + fa::crow(r, hh)); X[r] *= __builtin_amdgcn_exp2f(lg2 * (float)(dm < 0 ? -dm : dm)); }
#pragma unroll
        for (int s2 = 0; s2 < 2; ++s2) {
            v4u pw; pw.x = pk2(X[8 * s2 + 0], X[8 * s2 + 1]); pw.y = pk2(X[8 * s2 + 2], X[8 * s2 + 3]); pw.z = pk2(X[8 * s2 + 4], X[8 * s2 + 5]); pw.w = pk2(X[8 * s2 + 6], X[8 * s2 + 7]);
            const bf16x8 bwf = tr_frag(VR, PVR, 32 * mj + 16 * s2 + 4 * hh, 32 * mj + 16 * s2 + 8 + 4 * hh, 32 * vi, F.lane);
            oacc = __builtin_amdgcn_mfma_f32_32x32x16_bf16(*(const bf16x8*)&pw, bwf, oacc, 0, 0, 0); }
    }
    {
#pragma unroll
      for (int s = 0; s < 4; ++s) { const bf16x8 a = *(const bf16x8*)(QS + (32 * ni + r32) * RP + 16 * s + 8 * hh), b = I.pvf[s];
          cacc = __builtin_amdgcn_mfma_f32_32x32x16_bf16(a, b, cacc, 0, 0, 0); } }
#pragma unroll
    for (int r = 0; r < 16; ++r) { const int n = 32 * ni + fa::crow(r, hh); OS[n * 132 + 32 * vi + r32] = oacc[r] + __builtin_amdgcn_exp2f(lg2 * (float)(n + 1)) * cacc[r]; }
    __syncthreads();
    { const int n = F.tid >> 3, part = F.tid & 7, pos = 64 * c + n; float x[16]; float s = 0.f;
#pragma unroll
      for (int q = 0; q < 4; ++q) { const f32x4 v = *(const f32x4*)(OS + n * 132 + 16 * part + 4 * q); x[4 * q] = v[0]; x[4 * q + 1] = v[1]; x[4 * q + 2] = v[2]; x[4 * q + 3] = v[3]; s += (v[0] + v[1]) + (v[2] + v[3]); }
      s += __shfl_xor(s, 1); s += __shfl_xor(s, 2); s += __shfl_xor(s, 4);
      const float mu = s * (1.f / 128.f); float q2 = 0.f;
#pragma unroll
      for (int e = 0; e < 16; ++e) { x[e] -= mu; q2 += x[e] * x[e]; }
      q2 += __shfl_xor(q2, 1); q2 += __shfl_xor(q2, 2); q2 += __shfl_xor(q2, 4);
      const float rstd = 1.0f / sqrtf(q2 * (1.f / 128.f) + EPS_);
      const v4u g0 = I.g0, g1 = I.g1;
      const float* gn = A.in[I_GNG] + l * 768 + 128 * h + 16 * part; float y[16];
#pragma unroll
      for (int e = 0; e < 8; ++e) { const unsigned gw_ = e < 4 ? g0[e] : g1[e - 4];
          const float ga = bflo(gw_), gb = bfhi(gw_);
          y[2 * e] = x[2 * e] * rstd * gn[2 * e] * (ga / (1.f + __expf(-ga))); y[2 * e + 1] = x[2 * e + 1] * rstd * gn[2 * e + 1] * (gb / (1.f + __expf(-gb))); }
      bf16* op = (bf16*)(F.ws + WS_MIXED) + (size_t)pos * 2048 + M_RET + 128 * h + 16 * part;
      *(v4u*)op = (v4u){pk2(y[0], y[1]), pk2(y[2], y[3]), pk2(y[4], y[5]), pk2(y[6], y[7])};
      *(v4u*)(op + 8) = (v4u){pk2(y[8], y[9]), pk2(y[10], y[11]), pk2(y[12], y[13]), pk2(y[14], y[15])}; }
    __syncthreads();
}
__device__ __forceinline__ void attn_unit(Frame& F, int h, int qb) {
    using namespace fa;
    const bf16* PJ = (const bf16*)(F.ws + WS_PROJ); const float* CUM = (const float*)(F.ws + WS_CUM) + (size_t)h * S_; const float* MQK = (const float*)(F.ws + WS_MAXQK);
    char* lds = (char*)F.lds; char* V_lds = lds + OFF_V; char* K_lds = lds + OFF_K; float* b_lds = (float*)(lds + OFF_B);
    float* wsm = (float*)(lds + OFF_W) + F.wave * 64; float* li_l = wsm; float* al_l = wsm + 32;
    int tid = F.tid; asm volatile("" : "+v"(tid));
    const int wid = F.wave, lane = tid & 63, r32 = lane & 31, hi = lane >> 5;
    const int qlo = qb * QB + wid * QBLK;
    bf16x8 qr[8];
#pragma unroll
    for (int d0 = 0; d0 < 8; ++d0) qr[d0] = *(const bf16x8*)(PJ + (size_t)(qlo + r32) * NPJ + C_FQ + 128 * h + d0 * 16 + hi * 8);
    const int j_hi = 4 * qb + 4;
    const float cfirst = CUM[qb * QB];
    int j_lo;
    { const float kmx = wave_max(lane <= qb ? MQK[(h * 64 + lane) * 2 + 1] : 0.f);
      const float Dn = MQK[(h * 64 + qb) * 2] * (kmx + MQK[(h * 64 + qb) * 2 + 1]) * SCALE + 30.f;
      int cand = 4 * qb;
#pragma unroll
      for (int i = 0; i < 4; ++i) { const int j = lane + 64 * i; if (j < 4 * qb) { const bool skip = (cfirst - CUM[64 * j + 63]) < -Dn; if (!skip && j < cand) cand = j; } }
      j_lo = wave_min_i(cand); }
    float m_reg = -1e30f, l_reg = 0.f; f32x16 o[4] = {};
    const int sr = tid >> 4, sc = (tid & 15) * 8, vst0 = v_st(sr, sc), vst1 = v_st(32 + sr, sc), kws = KSWZ(sr, sc * 2);
    const int vb0 = (int)(uintptr_t)V_lds + v_rd_base(lane);
    const bf16* Kg = PJ + C_FK + 128 * h + sc; const bf16* Vg = PJ + C_FV + 128 * h + sc;
    v4u k0, k1, v0, v1; float bia = 0.f;
#define ATT_LOAD(t_) do { const int kb_ = (t_) * KVBLK; k0 = *(const v4u*)(Kg + (size_t)(kb_ + sr) * NPJ); k1 = *(const v4u*)(Kg + (size_t)(kb_ + 32 + sr) * NPJ); \
        v0 = *(const v4u*)(Vg + (size_t)(kb_ + sr) * NPJ); v1 = *(const v4u*)(Vg + (size_t)(kb_ + 32 + sr) * NPJ); if (tid < 64) bia = (cfirst - CUM[kb_ + tid]) * (1.0f / SCALE); } while (0)
    ATT_LOAD(j_lo);
    for (int t = j_lo; t < j_hi; ++t) {
        const int kb = t * KVBLK, bo = ((t - j_lo) & 1) * ATT_BUF;
        *(v4u*)(K_lds + bo + kws) = k0; *(v4u*)(K_lds + bo + kws + 32 * 256) = k1; *(v4u*)(V_lds + bo + vst0) = v0; *(v4u*)(V_lds + bo + vst1) = v1;
        if (tid < 64) b_lds[bo / 4 + tid] = bia;
        if (t + 1 < j_hi) ATT_LOAD(t + 1);
        __syncthreads();
        if (kb <= qlo + QBLK - 1) {
            f32x16 p0, p1; float mn, alpha; bf16x8 pa0, pa1, pa2, pa3;
            qkt(p0, p1, K_lds + bo, b_lds + bo / 4, r32, hi, qr);
            if (kb + KVBLK - 1 > qlo) mask_tile(p0, p1, qlo + r32 - 4 * hi - kb);
            partialSM(p0, p1, m_reg, mn, alpha);
            if (__any(alpha < 1.f)) { if (hi == 0) al_l[r32] = alpha; asm volatile("s_waitcnt lgkmcnt(0)" ::: "memory");
#pragma unroll
                for (int d_ = 0; d_ < 4; ++d_)
#pragma unroll
                    for (int r = 0; r < 16; ++r) o[d_][r] *= al_l[crow(r, hi)]; }
            finishSM(p0, p1, alpha, l_reg, pa0, pa1, pa2, pa3);
            pv_tile(o, vb0 + bo, pa0, pa1, pa2, pa3);
        }
    }
#undef ATT_LOAD
    if (hi == 0) li_l[r32] = l_reg; asm volatile("s_waitcnt lgkmcnt(0)" ::: "memory");
    float rli[16];
#pragma unroll
    for (int r = 0; r < 16; ++r) rli[r] = __builtin_amdgcn_rcpf(li_l[crow(r, hi)]);
    bf16* Ow = (bf16*)(F.ws + WS_MIXED) + (size_t)qlo * 2048 + M_FOX + 128 * h;
#pragma unroll
    for (int r = 0; r < 16; ++r) { const int orow = crow(r, hi);
#pragma unroll
        for (int d0 = 0; d0 < 4; ++d0) { const float v = o[d0][r] * rli[r]; const float vn = __shfl_xor(v, 1);
            if ((r32 & 1) == 0) *(unsigned*)(Ow + (size_t)orow * 2048 + d0 * 32 + r32) = cvtpk(v, vn); } }
    __syncthreads();
}
__device__ __forceinline__ int att_jlo(Frame& F, int h, int qb, int lane, float& cfirst) {
    const float* CUM = (const float*)(F.ws + WS_CUM) + (size_t)h * S_; const float* MQK = (const float*)(F.ws + WS_MAXQK);
    cfirst = CUM[qb * 256];
    const float kmx = wave_max(lane <= qb ? MQK[(h * 64 + lane) * 2 + 1] : 0.f);
    const float Dn = MQK[(h * 64 + qb) * 2] * (kmx + MQK[(h * 64 + qb) * 2 + 1]) * fa::SCALE + 30.f;
    int cand = 4 * qb;
#pragma unroll
    for (int i = 0; i < 4; ++i) { const int j = lane + 64 * i; if (j < 4 * qb) { const bool skip = (cfirst - CUM[64 * j + 63]) < -Dn; if (!skip && j < cand) cand = j; } }
    return wave_min_i(cand);
}
__device__ __forceinline__ void att_ref(Frame& F, int id, int lane, fa2::BlockRef& r) {
    const int h = id >> 6, qb = id & 63; const bf16* QH = (const bf16*)(F.ws + WS_QKVH);
    r.Q = QH + ((size_t)h * S_ + qb * 256) * 128; r.K = QH + (size_t)(6 + h) * S_ * 128; r.V = QH + (size_t)(12 + h) * S_ * 128;
    r.O = (bf16*)(F.ws + WS_MIXED) + (size_t)(qb * 256) * 2048 + M_FOX + 128 * h; r.C = (const float*)(F.ws + WS_CUM) + (size_t)h * S_; r.P0 = qb * 256;
    float cf; const int jl = att_jlo(F, h, qb, lane, cf); r.jlo = __builtin_amdgcn_readfirstlane(jl); r.cf = __builtin_bit_cast(float, __builtin_amdgcn_readfirstlane(__builtin_bit_cast(int, cf)));
}
#ifndef REPATT
#define REPATT 1
#endif
#ifndef REPR3
#define REPR3 1
#endif
__device__ __forceinline__ void mixa1_phase(Frame& F, int l, int rep) {
    volatile unsigned* nxt = (volatile unsigned*)(F.lds + LDSCTL_OFF + 64);
    unsigned* head = (unsigned*)(F.ctl + CW_Q + 128 * l + 16 * rep);
#pragma unroll 1
    for (int ra = 0; ra < REPATT; ++ra) {
        int tid = F.tid; asm volatile("" : "+v"(tid)); const int lane = tid & 63;
        unsigned* xh = (unsigned*)(F.ctl + CW_QX + (((l * 2 + rep) * 2 + ra) * 8 + (int)(blockIdx.x & 7)) * 16);
        const int ubase = 48 * (int)(blockIdx.x & 7);
        if (F.tid == 0) *nxt = __hip_atomic_fetch_add(xh, 1u, RLX_AGENT);
        __syncthreads();
        int k = __builtin_amdgcn_readfirstlane((int)*nxt);
        __syncthreads();
        while (k < 48) {
            fa2::Seam S; fa2::BlockRef cur;
            att_ref(F, ubase + k, lane, cur);
#ifdef DBG_TILES
            if (F.tid == 0) __hip_atomic_fetch_add(F.ctl + 20000, (unsigned)((cur.P0 + 255) / 64 + 1 - cur.jlo), RLX_AGENT);
#endif
            fa2::prime(cur, (char*)F.lds, S, tid);
            fa2::block(cur, (char*)F.lds, S, tid);
            if (F.tid == 0) *nxt = __hip_atomic_fetch_add(xh, 1u, RLX_AGENT);
            __syncthreads();
            k = __builtin_amdgcn_readfirstlane((int)*nxt);
            __syncthreads();
        }
    }
    constexpr int N_CONV = 256, N_R1 = 1536;
#pragma unroll 1
    for (int rr = 0; rr < REPR3; ++rr)
    for (;;) {
        if (F.tid == 0) *nxt = __hip_atomic_fetch_add(head + 64 + 4 * rr, 1u, RLX_AGENT);
        __syncthreads();
        const int id = __builtin_amdgcn_readfirstlane((int)*nxt);
        __syncthreads();
        if (id >= N_CONV + N_R1 / 4) break;
        if (id < N_CONV) conv_item(F, l, id);
        else {
#pragma unroll 1
            for (int q = 0; q < 4; ++q) { const int it = (id - N_CONV) * 4 + q; r1_item(F, it / 6, it % 6); } }
    }
}
__device__ __forceinline__ void mixr3_phase(Frame& F, int l) {
    int it = F.vcu;
    if (it < 1536) {
        R3In a, b;
        r3_load(F, it / 6, it % 6, a);
        for (;;) {
            const bool hb = it + F.G < 1536;
            if (hb) r3_load(F, (it + F.G) / 6, (it + F.G) % 6, b);
            r3_compute(F, l, it / 6, it % 6, a);
            if (!hb) break;
            it += F.G;
            const bool ha = it + F.G < 1536;
            if (ha) r3_load(F, (it + F.G) / 6, (it + F.G) % 6, a);
            r3_compute(F, l, it / 6, it % 6, b);
            if (!ha) break;
            it += F.G;
        }
    }
}

__device__ __forceinline__ void route_phase(Frame& F, int l) {
    const Args& A = *F.a; const float* rb = A.in[I_RB];
    const int t = (F.vcu * NWAVES + F.wave) * 64 + F.lane;
    if (t >= S_) return;
    const float* lg = (const float*)(F.ws + WS_LOGIT) + (size_t)t * 128;
    float bgs = -__builtin_inff(); int be0 = 0, be1 = 0; float ba0 = 0.f, ba1 = 0.f;
#pragma unroll
    for (int g = 0; g < 8; ++g) {
        f32x4 v0 = {0.f, 0.f, 0.f, 0.f}, v1 = {0.f, 0.f, 0.f, 0.f};
#pragma unroll
        for (int ks = 0; ks < 4; ++ks) { const float* p = lg + (size_t)ks * S_ * 128; v0 += *(const f32x4*)(p + 8 * g) + *(const f32x4*)(p + 64 + 8 * g); v1 += *(const f32x4*)(p + 8 * g + 4) + *(const f32x4*)(p + 64 + 8 * g + 4); }
        float s1 = -__builtin_inff(), s2 = -__builtin_inff(), a1 = 0.f, a2 = 0.f; int i1 = 0, i2 = 0;
#pragma unroll
        for (int i = 0; i < 8; ++i) { const float x = i < 4 ? v0[i] : v1[i - 4]; const float aff = 1.f / (1.f + __expf(-x)); const float sel = aff + rb[8 * g + i];
            if (sel > s1) { s2 = s1; i2 = i1; a2 = a1; s1 = sel; i1 = i; a1 = aff; } else if (sel > s2) { s2 = sel; i2 = i; a2 = aff; } }
        const float gs = s1 + s2;
        if (gs > bgs) { bgs = gs; be0 = 8 * g + i1; be1 = 8 * g + i2; ba0 = a1; ba1 = a2; }
    }
    const float inv = 1.f / (ba0 + ba1);
    unsigned* cnt = (unsigned*)(F.ctl + CW_CNT + 64 * l);
    const int p0 = (int)__hip_atomic_fetch_add(cnt + be0, 1u, RLX_AGENT), p1 = (int)__hip_atomic_fetch_add(cnt + be1, 1u, RLX_AGENT);
    int* TOPE = (int*)(F.ws + WS_ROUTE); float* TOPW = (float*)(F.ws + WS_ROUTE + 131072); int* TOPPOS = (int*)(F.ws + WS_ROUTE + 2 * 131072); int* TOKTAB = (int*)(F.ws + WS_TOKTAB);
    TOPE[2 * t] = be0; TOPE[2 * t + 1] = be1; TOPW[2 * t] = ba0 * inv; TOPW[2 * t + 1] = ba1 * inv; TOPPOS[2 * t] = p0; TOPPOS[2 * t + 1] = p1;
    TOKTAB[be0 * 16384 + p0] = t; TOKTAB[be1 * 16384 + p1] = t;
}
__device__ __forceinline__ void normb_route_phase(Frame& F, int l) {
    const Args& A = *F.a;
    constexpr int AP = 2056;
    bf16* Ahi = (bf16*)F.lds; bf16* Alo = Ahi + 16 * AP; float* red = (float*)F.lds; float* fin = red + 8 * 1024;
    const float* MODF = (const float*)(F.ws + WS_MODF) + l * 12288; const float* X1 = (const float*)(F.ws + WS_X1); bf16* H = (bf16*)(F.ws + WS_H);
    const bf16* RW = (const bf16*)(F.ws + WS_RWT2);
    const int lane = F.lane, c0 = lane * 4;
    f32x4 av[8], bv[8];
#pragma unroll
    for (int j = 0; j < 8; ++j) { const int col = c0 + 256 * j; const f32x4 ng = *(const f32x4*)(A.in[I_N2G] + l * 2048 + col), sc = *(const f32x4*)(MODF + 8192 + col); av[j] = ng * (1.f + sc); bv[j] = *(const f32x4*)(MODF + 6144 + col); }
    const int w = F.wave, mr = lane & 15, kq = lane >> 4;
    for (int blk = F.vcu; blk < S_ / 16; blk += F.G) {
        const int R0 = blk * 16;
#pragma unroll
        for (int q = 0; q < 2; ++q) { const int rl = 2 * w + q, t = R0 + rl; f32x4 x[8]; float ss = 0.f;
#pragma unroll
            for (int j = 0; j < 8; ++j) { x[j] = *(const f32x4*)(X1 + (size_t)t * 2048 + c0 + 256 * j); ss += (x[j][0] * x[j][0] + x[j][1] * x[j][1]) + (x[j][2] * x[j][2] + x[j][3] * x[j][3]); }
            const float rs = 1.0f / sqrtf(wave_sum(ss) * (1.f / 2048.f) + EPS_);
#pragma unroll
            for (int j = 0; j < 8; ++j) { const f32x4 hv = x[j] * rs * av[j] + bv[j]; v2u o; o.x = pk2(hv[0], hv[1]); o.y = pk2(hv[2], hv[3]);
                v2u ql; ql.x = pk2(hv[0] - bflo(o.x), hv[1] - bfhi(o.x)); ql.y = pk2(hv[2] - bflo(o.y), hv[3] - bfhi(o.y));
                if (MOE_FP8) *(int*)((unsigned char*)H + (size_t)t * 2048 + c0 + 256 * j) = pg8::pk4_fp8(4.f * hv[0], 4.f * hv[1], 4.f * hv[2], 4.f * hv[3]);
                else *(v2u*)(H + (size_t)t * 2048 + c0 + 256 * j) = o;
                *(v2u*)(Ahi + rl * AP + c0 + 256 * j) = o; *(v2u*)(Alo + rl * AP + c0 + 256 * j) = ql; } }
        __syncthreads();
        f32x4 acc[4] = {{0.f, 0.f, 0.f, 0.f}, {0.f, 0.f, 0.f, 0.f}, {0.f, 0.f, 0.f, 0.f}, {0.f, 0.f, 0.f, 0.f}};
#pragma unroll 2
        for (int ks = 0; ks < 8; ++ks) { const int k0 = 256 * w + 32 * ks + 8 * kq;
            const bf16x8 ah = *(const bf16x8*)(Ahi + mr * AP + k0), al = *(const bf16x8*)(Alo + mr * AP + k0);
#pragma unroll
            for (int et = 0; et < 4; ++et) { const bf16x8 wh = *(const bf16x8*)(RW + (size_t)(16 * et + mr) * 4096 + k0), wl = *(const bf16x8*)(RW + (size_t)(64 + 16 * et + mr) * 4096 + k0);
                acc[et] = __builtin_amdgcn_mfma_f32_16x16x32_bf16(ah, wh, acc[et], 0, 0, 0); acc[et] = __builtin_amdgcn_mfma_f32_16x16x32_bf16(al, wh, acc[et], 0, 0, 0);
                acc[et] = __builtin_amdgcn_mfma_f32_16x16x32_bf16(ah, wl, acc[et], 0, 0, 0); } }
        __syncthreads();
#pragma unroll
        for (int et = 0; et < 4; ++et)
#pragma unroll
            for (int r = 0; r < 4; ++r) red[w * 1024 + (4 * kq + r) * 64 + 16 * et + mr] = acc[et][r];
        __syncthreads();
#pragma unroll
        for (int q = 0; q < 2; ++q) { const int idx = F.tid + 512 * q; float s = 0.f;
#pragma unroll
            for (int ww = 0; ww < 8; ++ww) s += red[ww * 1024 + idx];
            fin[idx] = s; }
        __syncthreads();
        if (F.tid < 128) {
            const int rl = F.tid >> 3, g = F.tid & 7, t = R0 + rl; const float* lg = fin + rl * 64 + 8 * g;
            float s1 = -__builtin_inff(), s2 = -__builtin_inff(), a1 = 0.f, a2 = 0.f; int i1 = 0, i2 = 0;
#pragma unroll
            for (int i = 0; i < 8; ++i) { const float aff = 1.f / (1.f + __expf(-lg[i])); const float sel = aff + A.in[I_RB][8 * g + i];
                if (sel > s1) { s2 = s1; i2 = i1; a2 = a1; s1 = sel; i1 = i; a1 = aff; } else if (sel > s2) { s2 = sel; i2 = i; a2 = aff; } }
            float gs = s1 + s2; int bg = g, e0 = 8 * g + i1, e1 = 8 * g + i2;
#pragma unroll
            for (int o = 1; o < 8; o <<= 1) { const float ogs = __shfl_xor(gs, o); const int obg = __shfl_xor(bg, o), oe0 = __shfl_xor(e0, o), oe1 = __shfl_xor(e1, o); const float oa1 = __shfl_xor(a1, o), oa2 = __shfl_xor(a2, o);
                if (ogs > gs || (ogs == gs && obg < bg)) { gs = ogs; bg = obg; e0 = oe0; e1 = oe1; a1 = oa1; a2 = oa2; } }
            if (g == 0) { const float inv = 1.f / (a1 + a2);
                unsigned* cnt = (unsigned*)(F.ctl + CW_CNT + 64 * l);
                const int p0 = (int)__hip_atomic_fetch_add(cnt + e0, 1u, RLX_AGENT), p1 = (int)__hip_atomic_fetch_add(cnt + e1, 1u, RLX_AGENT);
                int* TOPE = (int*)(F.ws + WS_ROUTE); float* TOPW = (float*)(F.ws + WS_ROUTE + 131072); int* TOPPOS = (int*)(F.ws + WS_ROUTE + 2 * 131072); int* TOKTAB = (int*)(F.ws + WS_TOKTAB);
                TOPE[2 * t] = e0; TOPE[2 * t + 1] = e1; TOPW[2 * t] = a1 * inv; TOPW[2 * t + 1] = a2 * inv; TOPPOS[2 * t] = p0; TOPPOS[2 * t + 1] = p1;
                TOKTAB[e0 * 16384 + p0] = t; TOKTAB[e1 * 16384 + p1] = t; } }
        __syncthreads();
    }
}
__device__ __forceinline__ int moe_tables(Frame& F, int l) {
    int* te = (int*)(F.lds + LDS_TE); int* off = (int*)(F.lds + LDS_OFFS); int* cn = off + 128;
    const unsigned* cnt = (const unsigned*)(F.ctl + CW_CNT + 64 * l);
    if (F.tid == 0) { int o = 0, ti = 0;
        for (int e = 0; e < NE; ++e) { off[e] = o; const int c = (int)__hip_atomic_load(cnt + e, RLX_AGENT); cn[e] = c; const int n = (c + 255) >> 8; for (int q = 0; q < n && ti < 192; ++q) te[ti++] = e; o += n * 256; }
        off[NE] = ti;
        }
    __syncthreads();
    return off[NE];
}
template <class Sched>
__device__ __forceinline__ void moe_tokbuf(Frame& F, const Sched& S) {
    const int* te = (const int*)(F.lds + LDS_TE); const int* off = (const int*)(F.lds + LDS_OFFS); const int* cn = off + 128; int* tb = (int*)(F.lds + LDS_TOK);
    const int* TOKTAB = (const int*)(F.ws + WS_TOKTAB);
    pg8::Unit u;
    for (int i = 0; i < 9 && S.next(i, u); ++i) {
        if (F.tid < 256) { const int e = te[u.pm], idx = (u.pm - (off[e] >> 8)) * 256 + F.tid; tb[i * 256 + F.tid] = idx < cn[e] ? TOKTAB[e * 16384 + idx] : 0; } }
    __syncthreads();
}

constexpr int N_PHASES = 24;
#ifndef MK_PER_PHASE
#define MK_PER_PHASE 0
#endif
__global__ void __launch_bounds__(NWAVES * 64, 2) fwd_kernel(Args args) {
    extern __shared__ __attribute__((aligned(16))) unsigned char lds[];
    Frame F;
    F.lds = lds; F.ws = args.ws; F.a = &args; F.ctl = (gu32*)(args.ws + WS_CTL);
    F.tid = threadIdx.x; F.lane = F.tid & 63; F.wave = __builtin_amdgcn_readfirstlane(F.tid >> 6);
    F.G = gridDim.x; { const int bx = blockIdx.x; F.vcu = (F.G % 8 == 0) ? (bx % 8) * (F.G / 8) + bx / 8 : bx; }
    for (int u = F.tid; u < (LDS_BYTES - LDSCTL_OFF) / 4; u += NWAVES * 64) ((unsigned*)(lds + LDSCTL_OFF))[u] = 0u;
    __syncthreads();
    XcdBarrier bar; bar.bar = (unsigned*)(F.ctl + CW_BAR); bar.x = 0; bar.st = nullptr;
    if (!MK_PER_PHASE) bar = xcd_barrier_post((unsigned*)(F.ctl + CW_BAR), (volatile LAS unsigned*)(lds + LDSCTL_OFF));
#ifdef DBG_XCC
    if (threadIdx.x == 0) __hip_atomic_store(F.ctl + 16384 + blockIdx.x, 1u + (xb_xcc_id() & 15u), RLX_AGENT);
#endif
    const int lo = args.ph_lo, hi = args.ph_hi;
#ifndef PHMASK
#define PHMASK 0xFFFFFF
#endif
#define IN(k) (lo <= (k) && (k) < hi)
#define EN(j) ((PHMASK >> (j)) & 1)
#ifndef REPMASK
#define REPMASK 0
#endif
#define NREP(j) (((REPMASK >> (j)) & 1) ? 2 : 1)
#define REFRESH() do { int t_ = threadIdx.x; asm volatile("" : "+v"(t_)); F.tid = t_; F.lane = t_ & 63; unsigned long long z_ = 0; asm volatile("" : "+s"(z_)); F.ws = args.ws + z_; F.ctl = (gu32*)(F.ws + WS_CTL); int g_ = (int)gridDim.x, b_ = (int)blockIdx.x; asm volatile("" : "+s"(g_), "+s"(b_)); F.G = g_; F.vcu = (g_ % 8 == 0) ? (b_ % 8) * (g_ / 8) + b_ / 8 : b_; } while (0)
#ifndef DOWN_ALIGN
#define DOWN_ALIGN true
#endif
#ifndef MOE_BAUX
#define MOE_BAUX 0
#endif
#ifndef NBAR
#define NBAR 1
#endif
#define SEAM(k) do { if (IN((k) + 1)) { if (!MK_PER_PHASE) { bar.bar = (unsigned*)(F.ctl + CW_BAR); for (int nb_ = 0; nb_ < NBAR; ++nb_) xcd_barrier(bar); } } } while (0)
    LAS unsigned char* ldsl = (LAS unsigned char*)lds;

    if (EN(11) && IN(0)) { _Pragma("unroll 1") for (int rep = 0; rep < NREP(11); ++rep) p0_prologue(F); SEAM(0); }
    for (int l = 0; l < NL; ++l) {
        const int pb = 1 + 11 * l;
        if (EN(0) && IN(pb + 0)) { _Pragma("unroll 1") for (int rep = 0; rep < NREP(0); ++rep) { REFRESH(); if (l == 0) { if (EN(13)) norm_phase<0>(F, l); } else { if (EN(14)) norm_phase<1>(F, l); } } SEAM(pb + 0); }
        if (EN(1) && IN(pb + 1)) { _Pragma("unroll 1") for (int rep = 0; rep < NREP(1); ++rep) { REFRESH();
            pg8::Gemm g{(const bf16*)(F.ws + WS_H), (const bf16*)(F.ws + WS_WIN) + (size_t)l * NPJ * 2048, S_, NPJ, 2048, 2048, 0};
            pg8::DenseOrder S; S.init(S_, NPJ, 2048, F.G, (int)blockIdx.x);
            pg8::EpiBf16 E{(bf16*)(F.ws + WS_PROJ), NPJ, (bf16*)(F.ws + WS_QKVH), C_FQ, S_, 1.f};
            pg8::gemm_phase<pg8::EpiBf16, pg8::DenseOrder, true, true>(ldsl + RING_OFF, g, S, E);
            } SEAM(pb + 1); }
        if (EN(2) && IN(pb + 2)) { _Pragma("unroll 1") for (int rep = 0; rep < NREP(2); ++rep) { REFRESH(); mixa0_phase(F); } SEAM(pb + 2); }
        if (EN(3) && IN(pb + 3)) { _Pragma("unroll 1") for (int rep = 0; rep < NREP(3); ++rep) { REFRESH(); mixa1_phase(F, l, rep); } SEAM(pb + 3); }
        if (EN(4) && IN(pb + 4)) { _Pragma("unroll 1") for (int rep = 0; rep < NREP(4); ++rep) { REFRESH(); mixb_phase(F); } SEAM(pb + 4); }
        if (EN(5) && IN(pb + 5)) { _Pragma("unroll 1") for (int rep = 0; rep < NREP(5); ++rep) { REFRESH(); mixr3_phase(F, l); } SEAM(pb + 5); }
        if (EN(6) && IN(pb + 6)) { _Pragma("unroll 1") for (int rep = 0; rep < NREP(6); ++rep) { REFRESH();
            pg8::Gemm g{(const bf16*)(F.ws + WS_MIXED), (const bf16*)(F.ws + WS_WOUT) + (size_t)l * 2048 * 2048, S_, 2048, 2048, 2048, 0};
            pg8::DenseOrder S; S.init(S_, 2048, 2048, F.G, (int)blockIdx.x);
            pg8::EpiResid E{l == 0 ? args.in[I_X] : (const float*)args.out, (float*)(F.ws + WS_X1), (const float*)(F.ws + WS_MODF) + l * 12288 + 4096, 2048};
            pg8::gemm_phase<pg8::EpiResid, pg8::DenseOrder, true, true>(ldsl + RING_OFF, g, S, E);
            } SEAM(pb + 6); }
        if (EN(7) && IN(pb + 7)) { _Pragma("unroll 1") for (int rep = 0; rep < NREP(7); ++rep) { REFRESH(); if (rep == 0) normb_route_phase(F, l); } SEAM(pb + 7); }
        if (EN(9) && IN(pb + 9)) { _Pragma("unroll 1") for (int rep = 0; rep < NREP(9); ++rep) { REFRESH();
            const int nT = moe_tables(F, l);
#if MOE_FP8
            pg8::Gemm g{(const bf16*)(F.ws + WS_H), (const bf16*)(F.ws + WS_WGU + (size_t)l * NE * 1024 * 2048), PMAX, 1024, 1024, 1024, 2048};
            pg8::MoeOrder S{(const LAS int*)(ldsl + LDS_TE), nT, 4, F.G, (int)blockIdx.x, (long)1024 * 2048, (long)256 * 2048, 0, (const LAS int*)(ldsl + LDS_TOK)};
            moe_tokbuf(F, S);
            pg8::EpiGateUp8 E{F.ws + WS_ACT, DE, 1.f / 128.f, 4.f};
            pg8::gemm_phase<pg8::EpiGateUp8, pg8::MoeOrder, true, true, true, MOE_BAUX, true>(ldsl + RING_OFF, g, S, E);
#else
            pg8::Gemm g{(const bf16*)(F.ws + WS_H), (const bf16*)(F.ws + WS_WGU) + (size_t)l * NE * 1024 * 2048, PMAX, 1024, 2048, 2048, 4096};
            pg8::MoeOrder S{(const LAS int*)(ldsl + LDS_TE), nT, 4, F.G, (int)blockIdx.x, (long)1024 * 2048 * 2, (long)256 * 2048 * 2, 0, (const LAS int*)(ldsl + LDS_TOK)};
            moe_tokbuf(F, S);
            pg8::EpiGateUp E{(bf16*)(F.ws + WS_ACT), DE};
            pg8::gemm_phase<pg8::EpiGateUp, pg8::MoeOrder, true, true, true, MOE_BAUX>(ldsl + RING_OFF, g, S, E);
#endif
            } SEAM(pb + 9); }
        if (EN(10) && IN(pb + 10)) { _Pragma("unroll 1") for (int rep = 0; rep < NREP(10); ++rep) { REFRESH();
            const int nT = moe_tables(F, l);
#if MOE_FP8
            pg8::Gemm g{(const bf16*)(F.ws + WS_ACT), (const bf16*)(F.ws + WS_WD + (size_t)l * NE * 2048 * 512), PMAX, 2048, 256, 256, 0};
            pg8::MoeOrder S{(const LAS int*)(ldsl + LDS_TE), nT, 8, F.G, (int)blockIdx.x, (long)2048 * 512, (long)256 * 512, (long)256 * 512, (const LAS int*)(ldsl + LDS_TOK)};
            pg8::EpiBf16 E{(bf16*)(F.ws + WS_YS), 2048, nullptr, 0, 0, 1.f / 128.f};
            pg8::gemm_phase<pg8::EpiBf16, pg8::MoeOrder, DOWN_ALIGN, true, false, MOE_BAUX, true>(ldsl + RING_OFF, g, S, E);
#else
            pg8::Gemm g{(const bf16*)(F.ws + WS_ACT), (const bf16*)(F.ws + WS_WD) + (size_t)l * NE * 2048 * 512, PMAX, 2048, DE, DE, 0};
            pg8::MoeOrder S{(const LAS int*)(ldsl + LDS_TE), nT, 8, F.G, (int)blockIdx.x, (long)2048 * 512 * 2, (long)256 * 512 * 2, (long)256 * 512 * 2, (const LAS int*)(ldsl + LDS_TOK)};
            pg8::EpiBf16 E{(bf16*)(F.ws + WS_YS), 2048, nullptr, 0, 0, 1.f};
            pg8::gemm_phase<pg8::EpiBf16, pg8::MoeOrder, DOWN_ALIGN, true, false, MOE_BAUX>(ldsl + RING_OFF, g, S, E);
#endif
            } SEAM(pb + 10); }
    }
    if (EN(12) && IN(23)) { REFRESH(); norm_phase<3>(F, NL - 1);
#ifdef DBG_TILES
        xcd_barrier(bar);
        { const float avg = (float)__hip_atomic_load(F.ctl + 20000, RLX_AGENT) / 768.f; const float sc = 1.f + avg * 0.01f;
          for (size_t i = (size_t)blockIdx.x * 512 + threadIdx.x; i < (size_t)S_ * D_; i += (size_t)gridDim.x * 512) args.out[i] *= sc; }
#endif
#ifdef DBG_XCC
        xcd_barrier(bar);
        { bool okA = true, okB = true; for (int b = 0; b < 256; ++b) { const unsigned xb = __hip_atomic_load(F.ctl + 16384 + b, RLX_AGENT); if (xb != __hip_atomic_load(F.ctl + 16384 + (b & 7), RLX_AGENT)) okA = false; if (xb != __hip_atomic_load(F.ctl + 16384 + (b & ~31), RLX_AGENT)) okB = false; }
          const float sc = okA ? 1.1f : (okB ? 1.2f : 1.3f);
          for (size_t i = (size_t)blockIdx.x * 512 + threadIdx.x; i < (size_t)S_ * D_; i += (size_t)gridDim.x * 512) args.out[i] *= sc; }
#endif
    }
#undef IN
#undef SEAM
}

extern "C" void kernel_launch(void* const* d_in, const int* in_sizes, int n_in, void* d_out, int out_size, void* d_ws, size_t ws_size, hipStream_t stream) {
    static int grid = 0;
    if (grid == 0) {
        if (n_in != 17 || out_size != S_ * D_ || ws_size < WS_END) { fprintf(stderr, "kernel_launch: unexpected shapes (n_in %d out %d ws %zu)\n", n_in, out_size, ws_size); grid = -1; return; }
        int dev = 0, cus = 0, per_cu = 0;
        if (hipGetDevice(&dev) != hipSuccess || hipDeviceGetAttribute(&cus, hipDeviceAttributeMultiprocessorCount, dev) != hipSuccess) { grid = -1; return; }
        if (hipFuncSetAttribute((const void*)fwd_kernel, hipFuncAttributeMaxDynamicSharedMemorySize, LDS_BYTES) != hipSuccess) { fprintf(stderr, "kernel_launch: hipFuncSetAttribute failed\n"); grid = -1; return; }
        if (hipOccupancyMaxActiveBlocksPerMultiprocessor(&per_cu, (const void*)fwd_kernel, NWAVES * 64, LDS_BYTES) != hipSuccess || per_cu < 1)
            fprintf(stderr, "kernel_launch: note: occupancy query reports %d workgroups per CU\n", per_cu);
        (void)hipGetLastError();
        grid = cus;
    }
    if (grid < 0) return;
    if (hipMemsetAsync((char*)d_ws + WS_CTL, 0, CTL_ZERO_BYTES, stream) != hipSuccess) return;
    Args a{};
    for (int i = 0; i < 17; ++i) a.in[i] = (const float*)d_in[i];
    a.out = (float*)d_out; a.ws = (unsigned char*)d_ws;
#if MK_PER_PHASE
    for (int p = 0; p < N_PHASES; ++p) { a.ph_lo = p; a.ph_hi = p + 1; fwd_kernel<<<dim3(grid), dim3(NWAVES * 64), LDS_BYTES, stream>>>(a); }
#else
    a.ph_lo = 0; a.ph_hi = N_PHASES; fwd_kernel<<<dim3(grid), dim3(NWAVES * 64), LDS_BYTES, stream>>>(a);
#endif
}
```

```cpp
#define MK_PER_PHASE 0
#include <hip/hip_runtime.h>
#include <cstdio>
#include <cstdint>

#define GAS __attribute__((address_space(1)))
#define LAS __attribute__((address_space(3)))
typedef unsigned short bf16;
typedef unsigned v4u __attribute__((ext_vector_type(4)));
typedef unsigned v2u __attribute__((ext_vector_type(2)));
typedef float f32x2 __attribute__((ext_vector_type(2)));
typedef float f32x4 __attribute__((ext_vector_type(4)));
typedef float f32x16 __attribute__((ext_vector_type(16)));
typedef short bf16x8 __attribute__((ext_vector_type(8)));
typedef short s16x4 __attribute__((ext_vector_type(4)));
typedef GAS unsigned gu32;

constexpr int S_ = 16384, D_ = 2048, NL = 2, NIN = 6150, NPJ = 6144;
constexpr int C_CB = 0, C_CC = 512, C_CU = 1024, C_RQ = 1536, C_RK = 1920, C_RV = 2304, C_RG = 3072, C_FQ = 3840, C_FK = 4608, C_FV = 5376, C_FF = 6144;
constexpr int NPC = 1536;
constexpr int G_RQ = 0, G_RK = 3, G_RV = 6, G_RG = 12, G_FQ = 18, G_FK = 24, G_FV = 30;
constexpr int M_CONV = 0, M_RET = 512, M_FOX = 1280;
constexpr int NE = 64, DE = 512, PMAX = 49152;
constexpr float EPS_ = 1e-6f;

#ifndef X1_BF16
#define X1_BF16 0
#endif
__device__ __forceinline__ int lane_id_fresh() { int l; asm volatile("v_mbcnt_lo_u32_b32 %0, -1, 0\n\tv_mbcnt_hi_u32_b32 %0, -1, %0" : "=v"(l)); return l; }
#ifndef TID_V0
#define TID_V0 0
#endif
#if TID_V0
#define LANE_ID() ((int)(threadIdx.x & 63))
#else
#define LANE_ID() lane_id_fresh()
#endif
namespace pg8 {
#define PG8_LAS __attribute__((address_space(3)))
typedef unsigned short bf16_t;
typedef short bf16x8 __attribute__((ext_vector_type(8)));
typedef float f32x4 __attribute__((ext_vector_type(4)));
typedef unsigned u32x4 __attribute__((ext_vector_type(4)));
typedef int v8i_t __attribute__((ext_vector_type(8)));
typedef long l2_t __attribute__((ext_vector_type(2)));
constexpr int BM = 256, BK = 64, HALF = 128, HTB = HALF * BK * 2  , STAGE_BYTES = 8 * HTB, NXCD = 8, WGM = 8;

__host__ __device__ __forceinline__ int lds_byte(int r, int c) { const int st = (r >> 4) * 2 + (c >> 5), rr = r & 15, cc = c & 31, ob = rr * 64 + cc * 2; return st * 1024 + (ob ^ (((ob >> 9) & 1) << 5)); }
__host__ __device__ __forceinline__ void stage_rc(int b, int& R, int& C) { const int st = b / 1024, sb = b % 1024, swz = sb ^ (((sb >> 9) & 1) << 5); R = (st >> 1) * 16 + swz / 64; C = (st & 1) * 32 + (swz % 64) / 2; }
__host__ __device__ __forceinline__ int perm32(int rho) { const int n = rho >> 4, i = rho & 15; return 8 * (i >> 2) + 4 * n + (i & 3); }

struct Unit { int pm, pn; long ao, bo; };
struct Gemm { const bf16_t* A; const bf16_t* Bt; int M, N, K, KL, lda; };

struct DenseOrder {
    int nM, nN, nwg, G, c, i0, cnt; long tsB;
    __device__ void init(int M, int N, int K, int G_, int c_) { nM = M / BM; nN = N / BM; nwg = nM * nN; G = G_; c = c_; tsB = (long)BM * K * 2; i0 = 0; cnt = 1 << 30; }
    __device__ bool next(int i, Unit& u) const {
        if (i >= cnt) return false;
        const long L = (long)(i + i0) * G + c; if (L >= nwg) return false;
        int wgid = (int)L; { const int q = nwg / NXCD, r = nwg % NXCD, xcd = wgid % NXCD, off = wgid / NXCD; wgid = (xcd < r ? xcd * (q + 1) : r * (q + 1) + (xcd - r) * q) + off; }
        const int nig = WGM * nN, gid = wgid / nig, fm = gid * WGM, gsz = (nM - fm) < WGM ? (nM - fm) : WGM;
        u.pm = fm + ((wgid % nig) % gsz); u.pn = (wgid % nig) / gsz; u.ao = (long)u.pm * tsB; u.bo = (long)u.pn * tsB; return true;
    }
    __device__ __forceinline__ void a_ready(const Unit&) const {}
    __device__ __forceinline__ void done(const Unit&) const {}
};
struct MoeOrder {
    const PG8_LAS int* te; int nT, nN, G, c; long estride, tsB, tsA; const PG8_LAS int* tokbuf;
    __device__ bool next(int i, Unit& u) const {
        long L;
#if 1
        if (G == 256) { const int U = nT * nN, x = c & 7, q = U >> 3, rem = U & 7, len = q + (x < rem ? 1 : 0), start = x * q + (x < rem ? x : rem), idx = (c >> 3) + 32 * i;
            if (idx >= len) return false; L = start + idx; } else
#endif
        { L = (long)i * G + c; if (L >= (long)nT * nN) return false; }
        u.pm = (int)(L / nN); u.pn = (int)(L % nN); u.ao = (long)u.pm * tsA; u.bo = (long)te[u.pm] * estride + (long)u.pn * tsB; return true;
    }
    __device__ __forceinline__ int tok(int i, int r) const { return tokbuf[i * 256 + r]; }
    __device__ __forceinline__ void a_ready(const Unit&) const {}
    __device__ __forceinline__ void done(const Unit&) const {}
};
struct RouterOrder {
    int G, c; long tsA, kbytes;
    __device__ bool next(int i, Unit& u) const {
        const long L = (long)i * G + c; if (L >= 256) return false;
        u.pm = (int)(L >> 2); u.pn = (int)(L & 3); u.ao = (long)u.pm * tsA + (long)u.pn * kbytes; u.bo = (long)u.pn * kbytes; return true;
    }
    __device__ __forceinline__ void a_ready(const Unit&) const {}
    __device__ __forceinline__ void done(const Unit&) const {}
};

__device__ __forceinline__ unsigned cvt_pk_bf16(float lo, float hi) { unsigned r; asm volatile("v_cvt_pk_bf16_f32 %0, %1, %2" : "=v"(r) : "v"(lo), "v"(hi)); return r; }

struct EpiBf16 {
    static constexpr bool PERM = true, AFTER_DRAIN = false;
    bf16_t* O; int ldc; bf16_t* HM; int hm_col0, hm_rows; float scale;
    __device__ __forceinline__ void operator()(const f32x4 (&acc)[2][2][4][2], const Unit& u, int wr, int wc, int fr, int fq) const {
        const int row0 = u.pm * BM + wr * 64 + fr, col0 = u.pn * BM + wc * 32 + 8 * fq;
        const bool hm = HM != nullptr && u.pn * BM >= hm_col0;
        const int hd0 = hm ? (u.pn * BM - hm_col0) / 128 : 0;
#pragma unroll
        for (int ai = 0; ai < 2; ++ai)
#pragma unroll
            for (int m = 0; m < 4; ++m) { const int row = row0 + ai * HALF + m * 16;
#pragma unroll
                for (int bj = 0; bj < 2; ++bj) { const f32x4 v0 = acc[ai][bj][m][0] * scale, v1 = acc[ai][bj][m][1] * scale;
                    u32x4 w; w.x = cvt_pk_bf16(v0[0], v0[1]); w.y = cvt_pk_bf16(v0[2], v0[3]); w.z = cvt_pk_bf16(v1[0], v1[1]); w.w = cvt_pk_bf16(v1[2], v1[3]);
                    bf16_t* dst = hm ? HM + ((size_t)(hd0 + bj) * hm_rows + row) * 128 + wc * 32 + 8 * fq : O + (size_t)row * ldc + col0 + bj * HALF;
                    *(u32x4*)dst = w; asm volatile("" ::: "memory"); } }
    }
};
struct EpiResid {
    static constexpr bool PERM = false, AFTER_DRAIN = false;
    const float* Xi; float* Xo; const float* g; int ldc;
    __device__ __forceinline__ void operator()(const f32x4 (&acc)[2][2][4][2], const Unit& u, int wr, int wc, int fr, int fq) const {
        const int row0 = u.pm * BM + wr * 64 + fr, col0 = u.pn * BM + wc * 32 + 4 * fq;
        f32x4 gv[2][2];
#pragma unroll
        for (int bj = 0; bj < 2; ++bj)
#pragma unroll
            for (int n = 0; n < 2; ++n) gv[bj][n] = *(const f32x4*)(g + col0 + bj * HALF + 16 * n);
        const float* __restrict__ xin = Xi; float* __restrict__ xout = Xo;
#pragma unroll
        for (int ai = 0; ai < 2; ++ai)
#pragma unroll
            for (int mp = 0; mp < 4; mp += 2) { f32x4 xi[2][2][2];
#pragma unroll
                for (int mm = 0; mm < 2; ++mm) { const size_t ro = (size_t)(row0 + ai * HALF + (mp + mm) * 16) * ldc + col0;
#pragma unroll
                    for (int bj = 0; bj < 2; ++bj)
#pragma unroll
                        for (int n = 0; n < 2; ++n) xi[mm][bj][n] = *(const f32x4*)(xin + ro + bj * HALF + 16 * n); }
                asm volatile("" ::: "memory");
#pragma unroll
                for (int mm = 0; mm < 2; ++mm) { const size_t ro = (size_t)(row0 + ai * HALF + (mp + mm) * 16) * ldc + col0;
#pragma unroll
                    for (int bj = 0; bj < 2; ++bj)
#pragma unroll
                        for (int n = 0; n < 2; ++n) { const size_t o = ro + bj * HALF + 16 * n;
                            const f32x4 xo = xi[mm][bj][n] + gv[bj][n] * acc[ai][bj][mp + mm][n];
#if X1_BF16
                            { typedef unsigned u32x2 __attribute__((ext_vector_type(2))); *(u32x2*)((bf16_t*)xout + o) = (u32x2){cvt_pk_bf16(xo[0], xo[1]), cvt_pk_bf16(xo[2], xo[3])}; }
#else
                            *(f32x4*)(xout + o) = xo;
#endif
                        } }
                asm volatile("" ::: "memory"); }
    }
};
struct EpiLogits {
    static constexpr bool PERM = false, AFTER_DRAIN = false;
    float* Lg;
    __device__ __forceinline__ void operator()(const f32x4 (&acc)[2][2][4][2], const Unit& u, int wr, int wc, int fr, int fq) const {
        const int row0 = u.pn * 16384 + u.pm * BM + wr * 64 + fr, col0 = wc * 32 + 4 * fq;
#pragma unroll
        for (int ai = 0; ai < 2; ++ai)
#pragma unroll
            for (int m = 0; m < 4; ++m)
#pragma unroll
                for (int n = 0; n < 2; ++n) *(f32x4*)(Lg + (size_t)(row0 + ai * HALF + m * 16) * 128 + col0 + 16 * n) = acc[ai][0][m][n];
    }
};
struct EpiGateUp {
    static constexpr bool PERM = true, AFTER_DRAIN = false;
    bf16_t* O; int ldc;
    __device__ __forceinline__ void operator()(const f32x4 (&acc)[2][2][4][2], const Unit& u, int wr, int wc, int fr, int fq) const {
        const int row0 = u.pm * BM + wr * 64 + fr, col0 = u.pn * HALF + wc * 32 + 8 * fq;
#pragma unroll
        for (int ai = 0; ai < 2; ++ai)
#pragma unroll
            for (int m = 0; m < 4; ++m) { float a[8];
#pragma unroll
                for (int n = 0; n < 2; ++n)
#pragma unroll
                    for (int i = 0; i < 4; ++i) { const float gt = acc[ai][0][m][n][i], up = acc[ai][1][m][n][i];
                        a[n * 4 + i] = gt * __builtin_amdgcn_rcpf(1.f + __builtin_amdgcn_exp2f(-1.4426950408889634f * gt)) * up; }
                u32x4 w; w.x = cvt_pk_bf16(a[0], a[1]); w.y = cvt_pk_bf16(a[2], a[3]); w.z = cvt_pk_bf16(a[4], a[5]); w.w = cvt_pk_bf16(a[6], a[7]);
                *(u32x4*)(O + (size_t)(row0 + ai * HALF + m * 16) * ldc + col0) = w; }
    }
};
__device__ __forceinline__ float sat8(float x) { return __builtin_amdgcn_fmed3f(x, -448.f, 448.f); }
__device__ __forceinline__ int pk4_fp8_raw(float a, float b, float c, float d) { int w = __builtin_amdgcn_cvt_pk_fp8_f32(a, b, 0, false); return __builtin_amdgcn_cvt_pk_fp8_f32(c, d, w, true); }
__device__ __forceinline__ int pk4_fp8(float a, float b, float c, float d) { int w = __builtin_amdgcn_cvt_pk_fp8_f32(sat8(a), sat8(b), 0, false); return __builtin_amdgcn_cvt_pk_fp8_f32(sat8(c), sat8(d), w, true); }
struct EpiGateUp8 {
    static constexpr bool PERM = true, AFTER_DRAIN = false;
    unsigned char* O; int ldc; float in_scale, out_scale;
    __device__ __forceinline__ void operator()(const f32x4 (&acc)[2][2][4][2], const Unit& u, int wr, int wc, int fr, int fq) const {
        const int row0 = u.pm * BM + wr * 64 + fr, col0 = u.pn * HALF + wc * 32 + 8 * fq;
#pragma unroll
        for (int ai = 0; ai < 2; ++ai)
#pragma unroll
            for (int m = 0; m < 4; ++m) { float a[8];
#pragma unroll
                for (int n = 0; n < 2; ++n)
#pragma unroll
                    for (int i = 0; i < 4; ++i) { const float gt = acc[ai][0][m][n][i] * in_scale, up = acc[ai][1][m][n][i] * in_scale;
                        a[n * 4 + i] = gt * __builtin_amdgcn_rcpf(1.f + __builtin_amdgcn_exp2f(-1.4426950408889634f * gt)) * up * out_scale; }
                typedef int i32x2 __attribute__((ext_vector_type(2)));
                *(i32x2*)(O + (size_t)(row0 + ai * HALF + m * 16) * ldc + col0) = (i32x2){pk4_fp8(a[0], a[1], a[2], a[3]), pk4_fp8(a[4], a[5], a[6], a[7])}; asm volatile("" ::: "memory"); }
    }
};
struct EpiFp8 {
    static constexpr bool PERM = true, AFTER_DRAIN = false;
    unsigned char* O; int ldc; float scale;
    __device__ __forceinline__ void operator()(const f32x4 (&acc)[2][2][4][2], const Unit& u, int wr, int wc, int fr, int fq) const {
        const int row0 = u.pm * BM + wr * 64 + fr, col0 = u.pn * BM + wc * 32 + 8 * fq;
        typedef int i32x2 __attribute__((ext_vector_type(2)));
#pragma unroll
        for (int ai = 0; ai < 2; ++ai)
#pragma unroll
            for (int m = 0; m < 4; ++m)
#pragma unroll
                for (int bj = 0; bj < 2; ++bj) { const f32x4 v0 = acc[ai][bj][m][0] * scale, v1 = acc[ai][bj][m][1] * scale;
                    *(i32x2*)(O + (size_t)(row0 + ai * HALF + m * 16) * ldc + col0 + bj * HALF) = (i32x2){pk4_fp8(v0[0], v0[1], v0[2], v0[3]), pk4_fp8(v1[0], v1[1], v1[2], v1[3])}; asm volatile("" ::: "memory"); }
    }
};

template <class Epi, class Sched, bool ALIGN_EPI = false, bool SP2 = false, bool GATHER = false, int BAUX = 0, bool FP8 = false>
__device__ __forceinline__ void gemm_phase(PG8_LAS unsigned char* lds, const Gemm g, const Sched& S, const Epi& E, const int wv) {
    int tid = (wv << 6) | LANE_ID(); asm volatile("" : "+v"(tid));
    const int wid = __builtin_amdgcn_readfirstlane(tid >> 6), lane = tid & 63, wr = wid >> 2, wc = wid & 3, fr = lane & 15, fq = lane >> 4;
    static_assert(!GATHER || SP2, "gathered A rows: SP2 loop only");
    int kl_ = g.KL; asm volatile("" : "+s"(kl_));
    const int K = g.K, nt = kl_ / BK;
    unsigned voffA[2], voffB[2], gC2[2]; int gR[2];
#pragma unroll
    for (int i = 0; i < 2; ++i) { int R, C; stage_rc(tid * 16 + i * 8192, R, C); const int Rb = Epi::PERM ? ((R & ~31) + perm32(R & 31)) : R;
        voffA[i] = (unsigned)(R * K + C) * 2u; voffB[i] = (unsigned)(Rb * K + C) * 2u; gR[i] = R; gC2[i] = (unsigned)C * 2u; }
    unsigned vC[2][2], vN[2][2];
    const size_t kstep = (size_t)(BK * 2);
    const size_t hstep = (size_t)HALF * K * 2;
    const size_t tstep = 2 * hstep;
    const unsigned ldsw = (unsigned)wid * 1024u;
    const int aoff = lds_byte(wr * 64 + fr, fq * 8), boff = lds_byte(wc * 32 + fr, fq * 8);
#define PG8_SA(b, h) (((b) * 2 + (h)) * HTB)
#define PG8_SB(b, h) ((4 + (b) * 2 + (h)) * HTB)
#define PG8_STAGE(bufoff, gbase, voff) do { _Pragma("unroll") for (int _i = 0; _i < 2; ++_i) \
        __builtin_amdgcn_global_load_lds((const unsigned*)((const char*)(gbase) + (voff)[_i]), (PG8_LAS unsigned*)(lds + (bufoff) + ldsw + _i * 8192), 16, 0, 0); } while (0)
#define PG8_STAGE_A(bufoff, ptr, h, VS) do { if constexpr (GATHER) { PG8_STAGE(bufoff, ptr, VS[h]); } else { PG8_STAGE(bufoff, (ptr) + ((h) ? hstep : 0), voffA); } } while (0)
#define PG8_STAGE_B(bufoff, gbase, voff) do { _Pragma("unroll") for (int _i = 0; _i < 2; ++_i) \
        __builtin_amdgcn_global_load_lds((const unsigned*)((const char*)(gbase) + (voff)[_i]), (PG8_LAS unsigned*)(lds + (bufoff) + ldsw + _i * 8192), 16, 0, BAUX); } while (0)
#define PG8_LDA(dst, b, h) do { _Pragma("unroll") for (int m = 0; m < 4; ++m) _Pragma("unroll") for (int k = 0; k < 2; ++k) dst[m][k] = *(const PG8_LAS bf16x8*)(lds + PG8_SA(b, h) + aoff + m * 2048 + k * 1024); } while (0)
#define PG8_LDB(dst, b, h) do { _Pragma("unroll") for (int n = 0; n < 2; ++n) _Pragma("unroll") for (int k = 0; k < 2; ++k) dst[n][k] = *(const PG8_LAS bf16x8*)(lds + PG8_SB(b, h) + boff + n * 2048 + k * 1024); } while (0)
#define PG8_MMA(ai, bj, At, Bt) do { __builtin_amdgcn_s_setprio(1); _Pragma("unroll") for (int m = 0; m < 4; ++m) _Pragma("unroll") for (int n = 0; n < 2; ++n) { \
        if constexpr (FP8) { _Pragma("unroll") for (int k = 0; k < 2; ++k) { const l2_t a2 = __builtin_bit_cast(l2_t, At[m][k]), b2 = __builtin_bit_cast(l2_t, Bt[n][k]); \
                acc[ai][bj][m][n] = __builtin_amdgcn_mfma_f32_16x16x32_fp8_fp8(b2[0], a2[0], acc[ai][bj][m][n], 0, 0, 0); \
                acc[ai][bj][m][n] = __builtin_amdgcn_mfma_f32_16x16x32_fp8_fp8(b2[1], a2[1], acc[ai][bj][m][n], 0, 0, 0); } } \
        else { _Pragma("unroll") for (int k = 0; k < 2; ++k) acc[ai][bj][m][n] = __builtin_amdgcn_mfma_f32_16x16x32_bf16(Bt[n][k], At[m][k], acc[ai][bj][m][n], 0, 0, 0); } } \
        __builtin_amdgcn_s_setprio(0); } while (0)
#define PG8_WAIT_V(n) asm volatile("s_waitcnt vmcnt(" #n ")" ::: "memory")
#define PG8_WAIT_L(n) asm volatile("s_waitcnt lgkmcnt(" #n ")" ::: "memory")
#define PG8_BAR __builtin_amdgcn_s_barrier()
#define PG8_SCHED __builtin_amdgcn_sched_barrier(0)
    Unit cur, nxt; int ui = 0;
    if (!S.next(0, cur)) return;
    f32x4 acc[2][2][4][2];
#pragma unroll
    for (int a = 0; a < 2; ++a)
#pragma unroll
        for (int b = 0; b < 2; ++b)
#pragma unroll
            for (int m = 0; m < 4; ++m)
#pragma unroll
                for (int n = 0; n < 2; ++n) acc[a][b][m][n] = (f32x4){0.f, 0.f, 0.f, 0.f};
    bf16x8 At[4][2], B0[2][2], B1[2][2];
    const char* cA = (const char*)g.A + cur.ao; const char* cB = (const char*)g.Bt + cur.bo;
    if constexpr (GATHER) {
#pragma unroll
        for (int h = 0; h < 2; ++h)
#pragma unroll
            for (int i = 0; i < 2; ++i) { vC[h][i] = (unsigned)S.tok(0, gR[i] + HALF * h) * (unsigned)g.lda + gC2[i]; vN[h][i] = vC[h][i]; } }
    S.a_ready(cur);
    if constexpr (SP2) {
        PG8_STAGE_B(PG8_SB(0, 0), cB, voffB); PG8_STAGE_B(PG8_SB(0, 1), cB + hstep, voffB); PG8_STAGE_A(PG8_SA(0, 0), cA, 0, vC); PG8_STAGE_A(PG8_SA(0, 1), cA, 1, vC);
        if (wr == 1) PG8_BAR;
        PG8_WAIT_V(2); PG8_BAR;
        PG8_STAGE_B(PG8_SB(1, 0), cB + kstep, voffB); PG8_STAGE_A(PG8_SA(1, 0), cA + kstep, 0, vC); PG8_STAGE_B(PG8_SB(1, 1), cB + hstep + kstep, voffB);
        PG8_WAIT_V(6); PG8_BAR;
    } else {
        PG8_STAGE_B(PG8_SB(0, 0), cB, voffB); PG8_STAGE(PG8_SA(0, 0), cA, voffA); PG8_STAGE_B(PG8_SB(0, 1), cB + hstep, voffB); PG8_STAGE(PG8_SA(0, 1), cA + hstep, voffA);
        if (wr == 1) PG8_BAR;
        PG8_WAIT_V(4); PG8_BAR;
        PG8_STAGE_B(PG8_SB(1, 0), cB + kstep, voffB); PG8_STAGE(PG8_SA(1, 0), cA + kstep, voffA); PG8_STAGE_B(PG8_SB(1, 1), cB + hstep + kstep, voffB);
        PG8_WAIT_V(6); PG8_BAR;
    }
    for (;;) {
        const bool has_next = S.next(ui + 1, nxt);
        const char* nA = has_next ? (const char*)g.A + nxt.ao : cA; const char* nB = has_next ? (const char*)g.Bt + nxt.bo : cB;
        if constexpr (GATHER) { if (has_next) {
#pragma unroll
            for (int h = 0; h < 2; ++h)
#pragma unroll
                for (int i = 0; i < 2; ++i) vN[h][i] = (unsigned)S.tok(ui + 1, gR[i] + HALF * h) * (unsigned)g.lda + gC2[i]; } }
        for (int t = 0; t < nt; t += 2) {
            const bool last = (t == nt - 2);
            const char* a1 = cA + (size_t)(t + 1) * kstep;
            const char* a2 = last ? nA : cA + (size_t)(t + 2) * kstep; const char* b2 = last ? nB : cB + (size_t)(t + 2) * kstep;
            const char* a3 = a2 + kstep; const char* b3 = b2 + kstep;
            if (last && has_next) S.a_ready(nxt);
            unsigned v2[2][2];
            if constexpr (GATHER) { const bool un = last && has_next;
#pragma unroll
                for (int h = 0; h < 2; ++h)
#pragma unroll
                    for (int i = 0; i < 2; ++i) v2[h][i] = un ? vN[h][i] : vC[h][i]; }
            if constexpr (SP2) {
            PG8_LDB(B0, 0, 0); PG8_LDB(B1, 0, 1); PG8_SCHED; PG8_LDA(At, 0, 0); PG8_STAGE_A(PG8_SA(1, 1), a1, 1, vC);
            PG8_WAIT_V(8); PG8_WAIT_L(0); PG8_BAR; PG8_MMA(0, 0, At, B0); PG8_MMA(0, 1, At, B1); PG8_BAR; PG8_SCHED;
            PG8_LDA(At, 0, 1); PG8_STAGE_B(PG8_SB(0, 0), b2, voffB); PG8_STAGE_B(PG8_SB(0, 1), b2 + hstep, voffB); PG8_STAGE_A(PG8_SA(0, 0), a2, 0, v2);
            PG8_WAIT_V(8); PG8_WAIT_L(0); PG8_BAR; PG8_MMA(1, 0, At, B0); PG8_MMA(1, 1, At, B1); PG8_BAR; PG8_SCHED;
            PG8_LDB(B0, 1, 0); PG8_LDB(B1, 1, 1); PG8_SCHED; PG8_LDA(At, 1, 0); PG8_STAGE_A(PG8_SA(0, 1), a2, 1, v2);
            PG8_WAIT_V(8); PG8_WAIT_L(0); PG8_BAR; PG8_MMA(0, 0, At, B0); PG8_MMA(0, 1, At, B1); PG8_BAR; PG8_SCHED;
            PG8_LDA(At, 1, 1); PG8_STAGE_B(PG8_SB(1, 0), b3, voffB); PG8_STAGE_B(PG8_SB(1, 1), b3 + hstep, voffB); PG8_STAGE_A(PG8_SA(1, 0), a3, 0, v2);
            PG8_WAIT_V(8); PG8_WAIT_L(0); PG8_BAR; PG8_MMA(1, 0, At, B0); PG8_MMA(1, 1, At, B1); PG8_BAR; PG8_SCHED;
            } else {
            PG8_LDB(B0, 0, 0); PG8_SCHED; PG8_LDA(At, 0, 0); PG8_STAGE(PG8_SA(1, 1), a1 + hstep, voffA);
            PG8_WAIT_L(8); PG8_BAR; PG8_WAIT_L(0); PG8_MMA(0, 0, At, B0); PG8_BAR; PG8_SCHED;
            PG8_LDB(B1, 0, 1); PG8_STAGE_B(PG8_SB(0, 0), b2, voffB);
            PG8_BAR; PG8_WAIT_L(0); PG8_MMA(0, 1, At, B1); PG8_BAR;
            PG8_LDA(At, 0, 1); PG8_STAGE(PG8_SA(0, 0), a2, voffA);
            PG8_BAR; PG8_WAIT_L(0); PG8_MMA(1, 0, At, B0); PG8_BAR; PG8_SCHED;
            PG8_STAGE_B(PG8_SB(0, 1), b2 + hstep, voffB);
            PG8_WAIT_V(6); PG8_BAR; PG8_MMA(1, 1, At, B1); PG8_BAR;
            PG8_LDB(B0, 1, 0); PG8_SCHED; PG8_LDA(At, 1, 0); PG8_STAGE(PG8_SA(0, 1), a2 + hstep, voffA);
            PG8_WAIT_L(8); PG8_BAR; PG8_WAIT_L(0); PG8_MMA(0, 0, At, B0); PG8_BAR; PG8_SCHED;
            PG8_LDB(B1, 1, 1); PG8_STAGE_B(PG8_SB(1, 0), b3, voffB);
            PG8_BAR; PG8_WAIT_L(0); PG8_MMA(0, 1, At, B1); PG8_BAR;
            PG8_LDA(At, 1, 1); PG8_STAGE(PG8_SA(1, 0), a3, voffA);
            PG8_BAR; PG8_WAIT_L(0); PG8_MMA(1, 0, At, B0); PG8_BAR; PG8_SCHED;
            PG8_STAGE_B(PG8_SB(1, 1), b3 + hstep, voffB);
            PG8_WAIT_V(6); PG8_BAR; PG8_MMA(1, 1, At, B1); PG8_BAR;
            }
        }
        if constexpr (ALIGN_EPI) { if (wr == 0) PG8_BAR; }
        if constexpr (!Epi::AFTER_DRAIN) { E(acc, cur, wr, wc, fr, fq); S.done(cur); }
        if (!has_next) break;
#pragma unroll
        for (int a = 0; a < 2; ++a)
#pragma unroll
            for (int b = 0; b < 2; ++b)
#pragma unroll
                for (int m = 0; m < 4; ++m)
#pragma unroll
                    for (int n = 0; n < 2; ++n) acc[a][b][m][n] = (f32x4){0.f, 0.f, 0.f, 0.f};
        cur = nxt; cA = nA; cB = nB; ++ui;
        if constexpr (GATHER) {
#pragma unroll
            for (int h = 0; h < 2; ++h)
#pragma unroll
                for (int i = 0; i < 2; ++i) vC[h][i] = vN[h][i]; }
        if constexpr (ALIGN_EPI) { if (wr == 1) PG8_BAR; }
    }
    PG8_WAIT_V(0);
    if constexpr (!ALIGN_EPI) { if (wr == 0) PG8_BAR; }
    PG8_BAR;
    if constexpr (Epi::AFTER_DRAIN) { E.fused(acc, cur, wr, wc, fr, fq, lds, wid, lane); S.done(cur); }
#undef PG8_SA
#undef PG8_SB
#undef PG8_STAGE
#undef PG8_STAGE_B
#undef PG8_STAGE_A
#undef PG8_LDA
#undef PG8_LDB
#undef PG8_MMA
#undef PG8_WAIT_V
#undef PG8_WAIT_L
#undef PG8_BAR
#undef PG8_SCHED
}
}

namespace fa {
constexpr int D = 128, QBLK = 32, KVBLK = 64, QB = 256;
constexpr float SCALE = 0.08838834764831845f;
constexpr float THR = 8.f;
constexpr int SHM_K = KVBLK * D * 2, SHM_V = KVBLK * D * 2;
constexpr int OFF_V = 0, OFF_K = SHM_V, OFF_B = SHM_V + SHM_K, ATT_BUF = OFF_B + 256  , OFF_W = 2 * ATT_BUF, ATT_LDS = OFF_W + 8 * 64 * 4;
#define KSWZ(row, colB) ((row) * 256 + ((colB) ^ (((row) & 7) << 4)))
#define SBAR() __builtin_amdgcn_sched_barrier(0)
__device__ __forceinline__ int v_st(int k, int c) { const int kk = (k & ~0xC) | ((k & 4) << 1) | ((k & 8) >> 1); return ((kk >> 3) * 4 + (c >> 5)) * 512 + ((kk & 7) * 32 + (c & 31)) * 2; }
__device__ __forceinline__ int v_rd_base(int lane) { return ((lane & 3) << 3) | (((lane >> 2) & 3) << 6) | (((lane >> 4) & 1) << 5) | (((lane >> 5) & 1) << 8); }
constexpr int v_rd_off(int d0, int ks, int half) { return d0 * 512 + ks * 4096 + half * 2048; }
__device__ __forceinline__ int crow(int r, int hi) { return (r & 3) + 8 * (r >> 2) + 4 * hi; }
__device__ __forceinline__ unsigned cvtpk(float lo, float hi) { unsigned r; asm volatile("v_cvt_pk_bf16_f32 %0, %1, %2" : "=v"(r) : "v"(lo), "v"(hi)); return r; }
__device__ __forceinline__ void mask_tile(f32x16& p0, f32x16& p1, int dq) {
    const float NEG = -__builtin_inff();
#pragma unroll
    for (int r = 0; r < 16; ++r) {
        const int c = (r & 3) + 8 * (r >> 2);
        if (dq - c < 0) p0[r] = NEG;
        if (dq - c - 32 < 0) p1[r] = NEG;
    }
}
__device__ __forceinline__ void partialSM(f32x16& p0, f32x16& p1, float& m_reg, float& mn, float& alpha) {
    float pmax = p0[0];
#pragma unroll
    for (int r = 1; r < 16; ++r) pmax = fmaxf(pmax, p0[r]);
#pragma unroll
    for (int r = 0; r < 16; ++r) pmax = fmaxf(pmax, p1[r]);
    { auto rr = __builtin_amdgcn_permlane32_swap(__float_as_uint(pmax), __float_as_uint(pmax), false, false);
      pmax = fmaxf(__uint_as_float(rr[0]), __uint_as_float(rr[1])); }
    constexpr float C2 = 1.4426950408889634f * SCALE;
    if (__builtin_expect(__all((pmax - m_reg) * SCALE <= THR), 1)) { mn = m_reg; alpha = 1.f; }
    else { mn = fmaxf(m_reg, pmax); alpha = __builtin_amdgcn_exp2f((m_reg - mn) * C2); m_reg = mn; }
    const float mnL = -mn * C2;
#pragma unroll
    for (int r = 0; r < 16; ++r) p0[r] = fmaf(p0[r], C2, mnL);
#pragma unroll
    for (int r = 0; r < 16; ++r) p1[r] = fmaf(p1[r], C2, mnL);
#pragma unroll
    for (int r = 0; r < 16; ++r) p0[r] = __builtin_amdgcn_exp2f(p0[r]);
}
__device__ __forceinline__ void finishSM(f32x16& p0, f32x16& p1, float alpha, float& l_reg, bf16x8& pa0, bf16x8& pa1, bf16x8& pa2, bf16x8& pa3) {
#pragma unroll
    for (int r = 0; r < 16; ++r) p1[r] = __builtin_amdgcn_exp2f(p1[r]);
    float ps = 0;
#pragma unroll
    for (int r = 0; r < 16; ++r) ps += p0[r];
#pragma unroll
    for (int r = 0; r < 16; ++r) ps += p1[r];
    { auto rr = __builtin_amdgcn_permlane32_swap(__float_as_uint(ps), __float_as_uint(ps), false, false);
      ps = __uint_as_float(rr[0]) + __uint_as_float(rr[1]); }
    l_reg = l_reg * alpha + ps;
#define PK4(P, B_, OUT) do { unsigned a0 = cvtpk(P[B_+0], P[B_+1]), a1 = cvtpk(P[B_+2], P[B_+3]);                          \
        unsigned b0 = cvtpk(P[B_+4], P[B_+5]), b1 = cvtpk(P[B_+6], P[B_+7]);                                             \
        auto r0 = __builtin_amdgcn_permlane32_swap(a0, b0, false, false); auto r1 = __builtin_amdgcn_permlane32_swap(a1, b1, false, false); \
        v4u w = {r0[0], r1[0], r0[1], r1[1]}; OUT = *reinterpret_cast<bf16x8*>(&w); } while (0)
    PK4(p0, 0, pa0); PK4(p0, 8, pa1); PK4(p1, 0, pa2); PK4(p1, 8, pa3);
#undef PK4
}
__device__ __forceinline__ void qkt(f32x16& p0, f32x16& p1, const char* K_lds, const float* b_lds, int r32, int hi, const bf16x8* qr) {
#pragma unroll
    for (int g = 0; g < 4; ++g) { const f32x4 a = *(const f32x4*)(b_lds + 8 * g + 4 * hi), b = *(const f32x4*)(b_lds + 32 + 8 * g + 4 * hi);
#pragma unroll
        for (int i = 0; i < 4; ++i) { p0[4 * g + i] = a[i]; p1[4 * g + i] = b[i]; } }
    const char* kb[4];
#pragma unroll
    for (int dd = 0; dd < 4; ++dd) kb[dd] = K_lds + KSWZ(r32, (dd * 16 + hi * 8) * 2);
#pragma unroll
    for (int d0 = 0; d0 < 8; ++d0) { const char* a = kb[d0 & 3] + (d0 >> 2) * 128;
        bf16x8 b0 = *reinterpret_cast<const bf16x8*>(a);
        bf16x8 b1 = *reinterpret_cast<const bf16x8*>(a + 32 * 256);
        p0 = __builtin_amdgcn_mfma_f32_32x32x16_bf16(b0, qr[d0], p0, 0, 0, 0);
        p1 = __builtin_amdgcn_mfma_f32_32x32x16_bf16(b1, qr[d0], p1, 0, 0, 0); }
}
__device__ __forceinline__ void pv_tile(f32x16* o, int vb0, bf16x8 pa0, bf16x8 pa1, bf16x8 pa2, bf16x8 pa3) {
#define TRRD(dst, off) asm volatile("ds_read_b64_tr_b16 %0, %1 offset:%2" : "=&v"(dst) : "v"(vb0), "i"(off) : "memory")
#define PV_D0(d0) do { s16x4 l0, l1, l2, l3, h0, h1, h2, h3; constexpr int b_ = v_rd_off(d0, 0, 0);   \
        TRRD(l0, b_); TRRD(h0, b_ + 2048); TRRD(l1, b_ + 4096); TRRD(h1, b_ + 6144); TRRD(l2, b_ + 8192); TRRD(h2, b_ + 10240); TRRD(l3, b_ + 12288); TRRD(h3, b_ + 14336); \
        asm volatile("s_waitcnt lgkmcnt(0)" ::: "memory"); SBAR();                                                       \
        o[d0] = __builtin_amdgcn_mfma_f32_32x32x16_bf16(pa0, (bf16x8){l0[0], l0[1], l0[2], l0[3], h0[0], h0[1], h0[2], h0[3]}, o[d0], 0, 0, 0);   \
        o[d0] = __builtin_amdgcn_mfma_f32_32x32x16_bf16(pa1, (bf16x8){l1[0], l1[1], l1[2], l1[3], h1[0], h1[1], h1[2], h1[3]}, o[d0], 0, 0, 0);   \
        o[d0] = __builtin_amdgcn_mfma_f32_32x32x16_bf16(pa2, (bf16x8){l2[0], l2[1], l2[2], l2[3], h2[0], h2[1], h2[2], h2[3]}, o[d0], 0, 0, 0);   \
        o[d0] = __builtin_amdgcn_mfma_f32_32x32x16_bf16(pa3, (bf16x8){l3[0], l3[1], l3[2], l3[3], h3[0], h3[1], h3[2], h3[3]}, o[d0], 0, 0, 0); } while (0)
    PV_D0(0); PV_D0(1); PV_D0(2); PV_D0(3);
#undef PV_D0
#undef TRRD
}
}

namespace fa2 {
using namespace fa;
constexpr int PIN = 128, POUT = 2048, NW = 8;
constexpr int O2_V = 0, O2_K = 2 * SHM_V, O2_W = 2 * SHM_V + 2 * SHM_K, O2_B = O2_W + NW * 64 * 4, O2_Q = O2_B + 2 * 64 * 4, ATT2_LDS = O2_Q + NW * 8192;
__device__ __forceinline__ void mask_causal(f32x16& p0, f32x16& p1, int dq) {
    const float NEG = -__builtin_inff();
#pragma unroll
    for (int r = 0; r < 16; ++r) { const int c = (r & 3) + 8 * (r >> 2); if (dq - c < 0) p0[r] = NEG; if (dq - c - 32 < 0) p1[r] = NEG; }
}
template <int KB>
__device__ __forceinline__ void qkt(f32x16& p0, f32x16& p1, const char* K_lds, const float* b_lds, int r32, int hi, const char* qf) {
    { const float* bb = b_lds + KB * 64;
#pragma unroll
      for (int g = 0; g < 4; ++g) { const f32x4 a = *(const f32x4*)(bb + 8 * g + 4 * hi), b = *(const f32x4*)(bb + 32 + 8 * g + 4 * hi);
#pragma unroll
          for (int i = 0; i < 4; ++i) { p0[4 * g + i] = a[i]; p1[4 * g + i] = b[i]; } } }
    const char* kb[4];
#pragma unroll
    for (int dd = 0; dd < 4; ++dd) kb[dd] = K_lds + KB * SHM_K + KSWZ(r32, (dd * 16 + hi * 8) * 2);
#pragma unroll
    for (int d0 = 0; d0 < 8; ++d0) { const char* a = kb[d0 & 3] + (d0 >> 2) * 128;
        bf16x8 b0 = *reinterpret_cast<const bf16x8*>(a);
        bf16x8 b1 = *reinterpret_cast<const bf16x8*>(a + 32 * 256);
        const bf16x8 q = *reinterpret_cast<const bf16x8*>(qf + d0 * 1024);
        p0 = __builtin_amdgcn_mfma_f32_32x32x16_bf16(b0, q, p0, 0, 0, 0);
        p1 = __builtin_amdgcn_mfma_f32_32x32x16_bf16(b1, q, p1, 0, 0, 0); }
}
template <int VB>
__device__ __forceinline__ void pv_tile(f32x16* o, int vb0, bf16x8 pa0, bf16x8 pa1, bf16x8 pa2, bf16x8 pa3) {
#define TRRD(dst, off) asm volatile("ds_read_b64_tr_b16 %0, %1 offset:%2" : "=&v"(dst) : "v"(vb0), "i"(off) : "memory")
#define PV_D0(d0) do { s16x4 l0, l1, l2, l3, h0, h1, h2, h3; constexpr int b_ = VB * SHM_V + v_rd_off(d0, 0, 0);   \
        TRRD(l0, b_); TRRD(h0, b_ + 2048); TRRD(l1, b_ + 4096); TRRD(h1, b_ + 6144); TRRD(l2, b_ + 8192); TRRD(h2, b_ + 10240); TRRD(l3, b_ + 12288); TRRD(h3, b_ + 14336); \
        asm volatile("s_waitcnt lgkmcnt(0)" ::: "memory"); SBAR();                                                       \
        o[d0] = __builtin_amdgcn_mfma_f32_32x32x16_bf16(pa0, (bf16x8){l0[0], l0[1], l0[2], l0[3], h0[0], h0[1], h0[2], h0[3]}, o[d0], 0, 0, 0);   \
        o[d0] = __builtin_amdgcn_mfma_f32_32x32x16_bf16(pa1, (bf16x8){l1[0], l1[1], l1[2], l1[3], h1[0], h1[1], h1[2], h1[3]}, o[d0], 0, 0, 0);   \
        o[d0] = __builtin_amdgcn_mfma_f32_32x32x16_bf16(pa2, (bf16x8){l2[0], l2[1], l2[2], l2[3], h2[0], h2[1], h2[2], h2[3]}, o[d0], 0, 0, 0);   \
        o[d0] = __builtin_amdgcn_mfma_f32_32x32x16_bf16(pa3, (bf16x8){l3[0], l3[1], l3[2], l3[3], h3[0], h3[1], h3[2], h3[3]}, o[d0], 0, 0, 0); } while (0)
    PV_D0(0); PV_D0(1); PV_D0(2); PV_D0(3);
#undef PV_D0
#undef TRRD
}
struct BlockRef { const bf16* Q; const bf16* K; const bf16* V; bf16* O; const float* C; int P0, jlo; float cf; };
struct Seam { bf16x8 st_v0, st_v1, st_k0, st_k1; float st_b; };
#define A2_LD(p, k0, off32) (*(const bf16x8*)((const char*)(p) + (size_t)(k0) * (PIN * 2) + (off32)))
#define A2_VMW() asm volatile("s_waitcnt vmcnt(0)" ::: "memory")
#define A2_VMWN(n) asm volatile("s_waitcnt vmcnt(%0)" :: "i"(n) : "memory")
#define A2_SLOAD(R_, k0) do { S.st_v0 = A2_LD((R_).V, k0, go0); S.st_v1 = A2_LD((R_).V, k0, go1);              \
                              S.st_k0 = A2_LD((R_).K, k0, go0); S.st_k1 = A2_LD((R_).K, k0, go1); \
                              if (tid < 64) S.st_b = ((R_).cf - (R_).C[(k0) + tid]) * (1.0f / SCALE); } while (0)
#define A2_SWRITE_K(bf) do { *(bf16x8*)(K_lds + (bf) * SHM_K + kws) = S.st_k0; *(bf16x8*)(K_lds + (bf) * SHM_K + kws + 32 * 256) = S.st_k1; if (tid < 64) b_lds[(bf) * 64 + tid] = S.st_b; } while (0)
#define A2_SWRITE_V(bf) do { *(bf16x8*)(V_lds + (bf) * SHM_V + vst0) = S.st_v0; *(bf16x8*)(V_lds + (bf) * SHM_V + vst1) = S.st_v1; } while (0)
#define A2_SWRITE(bf) do { A2_SWRITE_V(bf); A2_SWRITE_K(bf); } while (0)
__device__ __forceinline__ void prime(const BlockRef& cur, char* lds, Seam& S, int tid) {
    const int wid = __builtin_amdgcn_readfirstlane(tid >> 6), lane = tid & 63, r32 = lane & 31, hi = lane >> 5;
    const int sr = tid >> 4, sc = (tid & 15) * 8, kws = KSWZ(sr, sc * 2); char* K_lds = lds + O2_K; float* b_lds = (float*)(lds + O2_B);
    const unsigned go0 = (unsigned)(sr * PIN + sc) * 2u, go1 = go0 + 32u * PIN * 2u, qo = (unsigned)(r32 * PIN + hi * 8) * 2u;
    const int kb0 = cur.jlo * KVBLK;
    { bf16x8 qr[8]; char* qf = lds + O2_Q + wid * 8192 + lane * 16;
#pragma unroll
      for (int d0 = 0; d0 < 8; ++d0) qr[d0] = *(const bf16x8*)((const char*)cur.Q + (size_t)(wid * QBLK) * (PIN * 2) + qo + d0 * 32);
      A2_SLOAD(cur, kb0); A2_VMW(); A2_SWRITE_K(0);
#pragma unroll
      for (int d0 = 0; d0 < 8; ++d0) *(bf16x8*)(qf + d0 * 1024) = qr[d0]; }
    __syncthreads();
}
__device__ __forceinline__ void block(const BlockRef& cur, char* lds, Seam& S, int tid) {
    const int wid = __builtin_amdgcn_readfirstlane(tid >> 6), lane = tid & 63, r32 = lane & 31, hi = lane >> 5;
    const int j_lo = cur.jlo, j_hi = (cur.P0 + QB - 1) / KVBLK + 1;
    const int NT = j_hi - j_lo;
    const int qlo = cur.P0 + wid * QBLK, qm = qlo + r32 - 4 * hi;
    char* V_lds = lds + O2_V; char* K_lds = lds + O2_K; float* b_lds = (float*)(lds + O2_B);
    float* ws = (float*)(lds + O2_W) + wid * 64; float* li_l = ws, * al_l = ws + 32;
    float m_reg = -1e30f, l_reg = 0; f32x16 o[4] = {};
    const int sr = tid >> 4, sc = (tid & 15) * 8, vst0 = v_st(sr, sc), vst1 = v_st(32 + sr, sc), kws = KSWZ(sr, sc * 2);
    const int vb0 = (int)(uintptr_t)V_lds + v_rd_base(lane);
    const unsigned go0 = (unsigned)(sr * PIN + sc) * 2u, go1 = go0 + 32u * PIN * 2u;
    const char* qf = lds + O2_Q + wid * 8192 + lane * 16;
#define RESC(a) do { if (__any((a) < 1.f)) { if (hi == 0) al_l[r32] = (a); asm volatile("s_waitcnt lgkmcnt(0)" ::: "memory");              \
                     for (int d_ = 0; d_ < 4; ++d_) for (int r = 0; r < 16; ++r) o[d_][r] *= al_l[crow(r, hi)]; } } while (0)
#define KBASE(t) ((j_lo + (t)) * KVBLK)
#define MASKT(P0_, P1_, t) do { const int kb_ = KBASE(t); if (kb_ + KVBLK - 1 > qlo) mask_causal(P0_, P1_, qm - kb_); } while (0)
    f32x16 pA0, pA1, pB0, pB1; float mnA, mnB, alA, alB; bf16x8 pa0, pa1, pa2, pa3;
    A2_SWRITE_V(0); SBAR();
    if (NT > 1) A2_SLOAD(cur, KBASE(1));
    SBAR(); qkt<0>(pA0, pA1, K_lds, b_lds, r32, hi, qf);
    MASKT(pA0, pA1, 0); partialSM(pA0, pA1, m_reg, mnA, alA);
    if (NT > 1) { A2_VMW(); A2_SWRITE(1); }
    __syncthreads();
#define HALF_STEP(PX0, PX1, mnX, alX, PY0, PY1, alY, t, KB, VB, SB) do {                                                      \
        SBAR(); qkt<KB>(PX0, PX1, K_lds, b_lds, r32, hi, qf);                                                               \
        finishSM(PY0, PY1, alY, l_reg, pa0, pa1, pa2, pa3); SBAR();                                                           \
        if ((t) + 1 < NT) { A2_SLOAD(cur, KBASE((t) + 1)); SBAR(); }                                                          \
        pv_tile<VB>(o, vb0, pa0, pa1, pa2, pa3); MASKT(PX0, PX1, (t)); partialSM(PX0, PX1, m_reg, mnX, alX);                  \
        __syncthreads();                                                                                                      \
        if ((t) + 1 < NT) { A2_VMW(); A2_SWRITE(SB); }                                                                        \
        RESC(alX); __syncthreads(); } while (0)
    for (int t = 1; t + 1 < NT; t += 2) {
        HALF_STEP(pB0, pB1, mnB, alB, pA0, pA1, alA, t, 1, 0, 0);
        HALF_STEP(pA0, pA1, mnA, alA, pB0, pB1, alB, t + 1, 0, 1, 1);
    }
    const bool even = (NT & 1) == 0;
    if (even) { SBAR(); qkt<1>(pB0, pB1, K_lds, b_lds, r32, hi, qf); SBAR(); }
    finishSM(pA0, pA1, alA, l_reg, pa0, pa1, pa2, pa3); SBAR();
    pv_tile<0>(o, vb0, pa0, pa1, pa2, pa3);
    if (even) { MASKT(pB0, pB1, NT - 1); partialSM(pB0, pB1, m_reg, mnB, alB); __syncthreads(); RESC(alB);
        finishSM(pB0, pB1, alB, l_reg, pa0, pa1, pa2, pa3); SBAR(); pv_tile<1>(o, vb0, pa0, pa1, pa2, pa3); }
    if (hi == 0) li_l[r32] = l_reg; asm volatile("s_waitcnt lgkmcnt(0)" ::: "memory");
    char* Ob = (char*)(cur.O + (size_t)(wid * QBLK) * POUT); const unsigned oo = (unsigned)(4 * hi * POUT + r32) * 2u;
#pragma unroll
    for (int r = 0; r < 16; ++r) { const float rl = __builtin_amdgcn_rcpf(li_l[crow(r, hi)]);
#pragma unroll
        for (int d0 = 0; d0 < 4; ++d0) { const float v = o[d0][r] * rl; const float vn = __shfl_xor(v, 1);
            if ((r32 & 1) == 0) *(unsigned*)(Ob + (size_t)(((r & 3) + 8 * (r >> 2)) * POUT * 2 + d0 * 64) + oo) = cvtpk(v, vn); } }
    __syncthreads();
#undef RESC
#undef KBASE
#undef MASKT
#undef HALF_STEP
}
#undef A2_LD
#undef A2_VMW
#undef A2_VMWN
#undef A2_SLOAD
#undef A2_SWRITE_K
#undef A2_SWRITE_V
#undef A2_SWRITE
}

constexpr size_t MiB = 1u << 20;
constexpr size_t WS_CTL = 0, CTL_ZERO_BYTES = 1 * MiB;
constexpr size_t WS_MODP = 1 * MiB;
constexpr size_t WS_MODF = 2 * MiB;
constexpr size_t WS_LS = 3 * MiB;
constexpr size_t WS_CUM = 4 * MiB;
constexpr size_t WS_MAXQK = 5 * MiB;
constexpr size_t WS_ROUTE = 6 * MiB;
constexpr size_t WS_LOGIT = 1298 * MiB;
constexpr size_t WS_TOKTAB = 1330 * MiB;
constexpr size_t WS_ROT = 1932 * MiB;
constexpr size_t WS_WOUT = 18 * MiB;
constexpr size_t WS_WIN = 34 * MiB;
constexpr size_t WS_WGU = 82 * MiB;
constexpr size_t WS_WD = 594 * MiB;
constexpr size_t WS_H = 850 * MiB;
constexpr size_t WS_PROJ = 914 * MiB;
constexpr size_t WS_MIXED = 1106 * MiB;
constexpr size_t WS_X1 = 1170 * MiB;
constexpr size_t WS_ACT = 1490 * MiB;
constexpr size_t WS_YS = 1538 * MiB;
constexpr size_t WS_KVT = 1730 * MiB;
constexpr size_t WS_PREVT = 1778 * MiB;
constexpr size_t WS_H2X = 1802 * MiB;
constexpr size_t WS_RWT2 = 1930 * MiB;
constexpr size_t WS_QKVH = 962 * MiB;
constexpr size_t WS_END = 1936 * MiB;
constexpr int CW_TMO = 0, CW_CODE = 1;
constexpr int CW_BAR = 4096;
constexpr int CW_CNT = 8192;
constexpr int CW_Q = 8448;
constexpr int CW_QX = 16384 + 1024;
constexpr int RING_OFF = 0, RING_BYTES = 131072;
constexpr int SCR_WAVE = 16640;
constexpr int LDSCTL_OFF = 135168;
constexpr int LDS_TE = LDSCTL_OFF + 256;
constexpr int LDS_OFFS = LDS_TE + 1024;
constexpr int LDS_XT = LDSCTL_OFF + 2048;
constexpr int LDS_TOK = LDSCTL_OFF + 3072;
constexpr int LDS_BYTES = 147456;
constexpr int NWAVES = 8;
#ifndef MOE_FP8
#define MOE_FP8 1
#endif

#define RLX_AGENT __ATOMIC_RELAXED, __HIP_MEMORY_SCOPE_AGENT
#define LDS_WAIT() asm volatile("s_waitcnt lgkmcnt(0)" ::: "memory")
#define VM_WAIT() asm volatile("s_waitcnt vmcnt(0)" ::: "memory")
__device__ __forceinline__ unsigned pk2(float lo, float hi) { unsigned r; asm volatile("v_cvt_pk_bf16_f32 %0, %1, %2" : "=v"(r) : "v"(lo), "v"(hi)); return r; }
__device__ __forceinline__ float bflo(unsigned w) { return __uint_as_float(w << 16); }
__device__ __forceinline__ float bfhi(unsigned w) { return __uint_as_float(w & 0xffff0000u); }
__device__ __forceinline__ float bf1(bf16 h) { return __uint_as_float((unsigned)h << 16); }
__device__ __forceinline__ bf16 f2bf(float f) { return (bf16)(pk2(f, 0.f) & 0xffffu); }
#define DPP_F(v, ctrl) __builtin_bit_cast(float, __builtin_amdgcn_update_dpp(0, __builtin_bit_cast(int, (v)), (ctrl), 0xF, 0xF, true))
#define DPP_I(v, ctrl) __builtin_amdgcn_update_dpp(0, (v), (ctrl), 0xF, 0xF, true)
#define RDL_F(v, l) __builtin_bit_cast(float, __builtin_amdgcn_readlane(__builtin_bit_cast(int, (v)), (l)))
#ifndef DPP_RED
#define DPP_RED 0
#endif
#if !DPP_RED
__device__ __forceinline__ float wave_sum(float v) {
#pragma unroll
    for (int o = 1; o < 64; o <<= 1) v += __shfl_xor(v, o);
    return v;
}
__device__ __forceinline__ float wave_max(float v) {
#pragma unroll
    for (int o = 1; o < 64; o <<= 1) v = fmaxf(v, __shfl_xor(v, o));
    return v;
}
__device__ __forceinline__ int wave_min_i(int v) {
#pragma unroll
    for (int o = 1; o < 64; o <<= 1) { const int w = __shfl_xor(v, o); v = w < v ? w : v; }
    return v;
}
#else
__device__ __forceinline__ float wave_sum(float v) {
    v += DPP_F(v, 0xB1); v += DPP_F(v, 0x4E); v += DPP_F(v, 0x141); v += DPP_F(v, 0x140);
    return (RDL_F(v, 0) + RDL_F(v, 16)) + (RDL_F(v, 32) + RDL_F(v, 48));
}
__device__ __forceinline__ float wave_max(float v) {
    v = fmaxf(v, DPP_F(v, 0xB1)); v = fmaxf(v, DPP_F(v, 0x4E)); v = fmaxf(v, DPP_F(v, 0x141)); v = fmaxf(v, DPP_F(v, 0x140));
    return fmaxf(fmaxf(RDL_F(v, 0), RDL_F(v, 16)), fmaxf(RDL_F(v, 32), RDL_F(v, 48)));
}
__device__ __forceinline__ int wave_min_i(int v) {
    v = min(v, DPP_I(v, 0xB1)); v = min(v, DPP_I(v, 0x4E)); v = min(v, DPP_I(v, 0x141)); v = min(v, DPP_I(v, 0x140));
    return min(min(__builtin_amdgcn_readlane(v, 0), __builtin_amdgcn_readlane(v, 16)), min(__builtin_amdgcn_readlane(v, 32), __builtin_amdgcn_readlane(v, 48)));
}
#endif

#define XB_TMO      128
#define XB_XCNT(j)  (256  + 64 * (j))
#define XB_XSUB(j)  (1280 + 64 * (j))
#define XB_XGEN(j)  (2304 + 64 * (j))
#define XB_TOP      3328
#define XB_TOPGEN   3392
#define XCD_BAR_WORDS 3456
#define XB_SPIN_CAP (1u << 18)

__device__ __forceinline__ unsigned xb_ld(unsigned* p)              { return __hip_atomic_load(p, __ATOMIC_RELAXED, __HIP_MEMORY_SCOPE_AGENT); }
__device__ __forceinline__ unsigned xb_add(unsigned* p, unsigned v) { return __hip_atomic_fetch_add(p, v, __ATOMIC_RELAXED, __HIP_MEMORY_SCOPE_AGENT); }
__device__ __forceinline__ unsigned xb_xcc_id() { return (unsigned)__builtin_amdgcn_s_getreg((3 << 11) | 20) & 0xFu; }
#define XB_SPIN(cond, bar) do { unsigned _sp = 0; while (cond) { __builtin_amdgcn_s_sleep(1); \
    if ((++_sp & 255u) == 0u) { if (xb_ld(&(bar)[XB_TMO])) break; if (_sp > XB_SPIN_CAP) { atomicAdd(&(bar)[XB_TMO], 1u); break; } } } } while (0)

struct XcdBarrier {
    unsigned* bar; unsigned x; unsigned wv;
    volatile LAS unsigned* st;
};

__device__ __forceinline__ XcdBarrier xcd_barrier_post(unsigned* bar, volatile LAS unsigned* st) {
    XcdBarrier b; b.bar = bar; b.x = xb_xcc_id(); b.st = st; b.wv = (unsigned)__builtin_amdgcn_readfirstlane((int)(threadIdx.x >> 6));
    if (threadIdx.x == 0) (void)xb_add(&bar[XB_XCNT(b.x)], 1u);
    return b;
}
__device__ __forceinline__ void xcd_barrier_complete(unsigned* bar, unsigned x, unsigned& nloc, unsigned& nx) {
    const unsigned G = gridDim.x * gridDim.y * gridDim.z;
    unsigned sum, cnt, mine, sp = 0u;
    for (;;) {
        sum = 0u; cnt = 0u; mine = 0u;
#pragma unroll
        for (unsigned j = 0; j < 16; ++j) { const unsigned c = xb_ld(&bar[XB_XCNT(j)]); sum += c; cnt += (c > 0u) ? 1u : 0u; mine = (j == x) ? c : mine; }
        if (sum == G) break;
        __builtin_amdgcn_s_sleep(1);
        if ((++sp & 255u) == 0u) { if (xb_ld(&bar[XB_TMO])) break; if (sp > XB_SPIN_CAP) { atomicAdd(&bar[XB_TMO], 1u); break; } }
    }
    nloc = mine > 0u ? mine : 1u; nx = cnt > 0u ? cnt : 1u;
}

__device__ __forceinline__ void xcd_barrier(const XcdBarrier& b) {
    asm volatile("s_waitcnt vmcnt(0)" ::: "memory");
    __syncthreads();
    if (b.wv == 0u && LANE_ID() == 0) {
        unsigned* bar = b.bar;
        __builtin_amdgcn_s_waitcnt(0);
        unsigned nloc = b.st[0], nx = b.st[1];
        if (nloc == 0u) { xcd_barrier_complete(bar, b.x, nloc, nx); b.st[0] = nloc; b.st[1] = nx; }
        const unsigned old = xb_add(&bar[XB_XSUB(b.x)], 1u);
        const unsigned gen = old / nloc;
        if (old + 1u == (gen + 1u) * nloc) {
            __builtin_amdgcn_fence(__ATOMIC_RELEASE, "agent");
            asm volatile("s_waitcnt vmcnt(0)" ::: "memory");
            const unsigned og = xb_add(&bar[XB_TOP], 1u);
            const unsigned tg = og / nx;
            if (og + 1u == (tg + 1u) * nx) xb_add(&bar[XB_TOPGEN], 1u);
            else XB_SPIN(xb_ld(&bar[XB_TOPGEN]) == tg, bar);
            __builtin_amdgcn_fence(__ATOMIC_ACQUIRE, "agent");
            xb_add(&bar[XB_XGEN(b.x)], 1u);
            asm volatile("s_waitcnt vmcnt(0)" ::: "memory");
        } else {
            XB_SPIN(xb_ld(&bar[XB_XGEN(b.x)]) == gen, bar);
            __builtin_amdgcn_fence(__ATOMIC_ACQUIRE, "agent");
            asm volatile("s_waitcnt vmcnt(0)" ::: "memory");
        }
    }
    __syncthreads();
}

#ifndef N_NT
#define N_NT 0
#endif
#ifndef T_NT
#define T_NT 1
#endif
#ifndef T_NTS
#define T_NTS 0
#endif
struct Args { const float* in[17]; float* out; unsigned char* ws; int ph_lo, ph_hi; };
enum { I_X = 0, I_C, I_ADAW, I_ADAB, I_N1G, I_N2G, I_WIN, I_CONVW, I_GNG, I_FB, I_WOUT, I_RW, I_RB, I_WG, I_WU, I_WD, I_FG };
struct Frame {
    unsigned char* lds;
    gu32* ctl;
    unsigned char* ws;
    const Args* a;
    int tid, lane, wave, vcu, G;
};
__device__ __constant__ float INV_TAB[32] = {
    1.000000000e+00f, 7.498942614e-01f, 5.623413324e-01f, 4.216965139e-01f, 3.162277639e-01f, 2.371373773e-01f, 1.778279394e-01f, 1.333521307e-01f,
    1.000000015e-01f, 7.498941571e-02f, 5.623413250e-02f, 4.216965288e-02f, 3.162277490e-02f, 2.371373773e-02f, 1.778279431e-02f, 1.333521493e-02f,
    9.999999776e-03f, 7.498941850e-03f, 5.623413250e-03f, 4.216964822e-03f, 3.162277630e-03f, 2.371373586e-03f, 1.778279431e-03f, 1.333521446e-03f,
    1.000000047e-03f, 7.498942432e-04f, 5.623413017e-04f, 4.216965172e-04f, 3.162277571e-04f, 2.371373703e-04f, 1.778279402e-04f, 1.333521504e-04f};
__device__ __forceinline__ float ret_lg2(int h) { return __log2f(1.f - __builtin_amdgcn_exp2f((float)(-5 - h))); }

template <bool VEC2>
__device__ __forceinline__ void transpose_item(const float* W, int ldw, bf16* dst, int ldd, float* scr, int lane) {
    asm volatile("" : "+v"(lane));
    if (!VEC2) {
        const int kr = lane >> 4, nc = (lane & 15) * 4;
        f32x4 v[16];
#pragma unroll
        for (int i = 0; i < 16; ++i) v[i] = *(const f32x4*)(W + (size_t)(4 * i + kr) * ldw + nc);
#pragma unroll
        for (int i = 0; i < 16; ++i) { float* s = scr + (4 * i + kr) * 65 + nc; s[0] = v[i][0]; s[1] = v[i][1]; s[2] = v[i][2]; s[3] = v[i][3]; }
    } else {
        const int kr = lane >> 5, nc = (lane & 31) * 2;
#pragma unroll
        for (int hb = 0; hb < 2; ++hb) {
            f32x2 v[16];
#pragma unroll
            for (int i = 0; i < 16; ++i) v[i] = *(const f32x2*)(W + (size_t)(32 * hb + 2 * i + kr) * ldw + nc);
#pragma unroll
            for (int i = 0; i < 16; ++i) { float* s = scr + (32 * hb + 2 * i + kr) * 65 + nc; s[0] = v[i][0]; s[1] = v[i][1]; }
        }
    }
    LDS_WAIT();
    const int c = (lane & 3) + 4 * (lane >> 5), nn = (lane >> 2) & 7;
#pragma unroll
    for (int j = 0; j < 8; ++j) { const int n = nn + 8 * j; const float* s = scr + (8 * c) * 65 + n;
        v4u o; o.x = pk2(s[0 * 65], s[1 * 65]); o.y = pk2(s[2 * 65], s[3 * 65]); o.z = pk2(s[4 * 65], s[5 * 65]); o.w = pk2(s[6 * 65], s[7 * 65]);
        *(v4u*)(dst + (size_t)n * ldd + 8 * c) = o; }
    LDS_WAIT();
}
__device__ __forceinline__ void router_item(const float* W, bf16* dst, float* scr, int lane) {
    asm volatile("" : "+v"(lane));
    const int kr = lane >> 4, nc = (lane & 15) * 4;
    f32x4 v[16];
#pragma unroll
    for (int i = 0; i < 16; ++i) v[i] = *(const f32x4*)(W + (size_t)(4 * i + kr) * 64 + nc);
#pragma unroll
    for (int i = 0; i < 16; ++i) { float* s = scr + (4 * i + kr) * 65 + nc; s[0] = v[i][0]; s[1] = v[i][1]; s[2] = v[i][2]; s[3] = v[i][3]; }
    LDS_WAIT();
    const int c = (lane & 3) + 4 * (lane >> 5), nn = (lane >> 2) & 7;
#pragma unroll
    for (int j = 0; j < 8; ++j) { const int n = nn + 8 * j; const float* s = scr + (8 * c) * 65 + n; float x[8], lo[8];
#pragma unroll
        for (int e = 0; e < 8; ++e) { x[e] = s[e * 65]; lo[e] = x[e] - bf1(f2bf(x[e])); }
        const v4u oh = {pk2(x[0], x[1]), pk2(x[2], x[3]), pk2(x[4], x[5]), pk2(x[6], x[7])}, ol = {pk2(lo[0], lo[1]), pk2(lo[2], lo[3]), pk2(lo[4], lo[5]), pk2(lo[6], lo[7])};
        *(v4u*)(dst + (size_t)n * 4096 + 8 * c) = oh; *(v4u*)(dst + (size_t)n * 4096 + 2048 + 8 * c) = oh; *(v4u*)(dst + (size_t)(64 + n) * 4096 + 8 * c) = ol; }
    LDS_WAIT();
}
#ifndef NORM_PF
#define NORM_PF 0
#endif
#ifndef NPFJ
#define NPFJ 4
#endif
#ifndef CONV_V2
#define CONV_V2 1
#endif
#ifndef CONV_A1
#define CONV_A1 0
#endif
#ifndef CNS
#define CNS 2
#endif
#if CONV_V2
__device__ __forceinline__ void convert_items(Frame& F, int ml, int si0, int sstride, int nsup) {
    static_assert(MOE_FP8, "fp8 expert weights only");
    const Args& A = *F.a;
    int lane = F.lane; asm volatile("" : "+v"(lane));
    constexpr int TP = 144;
    unsigned char* tile = F.lds + F.wave * (64 * TP);
    const int nq = lane & 15, kg = lane >> 4;
    const int rn = lane >> 3, rc = lane & 7;
    const int NQP = ((4 * nsup + CNS - 1) / CNS) * CNS;
    const unsigned lo512 = (unsigned)((8 * kg * 512 + 4 * nq) * 4), lo2048 = (unsigned)((8 * kg * 2048 + 4 * nq) * 4);
#define C_SRC(si_, src, ldw) do { int r_ = (si_); \
        if (r_ < 16384) { const int s_ = r_ >> 13, e_ = (r_ >> 7) & 63, q_ = r_ & 127, kb_ = q_ >> 3, nb_ = q_ & 7; \
            src = A.in[s_ ? I_WU : I_WG] + ((size_t)(ml * 64 + e_) * 2048 + kb_ * 128) * 512 + nb_ * 64; ldw = 512; } \
        else { r_ -= 16384; const int e_ = r_ >> 7, q_ = r_ & 127, kb_ = q_ >> 5, nb_ = q_ & 31; \
            src = A.in[I_WD] + ((size_t)(ml * 64 + e_) * 512 + kb_ * 128) * 2048 + nb_ * 64; ldw = 2048; } } while (0)
#define C_DST(si_, dst, ldd) do { int r_ = (si_); \
        if (r_ < 16384) { const int s_ = r_ >> 13, e_ = (r_ >> 7) & 63, q_ = r_ & 127, kb_ = q_ >> 3, nb_ = q_ & 7, n0_ = nb_ * 64; \
            dst = F.ws + WS_WGU + ((size_t)(ml * 64 + e_) * 1024 + 256 * (n0_ >> 7) + 128 * s_ + (n0_ & 127)) * 2048 + kb_ * 128; ldd = 2048; } \
        else { r_ -= 16384; const int e_ = r_ >> 7, q_ = r_ & 127, kb_ = q_ >> 5, nb_ = q_ & 31; \
            dst = F.ws + WS_WD + ((size_t)(ml * 64 + e_) * 2048 + nb_ * 64) * 512 + kb_ * 128; ldd = 512; } } while (0)
#define C_LOAD(set, qq) do { const int q_l = (qq); const int si_l = si0 + min(q_l >> 2, nsup - 1) * sstride; const float* src_l; int ldw_l; C_SRC(si_l, src_l, ldw_l); \
        const char* pu = (const char*)(src_l + (size_t)(32 * (q_l & 3)) * ldw_l); const unsigned lo_l = ldw_l == 512 ? lo512 : lo2048; \
        _Pragma("unroll") for (int r = 0; r < 8; ++r) { const f32x4* pp = (const f32x4*)(pu + (size_t)r * ldw_l * 4 + lo_l); v[set][r] = T_NT ? __builtin_nontemporal_load(pp) : *pp; } } while (0)
#define C_PROC(set, qq) do { const int q_p = (qq), ks_p = q_p & 3; \
        _Pragma("unroll") for (int e = 0; e < 4; ++e) { i32x2 o; \
            o[0] = pg8::pk4_fp8(32.f * v[set][0][e], 32.f * v[set][1][e], 32.f * v[set][2][e], 32.f * v[set][3][e]); \
            o[1] = pg8::pk4_fp8(32.f * v[set][4][e], 32.f * v[set][5][e], 32.f * v[set][6][e], 32.f * v[set][7][e]); \
            *(i32x2*)(tile + (4 * nq + e) * TP + 32 * ks_p + 8 * kg) = o; } \
        if (ks_p == 3) { const int si_p = si0 + min(q_p >> 2, nsup - 1) * sstride; unsigned char* dst_p; int ldd_p; C_DST(si_p, dst_p, ldd_p); const unsigned so = (unsigned)(rn * ldd_p + 16 * rc); \
            LDS_WAIT(); \
            _Pragma("unroll") for (int j = 0; j < 8; ++j) { const v4u o = *(const v4u*)(tile + (rn + 8 * j) * TP + 16 * rc); v4u* g = (v4u*)(dst_p + (size_t)(8 * j) * ldd_p + so); \
                if (T_NTS) __builtin_nontemporal_store(o, g); else *g = o; } \
            LDS_WAIT(); } } while (0)
    typedef int i32x2 __attribute__((ext_vector_type(2)));
    f32x4 v[CNS][8];
#pragma unroll
    for (int s = 0; s < CNS - 1; ++s) C_LOAD(s, s);
    int q0 = 0;
#pragma unroll 1
    for (; q0 < NQP - CNS; q0 += CNS) {
#pragma unroll
        for (int s = 0; s < CNS; ++s) { C_LOAD((s + CNS - 1) % CNS, q0 + s + CNS - 1); C_PROC(s, q0 + s); }
    }
    C_LOAD(CNS - 1, q0 + CNS - 1);
#pragma unroll
    for (int s = 0; s < CNS; ++s) C_PROC(s, q0 + s);
#undef C_SRC
#undef C_DST
#undef C_LOAD
#undef C_PROC
}
#else
__device__ __forceinline__ void convert_items(Frame& F, int ml) {
    const Args& A = *F.a;
    float* scr = (float*)(F.lds + F.wave * SCR_WAVE);
    const int NGW = F.G * NWAVES;
    constexpr int N_ML = 16384, NIT = 3 * N_ML;
    constexpr bool is8 = MOE_FP8;
#define T_DECODE(r_, src, ldw, dst, ldd) do { int r = (r_); \
        if (r < 2 * N_ML) { const int s = r / N_ML, q0 = r % N_ML, le = ml * 64 + q0 / 256, q = q0 % 256, kb = q / 8, nb = q % 8, n0 = nb * 64; \
            const int row = 256 * (n0 >> 7) + 128 * s + (n0 & 127); \
            src = A.in[s ? I_WU : I_WG] + ((size_t)le * 2048 + kb * 64) * 512 + n0; ldw = 512; ldd = 2048; \
            dst = MOE_FP8 ? (bf16*)(F.ws + WS_WGU + ((size_t)le * 1024 + row) * 2048 + kb * 64) : (bf16*)(F.ws + WS_WGU) + ((size_t)le * 1024 + row) * 2048 + kb * 64; } \
        else { r -= 2 * N_ML; const int le = ml * 64 + r / 256, q = r % 256, kb = q / 32, nb = q % 32; \
            src = A.in[I_WD] + ((size_t)le * 512 + kb * 64) * 2048 + nb * 64; ldw = 2048; ldd = 512; \
            dst = MOE_FP8 ? (bf16*)(F.ws + WS_WD + ((size_t)le * 2048 + nb * 64) * 512 + kb * 64) : (bf16*)(F.ws + WS_WD) + ((size_t)le * 2048 + nb * 64) * 512 + kb * 64; } } while (0)
#define T_LOAD(v, src, ldw) do { _Pragma("unroll") for (int i = 0; i < 16; ++i) v[i] = T_NT ? __builtin_nontemporal_load((const f32x4*)(src + (size_t)(4 * i + kr) * ldw + nc)) : *(const f32x4*)(src + (size_t)(4 * i + kr) * ldw + nc); } while (0)
#define T_PROC(v, dst, ldd, is8) do { _Pragma("unroll") for (int i = 0; i < 16; ++i) { float* s = scr + (4 * i + kr) * 65 + nc; s[0] = v[i][0]; s[1] = v[i][1]; s[2] = v[i][2]; s[3] = v[i][3]; } \
        LDS_WAIT(); \
        if (is8) { const int c4 = lane & 3, n4 = lane >> 2;                    \
            _Pragma("unroll") for (int j = 0; j < 4; ++j) { const int n = n4 + 16 * j; const float* s = scr + (16 * c4) * 65 + n; v4u o; \
                o.x = (unsigned)pg8::pk4_fp8(32.f * s[0 * 65], 32.f * s[1 * 65], 32.f * s[2 * 65], 32.f * s[3 * 65]); o.y = (unsigned)pg8::pk4_fp8(32.f * s[4 * 65], 32.f * s[5 * 65], 32.f * s[6 * 65], 32.f * s[7 * 65]); \
                o.z = (unsigned)pg8::pk4_fp8(32.f * s[8 * 65], 32.f * s[9 * 65], 32.f * s[10 * 65], 32.f * s[11 * 65]); o.w = (unsigned)pg8::pk4_fp8(32.f * s[12 * 65], 32.f * s[13 * 65], 32.f * s[14 * 65], 32.f * s[15 * 65]); \
                if (T_NTS) __builtin_nontemporal_store(o, (v4u*)((unsigned char*)dst + (size_t)n * ldd + 16 * c4)); else *(v4u*)((unsigned char*)dst + (size_t)n * ldd + 16 * c4) = o; asm volatile("" ::: "memory"); } } \
        else { _Pragma("unroll") for (int j = 0; j < 8; ++j) { const int n = nn + 8 * j; const float* s = scr + (8 * cch) * 65 + n; \
            v4u o; o.x = pk2(s[0 * 65], s[1 * 65]); o.y = pk2(s[2 * 65], s[3 * 65]); o.z = pk2(s[4 * 65], s[5 * 65]); o.w = pk2(s[6 * 65], s[7 * 65]); \
            if (T_NTS) __builtin_nontemporal_store(o, (v4u*)(dst + (size_t)n * ldd + 8 * cch)); else *(v4u*)(dst + (size_t)n * ldd + 8 * cch) = o; } } \
        LDS_WAIT(); } while (0)
    { int lane = F.lane; asm volatile("" : "+v"(lane));
      const int kr = lane >> 4, nc = (lane & 15) * 4, cch = (lane & 3) + 4 * (lane >> 5), nn = (lane >> 2) & 7;
      int it = F.vcu * NWAVES + F.wave;
      if (it < NIT) {
          f32x4 va[16], vb[16]; const float* sa; const float* sb; bf16* da; bf16* db; int lwa, lda_, lwb, ldb_;
          T_DECODE(it, sa, lwa, da, lda_); T_LOAD(va, sa, lwa);
          for (;;) {
              const bool hb = it + NGW < NIT;
              if (hb) { T_DECODE(it + NGW, sb, lwb, db, ldb_); T_LOAD(vb, sb, lwb); }
              T_PROC(va, da, lda_, is8);
#ifdef DBL_TPROC
              T_PROC(va, da, lda_, is8);
#endif
              if (!hb) break;
              it += NGW;
              const bool ha = it + NGW < NIT;
              if (ha) { T_DECODE(it + NGW, sa, lwa, da, lda_); T_LOAD(va, sa, lwa); }
              T_PROC(vb, db, ldb_, is8);
#ifdef DBL_TPROC
              T_PROC(vb, db, ldb_, is8);
#endif
              if (!ha) break;
              it += NGW;
          }
      } }
#undef T_DECODE
#undef T_LOAD
#undef T_PROC
}
#endif
__device__ __forceinline__ void p0_prologue(Frame& F) {
    const Args& A = *F.a;
    float* scr = (float*)(F.lds + F.wave * SCR_WAVE);
    const int gw = F.wave * F.G + F.vcu, NGW = F.G * NWAVES;
    { const float* cv = A.in[I_C]; const float* W = A.in[I_ADAW]; float* MP = (float*)(F.ws + WS_MODP);
      for (int it = gw; it < 2 * 8 * 48; it += NGW) {
          const int l = it / 384, r = it % 384, ks = r / 48, nb = r % 48;
          const float* wp = W + ((size_t)l * 2048 + ks * 256) * 12288 + nb * 256 + F.lane * 4;
          f32x4 acc = {0.f, 0.f, 0.f, 0.f};
#pragma unroll 32
          for (int k = 0; k < 256; ++k) { const float cx = cv[ks * 256 + k]; const float sl = cx / (1.f + __expf(-cx)); acc += sl * (T_NT ? __builtin_nontemporal_load((const f32x4*)(wp + (size_t)k * 12288)) : *(const f32x4*)(wp + (size_t)k * 12288)); }
          *(f32x4*)(MP + (size_t)(l * 8 + ks) * 12288 + nb * 256 + F.lane * 4) = acc;
      } }
    { float* ROT = (float*)(F.ws + WS_ROT); const int gt = (F.vcu * NWAVES + F.wave) * 64 + F.lane, NT = NGW * 64;
      for (int idx = gt; idx < S_ * 32; idx += NT) { const int pos = idx >> 5, i = idx & 31;
          const float ang = (float)pos * INV_TAB[i]; double rev = (double)ang * 0.15915494309189535; rev -= __builtin_rint(rev); const float fr = (float)rev;
          *(f32x2*)(ROT + (size_t)idx * 2) = (f32x2){__builtin_amdgcn_cosf(fr), __builtin_amdgcn_sinf(fr)}; }
      v4u* z = (v4u*)(F.ws + WS_RWT2); const v4u zero = {0u, 0u, 0u, 0u};
      for (int idx = gt; idx < 64 * 256 + 128 * 512; idx += NT) { const int o = idx < 64 * 256 ? (64 + idx / 256) * 512 + 256 + idx % 256 : 128 * 512 + (idx - 64 * 256); z[o] = zero; } }
    constexpr int N_WIN = 2 * 32 * 96, N_RW = 32;
    for (int it = gw; it < N_WIN; it += NGW) { const int l = it / 3072, q = it % 3072, kb = q / 96, nb = q % 96;
        transpose_item<true>(A.in[I_WIN] + ((size_t)l * 2048 + kb * 64) * NIN + nb * 64, NIN, (bf16*)(F.ws + WS_WIN) + ((size_t)l * NPJ + nb * 64) * 2048 + kb * 64, 2048, scr, F.lane); }
    for (int it = gw; it < N_RW; it += NGW) router_item(A.in[I_RW] + (size_t)(it * 64) * 64, (bf16*)(F.ws + WS_RWT2) + it * 64, scr, F.lane);
    for (int it = gw; it < 2 * 32 * 32; it += NGW) { const int l = it / 1024, q = it % 1024, kb = q / 32, nb = q % 32;
        transpose_item<false>(A.in[I_WOUT] + ((size_t)l * 2048 + kb * 64) * 2048 + nb * 64, 2048, (bf16*)(F.ws + WS_WOUT) + ((size_t)l * 2048 + nb * 64) * 2048 + kb * 64, 2048, scr, F.lane); }
}

__device__ __forceinline__ float modv(const Args& A, const unsigned char* ws, int l, int idx) {
    const float* MP = (const float*)(ws + WS_MODP) + (size_t)l * 8 * 12288 + idx; float s = A.in[I_ADAB][l * 12288 + idx];
#pragma unroll
    for (int ks = 0; ks < 8; ++ks) s += MP[(size_t)ks * 12288];
    return s;
}
__device__ __forceinline__ float logsig(float x) { return fminf(x, 0.f) - __logf(1.f + __expf(-fabsf(x))); }
__device__ __forceinline__ int moe_tables(Frame& F, int l);
template <int MODE>
__device__ __forceinline__ void norm_phase(Frame& F, int l) {
    const Args& A = *F.a;
    if (MODE == 1 || MODE == 3) (void)moe_tables(F, MODE == 1 ? l - 1 : l);
    float* Av = (float*)F.lds; float* Bv = Av + 2048; float* Gv = Bv + 2048; float* W6 = Gv + 2048;
    const float* MODFr = (const float*)(F.ws + WS_MODF); const float* W6Tr = (const float*)(F.ws + WS_MODF + 131072);
    {
        float av_[4], bv_[4], gv_[4], w6_[4][6];
#pragma unroll
        for (int q = 0; q < 4; ++q) { const int col = F.tid + NWAVES * 64 * q; gv_[q] = 0.f;
            if (MODE == 0) {
                const float ng = A.in[I_N1G][l * 2048 + col], sh = modv(A, F.ws, l, col), sc = modv(A, F.ws, l, 2048 + col);
                av_[q] = ng * (1.f + sc); bv_[q] = sh;
                const float* w = A.in[I_WIN] + ((size_t)l * 2048 + col) * NIN + C_FF;
#pragma unroll
                for (int j = 0; j < 6; ++j) w6_[q][j] = w[j];
            } else if (MODE == 1) {
                av_[q] = A.in[I_N1G][l * 2048 + col] * (1.f + MODFr[l * 12288 + 2048 + col]); bv_[q] = MODFr[l * 12288 + col];
#pragma unroll
                for (int j = 0; j < 6; ++j) w6_[q][j] = W6Tr[(l * 6 + j) * 2048 + col];
            } else if (MODE == 2) {
                const float ng = A.in[I_N2G][l * 2048 + col], sh = modv(A, F.ws, l, 6144 + col), sc = modv(A, F.ws, l, 8192 + col);
                av_[q] = ng * (1.f + sc); bv_[q] = sh;
            } else { av_[q] = A.in[I_FG][col]; bv_[q] = 0.f; }
            if (MODE == 1 || MODE == 3) gv_[q] = MODFr[(MODE == 1 ? l - 1 : l) * 12288 + 10240 + col]; }
        asm volatile("" ::: "memory");
#pragma unroll
        for (int q = 0; q < 4; ++q) { const int col = F.tid + NWAVES * 64 * q; Av[col] = av_[q]; Bv[col] = bv_[q];
            if (MODE == 1 || MODE == 3) Gv[col] = gv_[q];
            if (MODE == 0 || MODE == 1) {
#pragma unroll
                for (int j = 0; j < 6; ++j) W6[j * 2048 + col] = w6_[q][j]; } }
    }
    if (MODE == 0) {
        if (F.tid < 96) { const int lyr = F.tid / 48, idx = F.vcu * 48 + F.tid % 48; ((float*)(F.ws + WS_MODF))[lyr * 12288 + idx] = modv(A, F.ws, lyr, idx); }
        else if (F.tid >= 128 && F.tid < 224) { const int id = F.vcu * 96 + (F.tid - 128), lyr = id / 12288, rem = id % 12288, col = rem / 6, j = rem % 6;
            ((float*)(F.ws + WS_MODF + 131072))[(lyr * 6 + j) * 2048 + col] = A.in[I_WIN][((size_t)lyr * 2048 + col) * NIN + C_FF + j]; }
    }
    __syncthreads();
    const float* X1 = (const float*)(F.ws + WS_X1); const bf16* YS = (const bf16*)(F.ws + WS_YS);
    const int* TOPE = (const int*)(F.ws + WS_ROUTE); const int* TOPPOS = (const int*)(F.ws + WS_ROUTE + 2 * 131072); const float* TOPW = (const float*)(F.ws + WS_ROUTE + 131072);
    const int* offs = (const int*)(F.lds + LDS_OFFS);
    bf16* H = (bf16*)(F.ws + WS_H); float* LS = (float*)(F.ws + WS_LS);
    const int gw = F.vcu * NWAVES + F.wave, NGW = F.G * NWAVES;
    int ns0 = 0, ns1 = 0; float nw0 = 0.f, nw1 = 0.f;
    if ((MODE == 1 || MODE == 3) && gw < S_) { ns0 = offs[TOPE[2 * gw]] + TOPPOS[2 * gw]; ns1 = offs[TOPE[2 * gw + 1]] + TOPPOS[2 * gw + 1]; nw0 = TOPW[2 * gw]; nw1 = TOPW[2 * gw + 1]; }
#if NORM_PF
    const float* XS = MODE == 0 ? A.in[I_X] : X1;
    f32x4 xn[NPFJ];
    { int ln0 = F.lane; asm volatile("" : "+v"(ln0));
#pragma unroll
      for (int j = 0; j < NPFJ; ++j) xn[j] = *(const f32x4*)(XS + (size_t)gw * 2048 + ln0 * 4 + 256 * j); }
#endif
    for (int t = gw; t < S_; t += NGW) {
        int ln_ = F.lane; asm volatile("" : "+v"(ln_)); f32x4 x[8]; const int c0 = ln_ * 4;
#if NORM_PF
        { const int tn = t + NGW < S_ ? t + NGW : t;
#pragma unroll
          for (int j = NPFJ; j < 8; ++j) x[j] = *(const f32x4*)(XS + (size_t)t * 2048 + c0 + 256 * j);
#pragma unroll
          for (int j = 0; j < NPFJ; ++j) { x[j] = xn[j]; xn[j] = *(const f32x4*)(XS + (size_t)tn * 2048 + c0 + 256 * j); } }
#else
        if (MODE == 0) {
#pragma unroll
            for (int j = 0; j < 8; ++j) x[j] = *(const f32x4*)(A.in[I_X] + (size_t)t * 2048 + c0 + 256 * j);
        } else {
#pragma unroll
#if X1_BF16
            for (int j = 0; j < 8; ++j) { const v2u w = *(const v2u*)((const bf16*)X1 + (size_t)t * 2048 + c0 + 256 * j); x[j] = (f32x4){bflo(w.x), bfhi(w.x), bflo(w.y), bfhi(w.y)}; }
#else
            for (int j = 0; j < 8; ++j) x[j] = (N_NT && (MODE == 1 || MODE == 3)) ? __builtin_nontemporal_load((const f32x4*)(X1 + (size_t)t * 2048 + c0 + 256 * j)) : *(const f32x4*)(X1 + (size_t)t * 2048 + c0 + 256 * j);
#endif
        }
#endif
        if (MODE == 1 || MODE == 3) {
            const int s0 = ns0, s1 = ns1; const float w0 = nw0, w1 = nw1;
            { const int tn = t + NGW < S_ ? t + NGW : t; ns0 = offs[TOPE[2 * tn]] + TOPPOS[2 * tn]; ns1 = offs[TOPE[2 * tn + 1]] + TOPPOS[2 * tn + 1]; nw0 = TOPW[2 * tn]; nw1 = TOPW[2 * tn + 1]; }
#pragma unroll
            for (int j = 0; j < 8; ++j) { const f32x4 g = *(const f32x4*)(Gv + c0 + 256 * j);
#if MOE_FP8
                const int a = N_NT ? __builtin_nontemporal_load((const int*)((const unsigned char*)YS + (size_t)s0 * 2048 + c0 + 256 * j)) : *(const int*)((const unsigned char*)YS + (size_t)s0 * 2048 + c0 + 256 * j), b = N_NT ? __builtin_nontemporal_load((const int*)((const unsigned char*)YS + (size_t)s1 * 2048 + c0 + 256 * j)) : *(const int*)((const unsigned char*)YS + (size_t)s1 * 2048 + c0 + 256 * j);
                const float u0 = w0 * (1.f / 16.f), u1 = w1 * (1.f / 16.f);
                x[j][0] += g[0] * (u0 * __builtin_amdgcn_cvt_f32_fp8(a, 0) + u1 * __builtin_amdgcn_cvt_f32_fp8(b, 0)); x[j][1] += g[1] * (u0 * __builtin_amdgcn_cvt_f32_fp8(a, 1) + u1 * __builtin_amdgcn_cvt_f32_fp8(b, 1));
                x[j][2] += g[2] * (u0 * __builtin_amdgcn_cvt_f32_fp8(a, 2) + u1 * __builtin_amdgcn_cvt_f32_fp8(b, 2)); x[j][3] += g[3] * (u0 * __builtin_amdgcn_cvt_f32_fp8(a, 3) + u1 * __builtin_amdgcn_cvt_f32_fp8(b, 3));
                if (NORM_PF && (j & 3) == 3) asm volatile("" ::: "memory");
#else
                const v2u a = *(const v2u*)(YS + (size_t)s0 * 2048 + c0 + 256 * j), b = *(const v2u*)(YS + (size_t)s1 * 2048 + c0 + 256 * j);
                x[j][0] += g[0] * (w0 * bflo(a.x) + w1 * bflo(b.x)); x[j][1] += g[1] * (w0 * bfhi(a.x) + w1 * bfhi(b.x));
                x[j][2] += g[2] * (w0 * bflo(a.y) + w1 * bflo(b.y)); x[j][3] += g[3] * (w0 * bfhi(a.y) + w1 * bfhi(b.y));
#endif
                }
            if (MODE == 1) {
#pragma unroll
                for (int j = 0; j < 8; ++j) *(f32x4*)(A.out + (size_t)t * 2048 + c0 + 256 * j) = x[j];
            }
        }
        float ss = 0.f;
#pragma unroll
        for (int j = 0; j < 8; ++j) ss += (x[j][0] * x[j][0] + x[j][1] * x[j][1]) + (x[j][2] * x[j][2] + x[j][3] * x[j][3]);
        const float rs = 1.0f / sqrtf(wave_sum(ss) * (1.f / 2048.f) + EPS_);
        float ff[6] = {0.f, 0.f, 0.f, 0.f, 0.f, 0.f};
#pragma unroll
        for (int j = 0; j < 8; ++j) { const f32x4 av = *(const f32x4*)(Av + c0 + 256 * j), bv = *(const f32x4*)(Bv + c0 + 256 * j);
            const f32x4 hv = x[j] * rs * av + bv;
            if (MODE == 3) *(f32x4*)(A.out + (size_t)t * 2048 + c0 + 256 * j) = hv;
            else if (MODE == 2) { v2u o; o.x = pk2(hv[0], hv[1]); o.y = pk2(hv[2], hv[3]); bf16* hp = (bf16*)(F.ws + WS_H2X) + (size_t)t * 4096 + c0 + 256 * j; *(v2u*)hp = o;
                v2u q; q.x = pk2(hv[0] - bflo(o.x), hv[1] - bfhi(o.x)); q.y = pk2(hv[2] - bflo(o.y), hv[3] - bfhi(o.y)); *(v2u*)(hp + 2048) = q; }
            else { v2u o; o.x = pk2(hv[0], hv[1]); o.y = pk2(hv[2], hv[3]); *(v2u*)(H + (size_t)t * 2048 + c0 + 256 * j) = o; }
            if (MODE == 0 || MODE == 1) {
#pragma unroll
                for (int q = 0; q < 6; ++q) { const f32x4 w = *(const f32x4*)(W6 + q * 2048 + c0 + 256 * j); ff[q] += (hv[0] * w[0] + hv[1] * w[1]) + (hv[2] * w[2] + hv[3] * w[3]); }
            }
            asm volatile("" ::: "memory");
        }
        if (MODE == 0 || MODE == 1) {
#pragma unroll
            for (int q = 0; q < 6; ++q) { const float f = wave_sum(ff[q]); if (F.lane == q) LS[(size_t)q * S_ + t] = logsig(f + A.in[I_FB][l * 6 + q]); }
        }
    }
}

__device__ __forceinline__ void cum_item(Frame& F, int h) {
    const float* LS = (const float*)(F.ws + WS_LS); float* CUM = (float*)(F.ws + WS_CUM) + (size_t)h * S_;
    float* red = (float*)F.lds;
    const int p0 = F.tid * 32; float v[32]; float run = 0.f;
#pragma unroll
    for (int i = 0; i < 32; i += 4) { const f32x4 x4 = *(const f32x4*)(LS + (size_t)h * S_ + p0 + i); run += x4[0]; v[i] = run; run += x4[1]; v[i + 1] = run; run += x4[2]; v[i + 2] = run; run += x4[3]; v[i + 3] = run; }
    float inc = run;
#pragma unroll
    for (int o = 1; o < 64; o <<= 1) { const float u = __shfl_up(inc, o); if (F.lane >= o) inc += u; }
    if (F.lane == 63) red[F.wave] = inc;
    __syncthreads();
    float base = inc - run;
    for (int w = 0; w < F.wave; ++w) base += red[w];
#pragma unroll
    for (int i = 0; i < 32; i += 4) *(f32x4*)(CUM + p0 + i) = (f32x4){base + v[i], base + v[i + 1], base + v[i + 2], base + v[i + 3]};
    __syncthreads();
}
__device__ __forceinline__ void qknorm_item(Frame& F, int h, int qb) {
    const bf16* PJ = (const bf16*)(F.ws + WS_PROJ); float* MQK = (float*)(F.ws + WS_MAXQK);
    float* red = (float*)F.lds;
    const int row = qb * 256 + (F.tid >> 1), half = F.tid & 1;
    const bf16* QH = (const bf16*)(F.ws + WS_QKVH); const bf16* qp = QH + ((size_t)(G_FQ + h) * S_ + row) * 128 + 64 * half; const bf16* kp = QH + ((size_t)(G_FK + h) * S_ + row) * 128 + 64 * half;
    float sq = 0.f, sk = 0.f;
#pragma unroll
    for (int i = 0; i < 8; ++i) { const v4u a = *(const v4u*)(qp + 8 * i), b = *(const v4u*)(kp + 8 * i);
#pragma unroll
        for (int e = 0; e < 4; ++e) { const float a0 = bflo(a[e]), a1 = bfhi(a[e]), b0 = bflo(b[e]), b1 = bfhi(b[e]); sq += a0 * a0 + a1 * a1; sk += b0 * b0 + b1 * b1; } }
    sq += __shfl_xor(sq, 1); sk += __shfl_xor(sk, 1);
    const float mq = wave_max(sqrtf(sq)), mk = wave_max(sqrtf(sk));
    if (F.lane == 0) { red[F.wave * 2] = mq; red[F.wave * 2 + 1] = mk; }
    __syncthreads();
    if (F.tid == 0) { float a = 0.f, b = 0.f; for (int w = 0; w < 8; ++w) { a = fmaxf(a, red[2 * w]); b = fmaxf(b, red[2 * w + 1]); } MQK[(h * 64 + qb) * 2] = a; MQK[(h * 64 + qb) * 2 + 1] = b; }
    __syncthreads();
}
__device__ __forceinline__ void conv_item(Frame& F, int l, int rb) {
    const Args& A = *F.a; const bf16* PJ = (const bf16*)(F.ws + WS_PROJ); bf16* MX = (bf16*)(F.ws + WS_MIXED);
    int tid = F.tid; asm volatile("" : "+v"(tid));
    const int ch = (tid & 63) * 8, t0 = rb * 64 + (tid >> 6) * 8;
    float w0[8], w1[8], w2[8], z1[8], z2[8];
#pragma unroll
    for (int e = 0; e < 8; ++e) { w0[e] = A.in[I_CONVW][(l * 3 + 0) * 512 + ch + e]; w1[e] = A.in[I_CONVW][(l * 3 + 1) * 512 + ch + e]; w2[e] = A.in[I_CONVW][(l * 3 + 2) * 512 + ch + e]; z1[e] = 0.f; z2[e] = 0.f; }
    const bf16* __restrict__ pj = PJ; bf16* __restrict__ mx = MX;
    v4u cc[10], cu[10], cb[8];
#pragma unroll
    for (int i = 0; i < 10; ++i) { const int t = t0 + i - 2, tc = t < 0 ? 0 : t; const bf16* rp = pj + (size_t)tc * NPC + ch; cc[i] = *(const v4u*)(rp + C_CC); cu[i] = *(const v4u*)(rp + C_CU); if (i >= 2) cb[i - 2] = *(const v4u*)(rp + C_CB); }
    asm volatile("" ::: "memory");
#pragma unroll
    for (int i = 0; i < 10; ++i) { const int t = t0 + i - 2; const float live = t < 0 ? 0.f : 1.f;
        float z[8];
#pragma unroll
        for (int e = 0; e < 4; ++e) { z[2 * e] = live * bflo(cc[i][e]) * bflo(cu[i][e]); z[2 * e + 1] = live * bfhi(cc[i][e]) * bfhi(cu[i][e]); }
        if (i >= 2) { const v4u g = cb[i - 2]; float y[8];
#pragma unroll
            for (int e = 0; e < 4; ++e) { y[2 * e] = bflo(g[e]) * (w0[2 * e] * z2[2 * e] + w1[2 * e] * z1[2 * e] + w2[2 * e] * z[2 * e]);
                                          y[2 * e + 1] = bfhi(g[e]) * (w0[2 * e + 1] * z2[2 * e + 1] + w1[2 * e + 1] * z1[2 * e + 1] + w2[2 * e + 1] * z[2 * e + 1]); }
            v4u o; o.x = pk2(y[0], y[1]); o.y = pk2(y[2], y[3]); o.z = pk2(y[4], y[5]); o.w = pk2(y[6], y[7]);
            *(v4u*)(mx + (size_t)t * 2048 + M_CONV + ch) = o; }
#pragma unroll
        for (int e = 0; e < 8; ++e) { z2[e] = z1[e]; z1[e] = z[e]; }
    }
}
__device__ __forceinline__ void rot4(const bf16* rowp, const float* ROT, int pos, int i0, float (&o1)[4], float (&o2)[4]) {
    const v2u a = *(const v2u*)(rowp + i0), b = *(const v2u*)(rowp + 32 + i0);
    const f32x4 c0 = *(const f32x4*)(ROT + ((size_t)pos * 32 + i0) * 2), c1 = *(const f32x4*)(ROT + ((size_t)pos * 32 + i0) * 2 + 4);
    const float x1[4] = {bflo(a.x), bfhi(a.x), bflo(a.y), bfhi(a.y)}, x2[4] = {bflo(b.x), bfhi(b.x), bflo(b.y), bfhi(b.y)};
    const float cs[4] = {c0[0], c0[2], c1[0], c1[2]}, sn[4] = {c0[1], c0[3], c1[1], c1[3]};
#pragma unroll
    for (int e = 0; e < 4; ++e) { o1[e] = x1[e] * cs[e] - x2[e] * sn[e]; o2[e] = x2[e] * cs[e] + x1[e] * sn[e]; }
}
constexpr int RP = 72;
constexpr int PVR = 160, PKR = 96;
typedef short v4i16_t __attribute__((ext_vector_type(4)));
__device__ __forceinline__ s16x4 trrd(const bf16* p) { return __builtin_bit_cast(s16x4, __builtin_amdgcn_ds_read_tr16_b64_v4i16((LAS v4i16_t*)p)); }
__device__ __forceinline__ bf16x8 tr_frag(const bf16* T, int pitch, int rowA, int rowB, int col0, int lane) {
    const int blk = (lane >> 4) & 1, q = (lane & 15) >> 2, p = lane & 3; const bf16* b = T + q * pitch + col0 + 16 * blk + 4 * p;
    const s16x4 lo = trrd(b + rowA * pitch), hi = trrd(b + rowB * pitch);
    return (bf16x8){lo[0], lo[1], lo[2], lo[3], hi[0], hi[1], hi[2], hi[3]};
}
__device__ __forceinline__ void stage_vr(unsigned char* ws, int tid, bf16* VR, int c, int h) {
    const bf16* HM = (const bf16*)(ws + WS_QKVH);
    const int m = tid >> 3, v0 = (tid & 7) * 16; const bf16* vp = HM + ((size_t)(G_RV + h) * S_ + 64 * c + m) * 128 + v0;
    const v4u a = *(const v4u*)vp, b = *(const v4u*)(vp + 8);
    *(v4u*)(VR + m * PVR + v0) = a; *(v4u*)(VR + m * PVR + v0 + 8) = b;
}
__device__ __forceinline__ void stage_vr_load(unsigned char* ws, int tid, int c, int h, v4u& a, v4u& b) {
    const bf16* HM = (const bf16*)(ws + WS_QKVH);
    const int m = tid >> 3, v0 = (tid & 7) * 16; const bf16* vp = HM + ((size_t)(G_RV + h) * S_ + 64 * c + m) * 128 + v0;
    a = *(const v4u*)vp; b = *(const v4u*)(vp + 8);
}
__device__ __forceinline__ void stage_vr_store(int tid, bf16* VR, v4u a, v4u b) { const int m = tid >> 3, v0 = (tid & 7) * 16; *(v4u*)(VR + m * PVR + v0) = a; *(v4u*)(VR + m * PVR + v0 + 8) = b; }
__device__ __forceinline__ void r1_item(Frame& FF, int c, int h) {
    struct { unsigned char* lds; unsigned char* ws; int tid, lane, wave; } F; F.lds = FF.lds; F.ws = FF.ws; F.wave = FF.wave;
    { int t_ = FF.tid; asm volatile("" : "+v"(t_)); F.tid = t_; F.lane = t_ & 63; }
    const bf16* PJ = (const bf16*)(F.ws + WS_PROJ); const float* ROT = (const float*)(F.ws + WS_ROT);
    bf16* KR = (bf16*)F.lds; bf16* VR = KR + 64 * PKR;
    const float lg2 = ret_lg2(h);
    v4u va_, vb_; stage_vr_load(F.ws, F.tid, c, h, va_, vb_);
    { const int m = F.tid >> 3, i0 = (F.tid & 7) * 4, pos = 64 * c + m; float o1[4], o2[4];
      rot4((const bf16*)(F.ws + WS_QKVH) + ((size_t)(G_RK + (h >> 1)) * S_ + pos) * 128 + 64 * (h & 1), ROT, pos, i0, o1, o2);
      const float sc = 0.125f * __builtin_amdgcn_exp2f(lg2 * (float)(63 - m));
      *(v2u*)(KR + m * PKR + i0) = (v2u){pk2(o1[0] * sc, o1[1] * sc), pk2(o1[2] * sc, o1[3] * sc)}; *(v2u*)(KR + m * PKR + 32 + i0) = (v2u){pk2(o2[0] * sc, o2[1] * sc), pk2(o2[2] * sc, o2[3] * sc)}; }
    stage_vr_store(F.tid, VR, va_, vb_);
    __syncthreads();
    const int r32 = F.lane & 31, hh = F.lane >> 5, vi = F.wave >> 1, di = F.wave & 1;
    f32x16 acc = {};
#pragma unroll
    for (int s = 0; s < 4; ++s) { const bf16x8 a = tr_frag(VR, PVR, 16 * s + 8 * hh, 16 * s + 8 * hh + 4, 32 * vi, F.lane), b = tr_frag(KR, PKR, 16 * s + 8 * hh, 16 * s + 8 * hh + 4, 32 * di, F.lane);
        acc = __builtin_amdgcn_mfma_f32_32x32x16_bf16(a, b, acc, 0, 0, 0); }
    float* KVT = (float*)(F.ws + WS_KVT) + (size_t)(c * 6 + h) * 8192;
#pragma unroll
    for (int r = 0; r < 16; ++r) KVT[(32 * vi + fa::crow(r, hh)) * 64 + 32 * di + r32] = acc[r];
    __syncthreads();
}
#ifndef R1_IN_A0
#define R1_IN_A0 0
#endif
__device__ __forceinline__ void mixa0_phase(Frame& F) {
    constexpr int N_CUM = 6, N_QK = 384;
    for (int it = F.vcu; it < N_CUM + N_QK; it += F.G) { if (it < N_CUM) cum_item(F, it); else qknorm_item(F, (it - N_CUM) % 6, (it - N_CUM) / 6); }
#if R1_IN_A0
#pragma unroll 1
    for (int it = F.G - 1 - F.vcu; it < 1536; it += F.G) r1_item(F, it / 6, it % 6);
#endif
}
__device__ __forceinline__ void mixb_phase(Frame& F) {
    const float* KVT = (const float*)(F.ws + WS_KVT); bf16* PV = (bf16*)(F.ws + WS_PREVT);
    const int gt = (F.vcu * NWAVES + F.wave) * 64 + F.lane;
    if (gt < 6 * 8192) { const int h = gt / 8192; const float dec = __builtin_amdgcn_exp2f(ret_lg2(h) * 64.f); float st = 0.f;
        for (int c0 = 0; c0 < 256; c0 += 16) { float kv[16];
#pragma unroll
            for (int i = 0; i < 16; ++i) kv[i] = KVT[(size_t)(c0 + i) * 49152 + gt];
#pragma unroll
            for (int i = 0; i < 16; ++i) { PV[(size_t)(c0 + i) * 49152 + gt] = f2bf(st); st = st * dec + kv[i]; } } }
}
struct R3In { v2u qa, qb, ka, kb; f32x4 r0, r1; v4u va, vb, g0, g1; bf16x8 pvf[4]; f32x4 gn[4]; };
__device__ __forceinline__ void r3_load(Frame& FF, int l, int c, int h, R3In& I) {
    int tid = FF.tid; asm volatile("" : "+v"(tid)); const int lane = tid & 63;
    const bf16* PJ = (const bf16*)(FF.ws + WS_PROJ); const float* ROT = (const float*)(FF.ws + WS_ROT);
    const int m = tid >> 3, i0 = (tid & 7) * 4, pos = 64 * c + m; const bf16* HM = (const bf16*)(FF.ws + WS_QKVH);
    { const bf16* qp = HM + ((size_t)(G_RQ + (h >> 1)) * S_ + pos) * 128 + 64 * (h & 1) + i0; const bf16* kp = HM + ((size_t)(G_RK + (h >> 1)) * S_ + pos) * 128 + 64 * (h & 1) + i0;
      I.qa = *(const v2u*)qp; I.qb = *(const v2u*)(qp + 32); I.ka = *(const v2u*)kp; I.kb = *(const v2u*)(kp + 32); }
    I.r0 = *(const f32x4*)(ROT + ((size_t)pos * 32 + i0) * 2); I.r1 = *(const f32x4*)(ROT + ((size_t)pos * 32 + i0) * 2 + 4);
    { const bf16* vp = HM + ((size_t)(G_RV + h) * S_ + pos) * 128 + (tid & 7) * 16; I.va = *(const v4u*)vp; I.vb = *(const v4u*)(vp + 8); }
    { const bf16* gp = HM + ((size_t)(G_RG + h) * S_ + pos) * 128 + 16 * (tid & 7); I.g0 = *(const v4u*)gp; I.g1 = *(const v4u*)(gp + 8); }
    { const float* gnp = FF.a->in[I_GNG] + l * 768 + 128 * h + 16 * (tid & 7);
#pragma unroll
      for (int q = 0; q < 4; ++q) I.gn[q] = *(const f32x4*)(gnp + 4 * q); }
    { const int r32_ = lane & 31, hh_ = lane >> 5, vi_ = FF.wave >> 1; const bf16* PV = (const bf16*)(FF.ws + WS_PREVT) + ((size_t)(c * 6 + h) * 128 + 32 * vi_ + r32_) * 64;
#pragma unroll
      for (int s = 0; s < 4; ++s) I.pvf[s] = *(const bf16x8*)(PV + 16 * s + 8 * hh_); }
}
__device__ __forceinline__ void rot4v(v2u a, v2u b, f32x4 c0, f32x4 c1, float (&o1)[4], float (&o2)[4]) {
    const float x1[4] = {bflo(a.x), bfhi(a.x), bflo(a.y), bfhi(a.y)}, x2[4] = {bflo(b.x), bfhi(b.x), bflo(b.y), bfhi(b.y)};
    const float cs[4] = {c0[0], c0[2], c1[0], c1[2]}, sn[4] = {c0[1], c0[3], c1[1], c1[3]};
#pragma unroll
    for (int e = 0; e < 4; ++e) { o1[e] = x1[e] * cs[e] - x2[e] * sn[e]; o2[e] = x2[e] * cs[e] + x1[e] * sn[e]; }
}
__device__ __forceinline__ void r3_compute(Frame& FF, int l, int c, int h, const R3In& I) {
    struct { unsigned char* lds; unsigned char* ws; const Args* a; int tid, lane, wave; } F; F.lds = FF.lds; F.ws = FF.ws; F.a = FF.a; F.wave = FF.wave;
    { int t_ = FF.tid; asm volatile("" : "+v"(t_)); F.tid = t_; F.lane = t_ & 63; }
#ifdef DBG_R3T
    const unsigned long long t0_ = __builtin_amdgcn_s_memrealtime();
#endif
    const Args& A = *F.a;
    bf16* QS = (bf16*)F.lds; bf16* KS = QS + 64 * RP; bf16* VR = KS + 64 * RP; float* OS = (float*)(VR + 64 * PVR);
    const float lg2 = ret_lg2(h);
#ifndef R3_REP1
#define R3_REP1 1
#define R3_REP2 1
#define R3_REP3 1
#endif
#pragma unroll 1
    for (int rp1 = 0; rp1 < R3_REP1; ++rp1) {
    { const int m = F.tid >> 3, i0 = (F.tid & 7) * 4; float o1[4], o2[4];
      rot4v(I.qa, I.qb, I.r0, I.r1, o1, o2);
      *(v2u*)(QS + m * RP + i0) = (v2u){pk2(o1[0], o1[1]), pk2(o1[2], o1[3])}; *(v2u*)(QS + m * RP + 32 + i0) = (v2u){pk2(o2[0], o2[1]), pk2(o2[2], o2[3])};
      rot4v(I.ka, I.kb, I.r0, I.r1, o1, o2);
      *(v2u*)(KS + m * RP + i0) = (v2u){pk2(o1[0] * 0.125f, o1[1] * 0.125f), pk2(o1[2] * 0.125f, o1[3] * 0.125f)};
      *(v2u*)(KS + m * RP + 32 + i0) = (v2u){pk2(o2[0] * 0.125f, o2[1] * 0.125f), pk2(o2[2] * 0.125f, o2[3] * 0.125f)};
      const int v0 = (F.tid & 7) * 16; *(v4u*)(VR + m * PVR + v0) = I.va; *(v4u*)(VR + m * PVR + v0 + 8) = I.vb; }
    __syncthreads(); }
#ifdef DBG_R3T
    unsigned long long t1_ = __builtin_amdgcn_s_memrealtime(); if (FF.tid == 0 && blockIdx.x == 1) __hip_atomic_fetch_add((unsigned long long*)(FF.ctl + 20010 + 2 * 1), t1_ - t0_, RLX_AGENT);
#endif
    const int r32 = F.lane & 31, hh = F.lane >> 5, ni = F.wave & 1, vi = F.wave >> 1;
#pragma unroll 1
    for (int rp2 = 0; rp2 < R3_REP2; ++rp2) {
    f32x16 oacc = {}, cacc = {};
#pragma unroll
    for (int mj = 0; mj < 2; ++mj) {
        f32x16 X = {};
#pragma unroll
        for (int s = 0; s < 4; ++s) { const bf16x8 a = *(const bf16x8*)(KS + (32 * mj + r32) * RP + 16 * s + 8 * hh), b = *(const bf16x8*)(QS + (32 * ni + r32) * RP + 16 * s + 8 * hh);
            X = __builtin_amdgcn_mfma_f32_32x32x16_bf16(a, b, X, 0, 0, 0); }
#pragma unroll
        for (int r = 0; r < 16; ++r) { const int dm = (32 * ni + r32) - (32 * mj + fa::crow(r, hh)); X[r] *= __builtin_amdgcn_exp2f(lg2 * (float)(dm < 0 ? -dm : dm)); }
#pragma unroll
        for (int s2 = 0; s2 < 2; ++s2) {
            v4u pw; pw.x = pk2(X[8 * s2 + 0], X[8 * s2 + 1]); pw.y = pk2(X[8 * s2 + 2], X[8 * s2 + 3]); pw.z = pk2(X[8 * s2 + 4], X[8 * s2 + 5]); pw.w = pk2(X[8 * s2 + 6], X[8 * s2 + 7]);
            const bf16x8 bwf = tr_frag(VR, PVR, 32 * mj + 16 * s2 + 4 * hh, 32 * mj + 16 * s2 + 8 + 4 * hh, 32 * vi, F.lane);
            oacc = __builtin_amdgcn_mfma_f32_32x32x16_bf16(*(const bf16x8*)&pw, bwf, oacc, 0, 0, 0); }
    }
    {
#pragma unroll
      for (int s = 0; s < 4; ++s) { const bf16x8 a = *(const bf16x8*)(QS + (32 * ni + r32) * RP + 16 * s + 8 * hh), b = I.pvf[s];
          cacc = __builtin_amdgcn_mfma_f32_32x32x16_bf16(a, b, cacc, 0, 0, 0); } }
#pragma unroll
    for (int r = 0; r < 16; ++r) { const int n = 32 * ni + fa::crow(r, hh); OS[n * 132 + 32 * vi + r32] = oacc[r] + __builtin_amdgcn_exp2f(lg2 * (float)(n + 1)) * cacc[r]; }
    __syncthreads(); }
#ifdef DBG_R3T
    unsigned long long t2_ = __builtin_amdgcn_s_memrealtime(); if (FF.tid == 0 && blockIdx.x == 1) __hip_atomic_fetch_add((unsigned long long*)(FF.ctl + 20010 + 2 * 2), t2_ - t1_, RLX_AGENT);
#endif
#pragma unroll 1
    for (int rp3 = 0; rp3 < R3_REP3; ++rp3) {
    { const int n = F.tid >> 3, part = F.tid & 7, pos = 64 * c + n; float x[16]; float s = 0.f;
#pragma unroll
      for (int q = 0; q < 4; ++q) { const f32x4 v = *(const f32x4*)(OS + n * 132 + 16 * part + 4 * q); x[4 * q] = v[0]; x[4 * q + 1] = v[1]; x[4 * q + 2] = v[2]; x[4 * q + 3] = v[3]; s += (v[0] + v[1]) + (v[2] + v[3]); }
      s += __shfl_xor(s, 1); s += __shfl_xor(s, 2); s += __shfl_xor(s, 4);
      const float mu = s * (1.f / 128.f); float q2 = 0.f;
#pragma unroll
      for (int e = 0; e < 16; ++e) { x[e] -= mu; q2 += x[e] * x[e]; }
      q2 += __shfl_xor(q2, 1); q2 += __shfl_xor(q2, 2); q2 += __shfl_xor(q2, 4);
      const float rstd = 1.0f / sqrtf(q2 * (1.f / 128.f) + EPS_);
      const v4u g0 = I.g0, g1 = I.g1;
      float gn[16];
#pragma unroll
      for (int q = 0; q < 4; ++q) { gn[4 * q] = I.gn[q][0]; gn[4 * q + 1] = I.gn[q][1]; gn[4 * q + 2] = I.gn[q][2]; gn[4 * q + 3] = I.gn[q][3]; }
      float y[16];
#pragma unroll
      for (int e = 0; e < 8; ++e) { const unsigned gw_ = e < 4 ? g0[e] : g1[e - 4];
          const float ga = bflo(gw_), gb = bfhi(gw_);
          y[2 * e] = x[2 * e] * rstd * gn[2 * e] * (ga / (1.f + __expf(-ga))); y[2 * e + 1] = x[2 * e + 1] * rstd * gn[2 * e + 1] * (gb / (1.f + __expf(-gb))); }
      bf16* op = (bf16*)(F.ws + WS_MIXED) + (size_t)pos * 2048 + M_RET + 128 * h + 16 * part;
      *(v4u*)op = (v4u){pk2(y[0], y[1]), pk2(y[2], y[3]), pk2(y[4], y[5]), pk2(y[6], y[7])};
      *(v4u*)(op + 8) = (v4u){pk2(y[8], y[9]), pk2(y[10], y[11]), pk2(y[12], y[13]), pk2(y[14], y[15])}; }
    __syncthreads(); }
#ifdef DBG_R3T
    if (FF.tid == 0 && blockIdx.x == 1) { const unsigned long long t3_ = __builtin_amdgcn_s_memrealtime(); __hip_atomic_fetch_add((unsigned long long*)(FF.ctl + 20010 + 2 * 3), t3_ - t2_, RLX_AGENT); }
#endif
}
__device__ __forceinline__ void attn_unit(Frame& F, int h, int qb) {
    using namespace fa;
    const bf16* PJ = (const bf16*)(F.ws + WS_PROJ); const float* CUM = (const float*)(F.ws + WS_CUM) + (size_t)h * S_; const float* MQK = (const float*)(F.ws + WS_MAXQK);
    char* lds = (char*)F.lds; char* V_lds = lds + OFF_V; char* K_lds = lds + OFF_K; float* b_lds = (float*)(lds + OFF_B);
    float* wsm = (float*)(lds + OFF_W) + F.wave * 64; float* li_l = wsm; float* al_l = wsm + 32;
    int tid = F.tid; asm volatile("" : "+v"(tid));
    const int wid = F.wave, lane = tid & 63, r32 = lane & 31, hi = lane >> 5;
    const int qlo = qb * QB + wid * QBLK;
    bf16x8 qr[8];
#pragma unroll
    for (int d0 = 0; d0 < 8; ++d0) qr[d0] = *(const bf16x8*)(PJ + (size_t)(qlo + r32) * NPJ + C_FQ + 128 * h + d0 * 16 + hi * 8);
    const int j_hi = 4 * qb + 4;
    const float cfirst = CUM[qb * QB];
    int j_lo;
    { const float kmx = wave_max(lane <= qb ? MQK[(h * 64 + lane) * 2 + 1] : 0.f);
      const float Dn = MQK[(h * 64 + qb) * 2] * (kmx + MQK[(h * 64 + qb) * 2 + 1]) * SCALE + 30.f;
      int cand = 4 * qb;
#pragma unroll
      for (int i = 0; i < 4; ++i) { const int j = lane + 64 * i; if (j < 4 * qb) { const bool skip = (cfirst - CUM[64 * j + 63]) < -Dn; if (!skip && j < cand) cand = j; } }
      j_lo = wave_min_i(cand); }
    float m_reg = -1e30f, l_reg = 0.f; f32x16 o[4] = {};
    const int sr = tid >> 4, sc = (tid & 15) * 8, vst0 = v_st(sr, sc), vst1 = v_st(32 + sr, sc), kws = KSWZ(sr, sc * 2);
    const int vb0 = (int)(uintptr_t)V_lds + v_rd_base(lane);
    const bf16* Kg = PJ + C_FK + 128 * h + sc; const bf16* Vg = PJ + C_FV + 128 * h + sc;
    v4u k0, k1, v0, v1; float bia = 0.f;
#define ATT_LOAD(t_) do { const int kb_ = (t_) * KVBLK; k0 = *(const v4u*)(Kg + (size_t)(kb_ + sr) * NPJ); k1 = *(const v4u*)(Kg + (size_t)(kb_ + 32 + sr) * NPJ); \
        v0 = *(const v4u*)(Vg + (size_t)(kb_ + sr) * NPJ); v1 = *(const v4u*)(Vg + (size_t)(kb_ + 32 + sr) * NPJ); if (tid < 64) bia = (cfirst - CUM[kb_ + tid]) * (1.0f / SCALE); } while (0)
    ATT_LOAD(j_lo);
    for (int t = j_lo; t < j_hi; ++t) {
        const int kb = t * KVBLK, bo = ((t - j_lo) & 1) * ATT_BUF;
        *(v4u*)(K_lds + bo + kws) = k0; *(v4u*)(K_lds + bo + kws + 32 * 256) = k1; *(v4u*)(V_lds + bo + vst0) = v0; *(v4u*)(V_lds + bo + vst1) = v1;
        if (tid < 64) b_lds[bo / 4 + tid] = bia;
        if (t + 1 < j_hi) ATT_LOAD(t + 1);
        __syncthreads();
        if (kb <= qlo + QBLK - 1) {
            f32x16 p0, p1; float mn, alpha; bf16x8 pa0, pa1, pa2, pa3;
            qkt(p0, p1, K_lds + bo, b_lds + bo / 4, r32, hi, qr);
            if (kb + KVBLK - 1 > qlo) mask_tile(p0, p1, qlo + r32 - 4 * hi - kb);
            partialSM(p0, p1, m_reg, mn, alpha);
            if (__any(alpha < 1.f)) { if (hi == 0) al_l[r32] = alpha; asm volatile("s_waitcnt lgkmcnt(0)" ::: "memory");
#pragma unroll
                for (int d_ = 0; d_ < 4; ++d_)
#pragma unroll
                    for (int r = 0; r < 16; ++r) o[d_][r] *= al_l[crow(r, hi)]; }
            finishSM(p0, p1, alpha, l_reg, pa0, pa1, pa2, pa3);
            pv_tile(o, vb0 + bo, pa0, pa1, pa2, pa3);
        }
    }
#undef ATT_LOAD
    if (hi == 0) li_l[r32] = l_reg; asm volatile("s_waitcnt lgkmcnt(0)" ::: "memory");
    float rli[16];
#pragma unroll
    for (int r = 0; r < 16; ++r) rli[r] = __builtin_amdgcn_rcpf(li_l[crow(r, hi)]);
    bf16* Ow = (bf16*)(F.ws + WS_MIXED) + (size_t)qlo * 2048 + M_FOX + 128 * h;
#pragma unroll
    for (int r = 0; r < 16; ++r) { const int orow = crow(r, hi);
#pragma unroll
        for (int d0 = 0; d0 < 4; ++d0) { const float v = o[d0][r] * rli[r]; const float vn = __shfl_xor(v, 1);
            if ((r32 & 1) == 0) *(unsigned*)(Ow + (size_t)orow * 2048 + d0 * 32 + r32) = cvtpk(v, vn); } }
    __syncthreads();
}
__device__ __forceinline__ int att_jlo(Frame& F, int h, int qb, int lane, float& cfirst) {
    asm volatile("" : "+v"(lane));
    const float* CUM = (const float*)(F.ws + WS_CUM) + (size_t)h * S_; const float* MQK = (const float*)(F.ws + WS_MAXQK);
    cfirst = CUM[qb * 256];
    const float kmx = wave_max(lane <= qb ? MQK[(h * 64 + lane) * 2 + 1] : 0.f);
    const float Dn = MQK[(h * 64 + qb) * 2] * (kmx + MQK[(h * 64 + qb) * 2 + 1]) * fa::SCALE + 30.f;
    int cand = 4 * qb;
    float cj[4];
#pragma unroll
    for (int i = 0; i < 4; ++i) { const int j = lane + 64 * i, jc = j < 4 * qb ? j : 0; cj[i] = CUM[64 * jc + 63]; }
#pragma unroll
    for (int i = 0; i < 4; ++i) { const int j = lane + 64 * i; if (j < 4 * qb) { const bool skip = (cfirst - cj[i]) < -Dn; if (!skip && j < cand) cand = j; } }
    return wave_min_i(cand);
}
__device__ __forceinline__ void att_ref(Frame& F, int id, int lane, fa2::BlockRef& r) {
    const int h = id >> 6, qb = id & 63; const bf16* QH = (const bf16*)(F.ws + WS_QKVH);
    r.Q = QH + ((size_t)(G_FQ + h) * S_ + qb * 256) * 128; r.K = QH + (size_t)(G_FK + h) * S_ * 128; r.V = QH + (size_t)(G_FV + h) * S_ * 128;
    r.O = (bf16*)(F.ws + WS_MIXED) + (size_t)(qb * 256) * 2048 + M_FOX + 128 * h; r.C = (const float*)(F.ws + WS_CUM) + (size_t)h * S_; r.P0 = qb * 256;
    float cf; const int jl = att_jlo(F, h, qb, lane, cf); r.jlo = __builtin_amdgcn_readfirstlane(jl); r.cf = __builtin_bit_cast(float, __builtin_amdgcn_readfirstlane(__builtin_bit_cast(int, cf)));
}
#ifndef REPATT
#define REPATT 1
#endif
#ifndef REPR3
#define REPR3 1
#endif
__device__ __forceinline__ void mixa1_phase(Frame& F, int l, int rep) {
    volatile unsigned* nxt = (volatile unsigned*)(F.lds + LDSCTL_OFF + 64);
    unsigned* head = (unsigned*)(F.ctl + CW_Q + 128 * l + 16 * rep);
#pragma unroll 1
    for (int ra = 0; ra < REPATT; ++ra) {
        int tid = F.tid; asm volatile("" : "+v"(tid)); const int lane = tid & 63;
        unsigned* xh = (unsigned*)(F.ctl + CW_QX + (((l * 2 + rep) * 2 + ra) * 8 + (int)(blockIdx.x & 7)) * 16);
        const int ubase = 48 * (int)(blockIdx.x & 7);
        if (F.tid == 0) *nxt = __hip_atomic_fetch_add(xh, 1u, RLX_AGENT);
        __syncthreads();
        int k = __builtin_amdgcn_readfirstlane((int)*nxt);
        __syncthreads();
        while (k < 48) {
            fa2::Seam S; fa2::BlockRef cur;
            att_ref(F, ubase + k, lane, cur);
#ifdef DBG_TILES
            if (F.tid == 0) __hip_atomic_fetch_add(F.ctl + 20000, (unsigned)((cur.P0 + 255) / 64 + 1 - cur.jlo), RLX_AGENT);
#endif
            fa2::prime(cur, (char*)F.lds, S, tid);
            fa2::block(cur, (char*)F.lds, S, tid);
            if (F.tid == 0) *nxt = __hip_atomic_fetch_add(xh, 1u, RLX_AGENT);
            __syncthreads();
            k = __builtin_amdgcn_readfirstlane((int)*nxt);
            __syncthreads();
        }
    }
    constexpr int N_CONV = 256, N_R1 = 1536;
#pragma unroll 1
    for (int rr = 0; rr < REPR3; ++rr)
    for (;;) {
        if (F.tid == 0) *nxt = __hip_atomic_fetch_add(head + 64 + 4 * rr, 1u, RLX_AGENT);
        __syncthreads();
        const int id = __builtin_amdgcn_readfirstlane((int)*nxt);
        __syncthreads();
        constexpr int N_F1 = N_CONV + (R1_IN_A0 ? 0 : N_R1 / 4), N_CC = CONV_A1 ? 256 : 0;
        if (id >= N_F1 + N_CC) break;
        if (id < N_CONV) conv_item(F, l, id);
        else if (id < N_F1) {
#pragma unroll 1
            for (int q = 0; q < 4; ++q) { const int it = (id - N_CONV) * 4 + q; r1_item(F, it / 6, it % 6); } }
        else convert_items(F, l, 16384 + (id - N_F1) * 32 + F.wave, 8, 4);
    }
}
__device__ __forceinline__ void mixr3_phase(Frame& F, int l) {
    int it = F.vcu;
    if (it < 1536) {
        R3In a, b;
        r3_load(F, l, it / 6, it % 6, a);
        for (;;) {
            const bool hb = it + F.G < 1536;
            if (hb) r3_load(F, l, (it + F.G) / 6, (it + F.G) % 6, b);
            r3_compute(F, l, it / 6, it % 6, a);
            if (!hb) break;
            it += F.G;
            const bool ha = it + F.G < 1536;
            if (ha) r3_load(F, l, (it + F.G) / 6, (it + F.G) % 6, a);
            r3_compute(F, l, it / 6, it % 6, b);
            if (!ha) break;
            it += F.G;
        }
    }
}

__device__ __forceinline__ void route_phase(Frame& F, int l) {
    const Args& A = *F.a; const float* rb = A.in[I_RB];
    const int t = (F.vcu * NWAVES + F.wave) * 64 + F.lane;
    if (t >= S_) return;
    const float* lg = (const float*)(F.ws + WS_LOGIT) + (size_t)t * 128;
    float bgs = -__builtin_inff(); int be0 = 0, be1 = 0; float ba0 = 0.f, ba1 = 0.f;
#pragma unroll
    for (int g = 0; g < 8; ++g) {
        f32x4 v0 = {0.f, 0.f, 0.f, 0.f}, v1 = {0.f, 0.f, 0.f, 0.f};
#pragma unroll
        for (int ks = 0; ks < 4; ++ks) { const float* p = lg + (size_t)ks * S_ * 128; v0 += *(const f32x4*)(p + 8 * g) + *(const f32x4*)(p + 64 + 8 * g); v1 += *(const f32x4*)(p + 8 * g + 4) + *(const f32x4*)(p + 64 + 8 * g + 4); }
        float s1 = -__builtin_inff(), s2 = -__builtin_inff(), a1 = 0.f, a2 = 0.f; int i1 = 0, i2 = 0;
#pragma unroll
        for (int i = 0; i < 8; ++i) { const float x = i < 4 ? v0[i] : v1[i - 4]; const float aff = 1.f / (1.f + __expf(-x)); const float sel = aff + rb[8 * g + i];
            if (sel > s1) { s2 = s1; i2 = i1; a2 = a1; s1 = sel; i1 = i; a1 = aff; } else if (sel > s2) { s2 = sel; i2 = i; a2 = aff; } }
        const float gs = s1 + s2;
        if (gs > bgs) { bgs = gs; be0 = 8 * g + i1; be1 = 8 * g + i2; ba0 = a1; ba1 = a2; }
    }
    const float inv = 1.f / (ba0 + ba1);
    unsigned* cnt = (unsigned*)(F.ctl + CW_CNT + 64 * l);
    const int p0 = (int)__hip_atomic_fetch_add(cnt + be0, 1u, RLX_AGENT), p1 = (int)__hip_atomic_fetch_add(cnt + be1, 1u, RLX_AGENT);
    int* TOPE = (int*)(F.ws + WS_ROUTE); float* TOPW = (float*)(F.ws + WS_ROUTE + 131072); int* TOPPOS = (int*)(F.ws + WS_ROUTE + 2 * 131072); int* TOKTAB = (int*)(F.ws + WS_TOKTAB);
    TOPE[2 * t] = be0; TOPE[2 * t + 1] = be1; TOPW[2 * t] = ba0 * inv; TOPW[2 * t + 1] = ba1 * inv; TOPPOS[2 * t] = p0; TOPPOS[2 * t + 1] = p1;
    TOKTAB[be0 * 16384 + p0] = t; TOKTAB[be1 * 16384 + p1] = t;
}
#ifndef ROUTER_HILO
#define ROUTER_HILO 0
#endif
__device__ __forceinline__ void normb_route_phase(Frame& F, int l) {
    const Args& A = *F.a;
    constexpr int AP = 2056;
    bf16* Ahi = (bf16*)F.lds; bf16* Alo = Ahi + 16 * AP; float* red = (float*)F.lds; float* fin = red + 8 * 1024;
    static_assert(!ROUTER_HILO, "the modulation vectors reuse the lo tile's LDS");
    float* AVl = (float*)Alo; float* BVl = AVl + 2048;
    const float* MODF = (const float*)(F.ws + WS_MODF) + l * 12288; const float* X1 = (const float*)(F.ws + WS_X1); bf16* H = (bf16*)(F.ws + WS_H);
    const bf16* RW = (const bf16*)(F.ws + WS_RWT2);
    const int lane = F.lane, c0 = lane * 4;
    float a_[4], b_[4];
    {
#pragma unroll
      for (int q = 0; q < 4; ++q) { const int col = F.tid + NWAVES * 64 * q; a_[q] = A.in[I_N2G][l * 2048 + col] * (1.f + MODF[8192 + col]); b_[q] = MODF[6144 + col]; } }

    const int w = F.wave, mr = lane & 15, kq = lane >> 4;
#if !ROUTER_HILO
    bf16x8 wf[8][4];
#pragma unroll
    for (int ks = 0; ks < 8; ++ks)
#pragma unroll
        for (int et = 0; et < 4; ++et) wf[ks][et] = *(const bf16x8*)(RW + (size_t)(16 * et + mr) * 4096 + 256 * w + 32 * ks + 8 * kq);
#endif
    asm volatile("" ::: "memory");
#pragma unroll
    for (int q = 0; q < 4; ++q) { const int col = F.tid + NWAVES * 64 * q; AVl[col] = a_[q]; BVl[col] = b_[q]; }
    __syncthreads();
    for (int blk = F.vcu; blk < S_ / 16; blk += F.G) {
        const int R0 = blk * 16;
        f32x4 xr[2][8];
#pragma unroll
        for (int q = 0; q < 2; ++q) { const int t = R0 + 2 * w + q;
#pragma unroll
            for (int j = 0; j < 8; ++j) {
#if X1_BF16
                { const v2u w2 = *(const v2u*)((const bf16*)X1 + (size_t)t * 2048 + c0 + 256 * j); xr[q][j] = (f32x4){bflo(w2.x), bfhi(w2.x), bflo(w2.y), bfhi(w2.y)}; }
#else
                xr[q][j] = *(const f32x4*)(X1 + (size_t)t * 2048 + c0 + 256 * j);
#endif
            } }
        asm volatile("" ::: "memory");
#pragma unroll
        for (int q = 0; q < 2; ++q) { const int rl = 2 * w + q, t = R0 + rl; f32x4 x[8]; float ss = 0.f;
#pragma unroll
            for (int j = 0; j < 8; ++j) { x[j] = xr[q][j];
                ss += (x[j][0] * x[j][0] + x[j][1] * x[j][1]) + (x[j][2] * x[j][2] + x[j][3] * x[j][3]); }
            const float rs = 1.0f / sqrtf(wave_sum(ss) * (1.f / 2048.f) + EPS_);
#pragma unroll
            for (int j = 0; j < 8; ++j) { const f32x4 hv = x[j] * rs * *(const f32x4*)(AVl + c0 + 256 * j) + *(const f32x4*)(BVl + c0 + 256 * j); v2u o; o.x = pk2(hv[0], hv[1]); o.y = pk2(hv[2], hv[3]);
                v2u ql; ql.x = pk2(hv[0] - bflo(o.x), hv[1] - bfhi(o.x)); ql.y = pk2(hv[2] - bflo(o.y), hv[3] - bfhi(o.y));
                if (MOE_FP8) *(int*)((unsigned char*)H + (size_t)t * 2048 + c0 + 256 * j) = pg8::pk4_fp8(4.f * hv[0], 4.f * hv[1], 4.f * hv[2], 4.f * hv[3]);
                else *(v2u*)(H + (size_t)t * 2048 + c0 + 256 * j) = o;
                *(v2u*)(Ahi + rl * AP + c0 + 256 * j) = o; if (ROUTER_HILO) *(v2u*)(Alo + rl * AP + c0 + 256 * j) = ql; } }
        __syncthreads();
        f32x4 acc[4] = {{0.f, 0.f, 0.f, 0.f}, {0.f, 0.f, 0.f, 0.f}, {0.f, 0.f, 0.f, 0.f}, {0.f, 0.f, 0.f, 0.f}};
#if ROUTER_HILO
#pragma unroll 2
        for (int ks = 0; ks < 8; ++ks) { const int k0 = 256 * w + 32 * ks + 8 * kq;
            const bf16x8 ah = *(const bf16x8*)(Ahi + mr * AP + k0), al = *(const bf16x8*)(Alo + mr * AP + k0);
#pragma unroll
            for (int et = 0; et < 4; ++et) { const bf16x8 wh = *(const bf16x8*)(RW + (size_t)(16 * et + mr) * 4096 + k0), wl = *(const bf16x8*)(RW + (size_t)(64 + 16 * et + mr) * 4096 + k0);
                acc[et] = __builtin_amdgcn_mfma_f32_16x16x32_bf16(ah, wh, acc[et], 0, 0, 0);
                acc[et] = __builtin_amdgcn_mfma_f32_16x16x32_bf16(al, wh, acc[et], 0, 0, 0); acc[et] = __builtin_amdgcn_mfma_f32_16x16x32_bf16(ah, wl, acc[et], 0, 0, 0); } }
#else
#pragma unroll
        for (int ks = 0; ks < 8; ++ks) { const bf16x8 ah = *(const bf16x8*)(Ahi + mr * AP + 256 * w + 32 * ks + 8 * kq);
#pragma unroll
            for (int et = 0; et < 4; ++et) acc[et] = __builtin_amdgcn_mfma_f32_16x16x32_bf16(ah, wf[ks][et], acc[et], 0, 0, 0); }
#endif
        __syncthreads();
#pragma unroll
        for (int et = 0; et < 4; ++et)
#pragma unroll
            for (int r = 0; r < 4; ++r) red[w * 1024 + (4 * kq + r) * 64 + 16 * et + mr] = acc[et][r];
        __syncthreads();
#pragma unroll
        for (int q = 0; q < 2; ++q) { const int idx = F.tid + 512 * q; float s = 0.f;
#pragma unroll
            for (int ww = 0; ww < 8; ++ww) s += red[ww * 1024 + idx];
            fin[idx] = s; }
        __syncthreads();
        if (F.tid < 128) {
            const int rl = F.tid >> 3, g = F.tid & 7, t = R0 + rl; const float* lg = fin + rl * 64 + 8 * g;
            float s1 = -__builtin_inff(), s2 = -__builtin_inff(), a1 = 0.f, a2 = 0.f; int i1 = 0, i2 = 0;
#pragma unroll
            for (int i = 0; i < 8; ++i) { const float aff = 1.f / (1.f + __expf(-lg[i])); const float sel = aff + A.in[I_RB][8 * g + i];
                if (sel > s1) { s2 = s1; i2 = i1; a2 = a1; s1 = sel; i1 = i; a1 = aff; } else if (sel > s2) { s2 = sel; i2 = i; a2 = aff; } }
            float gs = s1 + s2; int bg = g, e0 = 8 * g + i1, e1 = 8 * g + i2;
#pragma unroll
            for (int o = 1; o < 8; o <<= 1) { const float ogs = __shfl_xor(gs, o); const int obg = __shfl_xor(bg, o), oe0 = __shfl_xor(e0, o), oe1 = __shfl_xor(e1, o); const float oa1 = __shfl_xor(a1, o), oa2 = __shfl_xor(a2, o);
                if (ogs > gs || (ogs == gs && obg < bg)) { gs = ogs; bg = obg; e0 = oe0; e1 = oe1; a1 = oa1; a2 = oa2; } }
            if (g == 0) { const float inv = 1.f / (a1 + a2);
                unsigned* cnt = (unsigned*)(F.ctl + CW_CNT + 64 * l);
                const int p0 = (int)__hip_atomic_fetch_add(cnt + e0, 1u, RLX_AGENT), p1 = (int)__hip_atomic_fetch_add(cnt + e1, 1u, RLX_AGENT);
                int* TOPE = (int*)(F.ws + WS_ROUTE); float* TOPW = (float*)(F.ws + WS_ROUTE + 131072); int* TOPPOS = (int*)(F.ws + WS_ROUTE + 2 * 131072); int* TOKTAB = (int*)(F.ws + WS_TOKTAB);
                TOPE[2 * t] = e0; TOPE[2 * t + 1] = e1; TOPW[2 * t] = a1 * inv; TOPW[2 * t + 1] = a2 * inv; TOPPOS[2 * t] = p0; TOPPOS[2 * t + 1] = p1;
                TOKTAB[e0 * 16384 + p0] = t; TOKTAB[e1 * 16384 + p1] = t; } }
        __syncthreads();
    }
}
__device__ __forceinline__ int moe_tables(Frame& F, int l) {
    int* te = (int*)(F.lds + LDS_TE); int* off = (int*)(F.lds + LDS_OFFS); int* cn = off + 128;
    const unsigned* cnt = (const unsigned*)(F.ctl + CW_CNT + 64 * l);
    static_assert(NE == 64, "one expert per lane of wave 0");
    if (__builtin_amdgcn_readfirstlane(F.tid >> 6) == 0) {
        const int e = F.lane;
        const int c = (int)__hip_atomic_load(cnt + e, RLX_AGENT);
        const int n = (c + 255) >> 8;
        int incl = n;
#pragma unroll
        for (int o = 1; o < 64; o <<= 1) { const int t = __shfl_up(incl, o); if (e >= o) incl += t; }
        const int start = incl - n;
        cn[e] = c; off[e] = start * 256;
        for (int q = 0; q < n; ++q) { const int ti = start + q; if (ti < 192) te[ti] = e; }
        if (e == NE - 1) off[NE] = incl < 192 ? incl : 192;
    }
    __syncthreads();
    return off[NE];
}
template <class Sched>
__device__ __forceinline__ void moe_tokbuf(Frame& F, const Sched& S) {
    const int* te = (const int*)(F.lds + LDS_TE); const int* off = (const int*)(F.lds + LDS_OFFS); const int* cn = off + 128; int* tb = (int*)(F.lds + LDS_TOK);
    const int* TOKTAB = (const int*)(F.ws + WS_TOKTAB);
    const int tr = F.tid & 255;
#pragma unroll 1
    for (int i0 = 0; i0 < 9; i0 += 3) { int tv[3]; bool ok[3];
#pragma unroll
        for (int q = 0; q < 3; ++q) { pg8::Unit u; ok[q] = S.next(i0 + q, u); const int pm = ok[q] ? u.pm : 0; const int e = te[pm], idx = (pm - (off[e] >> 8)) * 256 + tr; const bool in = ok[q] && idx < cn[e];
            tv[q] = TOKTAB[in ? e * 16384 + idx : 0]; if (!in) tv[q] = 0; }
        asm volatile("" ::: "memory");
#pragma unroll
        for (int q = 0; q < 3; ++q) if (ok[q] && F.tid < 256) tb[(i0 + q) * 256 + F.tid] = tv[q];
        if (!ok[2]) break; }
    __syncthreads();
}

constexpr int N_PHASES = 24;
#ifndef MK_PER_PHASE
#define MK_PER_PHASE 0
#endif
__global__ void __launch_bounds__(NWAVES * 64, 2) fwd_kernel(Args args) {
    extern __shared__ __attribute__((aligned(16))) unsigned char lds[];
    Frame F;
    F.lds = lds; F.ws = args.ws; F.a = &args; F.ctl = (gu32*)(args.ws + WS_CTL);
    F.tid = threadIdx.x; F.lane = F.tid & 63; F.wave = __builtin_amdgcn_readfirstlane(F.tid >> 6);
    F.G = gridDim.x; { const int bx = blockIdx.x; F.vcu = (F.G % 8 == 0) ? (bx % 8) * (F.G / 8) + bx / 8 : bx; }
    for (int u = F.tid; u < (LDS_BYTES - LDSCTL_OFF) / 4; u += NWAVES * 64) ((unsigned*)(lds + LDSCTL_OFF))[u] = 0u;
    __syncthreads();
    XcdBarrier bar; bar.bar = (unsigned*)(F.ctl + CW_BAR); bar.x = 0; bar.st = nullptr; bar.wv = (unsigned)F.wave;
    if (!MK_PER_PHASE) bar = xcd_barrier_post((unsigned*)(F.ctl + CW_BAR), (volatile LAS unsigned*)(lds + LDSCTL_OFF));
#ifdef DBG_XCC
    if (threadIdx.x == 0) __hip_atomic_store(F.ctl + 16384 + blockIdx.x, 1u + (xb_xcc_id() & 15u), RLX_AGENT);
#endif
    const int lo = args.ph_lo, hi = args.ph_hi; (void)lo; (void)hi;
#ifndef PHMASK
#define PHMASK 0xFFFFFF
#endif
#if MK_PER_PHASE
#define IN(k) (lo <= (k) && (k) < hi)
#else
#define IN(k) true
#endif
#define EN(j) ((PHMASK >> (j)) & 1)
#ifndef REPMASK
#define REPMASK 0
#endif
#define NREP(j) (((REPMASK >> (j)) & 1) ? 2 : 1)
#define REFRESH() do { int t_ = (F.wave << 6) | LANE_ID(); asm volatile("" : "+v"(t_)); F.tid = t_; F.lane = t_ & 63; unsigned long long z_ = 0; asm volatile("" : "+s"(z_)); F.ws = args.ws + z_; F.ctl = (gu32*)(F.ws + WS_CTL); int g_ = (int)gridDim.x, b_ = (int)blockIdx.x; asm volatile("" : "+s"(g_), "+s"(b_)); F.G = g_; F.vcu = (g_ % 8 == 0) ? (b_ % 8) * (g_ / 8) + b_ / 8 : b_; } while (0)
#ifndef G1_ALIGN
#define G1_ALIGN true
#endif
#ifndef DOWN_ALIGN
#define DOWN_ALIGN true
#endif
#ifndef MOE_BAUX
#define MOE_BAUX 0
#endif
#ifndef NBAR
#define NBAR 1
#endif
#ifndef MOE_CONV_IN_G1
#define MOE_CONV_IN_G1 1
#endif
#define CONV_G1_LIM (CONV_A1 ? 16384 : 24576)
#ifndef REPCONV
#define REPCONV 1
#endif
#ifndef G1_SLOTS
#define G1_SLOTS 7
#endif
#define SEAM(k) do { if (IN((k) + 1)) { if (!MK_PER_PHASE) { bar.bar = (unsigned*)(F.ctl + CW_BAR); for (int nb_ = 0; nb_ < NBAR; ++nb_) xcd_barrier(bar); } } } while (0)
    LAS unsigned char* ldsl = (LAS unsigned char*)lds;

    if (EN(11) && IN(0)) { _Pragma("unroll 1") for (int rep = 0; rep < NREP(11); ++rep) p0_prologue(F);
        if (MOE_CONV_IN_G1 != 1) { __syncthreads(); _Pragma("unroll 1") for (int l = 0; l < NL; ++l) { REFRESH(); const int w0 = F.vcu * NWAVES + F.wave, NGW = F.G * NWAVES; convert_items(F, l, w0, NGW, (24576 - w0 + NGW - 1) / NGW); } }
        SEAM(0); }
    for (int l = 0; l < NL; ++l) {
        const int pb = 1 + 11 * l;
        if (EN(0) && IN(pb + 0)) { _Pragma("unroll 1") for (int rep = 0; rep < NREP(0); ++rep) { REFRESH(); if (l == 0) { if (EN(13)) norm_phase<0>(F, l); } else { if (EN(14)) norm_phase<1>(F, l); } } SEAM(pb + 0); }
        if (EN(1) && IN(pb + 1)) { _Pragma("unroll 1") for (int rep = 0; rep < NREP(1); ++rep) {
            _Pragma("unroll 1") for (int part = 0; part < (MOE_CONV_IN_G1 ? 2 : 1); ++part) { REFRESH();
                pg8::Gemm g{(const bf16*)(F.ws + WS_H), (const bf16*)(F.ws + WS_WIN) + (size_t)l * NPJ * 2048, S_, NPJ, 2048, 2048, 0};
                pg8::DenseOrder S; S.init(S_, NPJ, 2048, F.G, (int)blockIdx.x);
                pg8::EpiBf16 E{(bf16*)(F.ws + WS_PROJ), NPC, (bf16*)(F.ws + WS_QKVH), C_RQ, S_, 1.f};
                if (MOE_CONV_IN_G1) { const int slot = (((int)blockIdx.x >> 3) * G1_SLOTS) >> 5;
                    S.i0 = part ? slot : 0; S.cnt = part ? (1 << 30) : slot; }
                pg8::gemm_phase<pg8::EpiBf16, pg8::DenseOrder, G1_ALIGN, true>(ldsl + RING_OFF, g, S, E, F.wave);
                if (MOE_CONV_IN_G1 == 1 && part == 0) { __syncthreads(); const int w0 = F.vcu * NWAVES + F.wave, NGW = F.G * NWAVES;
                    _Pragma("unroll 1") for (int rc = 0; rc < REPCONV; ++rc) convert_items(F, l, w0, NGW, (CONV_G1_LIM - w0 + NGW - 1) / NGW); __syncthreads(); }
            }
            } SEAM(pb + 1); }
        if (EN(2) && IN(pb + 2)) { _Pragma("unroll 1") for (int rep = 0; rep < NREP(2); ++rep) { REFRESH(); mixa0_phase(F); } SEAM(pb + 2); }
        if (EN(3) && IN(pb + 3)) { _Pragma("unroll 1") for (int rep = 0; rep < NREP(3); ++rep) { REFRESH(); mixa1_phase(F, l, rep); } SEAM(pb + 3); }
        if (EN(4) && IN(pb + 4)) { _Pragma("unroll 1") for (int rep = 0; rep < NREP(4); ++rep) { REFRESH(); mixb_phase(F); } SEAM(pb + 4); }
        if (EN(5) && IN(pb + 5)) { _Pragma("unroll 1") for (int rep = 0; rep < NREP(5); ++rep) { REFRESH(); mixr3_phase(F, l); } SEAM(pb + 5); }
        if (EN(6) && IN(pb + 6)) { _Pragma("unroll 1") for (int rep = 0; rep < NREP(6); ++rep) { REFRESH();
            pg8::Gemm g{(const bf16*)(F.ws + WS_MIXED), (const bf16*)(F.ws + WS_WOUT) + (size_t)l * 2048 * 2048, S_, 2048, 2048, 2048, 0};
            pg8::DenseOrder S; S.init(S_, 2048, 2048, F.G, (int)blockIdx.x);
            pg8::EpiResid E{l == 0 ? args.in[I_X] : (const float*)args.out, (float*)(F.ws + WS_X1), (const float*)(F.ws + WS_MODF) + l * 12288 + 4096, 2048};
            pg8::gemm_phase<pg8::EpiResid, pg8::DenseOrder, true, true>(ldsl + RING_OFF, g, S, E, F.wave);
            } SEAM(pb + 6); }
        if (EN(7) && IN(pb + 7)) { _Pragma("unroll 1") for (int rep = 0; rep < NREP(7); ++rep) { REFRESH(); if (rep == 0) normb_route_phase(F, l); } SEAM(pb + 7); }
        if (EN(9) && IN(pb + 9)) { _Pragma("unroll 1") for (int rep = 0; rep < NREP(9); ++rep) { REFRESH();
            const int nT = moe_tables(F, l);
#if MOE_FP8
            pg8::Gemm g{(const bf16*)(F.ws + WS_H), (const bf16*)(F.ws + WS_WGU + (size_t)l * NE * 1024 * 2048), PMAX, 1024, 1024, 1024, 2048};
            pg8::MoeOrder S{(const LAS int*)(ldsl + LDS_TE), nT, 4, F.G, (int)blockIdx.x, (long)1024 * 2048, (long)256 * 2048, 0, (const LAS int*)(ldsl + LDS_TOK)};
            moe_tokbuf(F, S);
            pg8::EpiGateUp8 E{F.ws + WS_ACT, DE, 1.f / 128.f, 4.f};
            pg8::gemm_phase<pg8::EpiGateUp8, pg8::MoeOrder, true, true, true, MOE_BAUX, true>(ldsl + RING_OFF, g, S, E, F.wave);
#else
            pg8::Gemm g{(const bf16*)(F.ws + WS_H), (const bf16*)(F.ws + WS_WGU) + (size_t)l * NE * 1024 * 2048, PMAX, 1024, 2048, 2048, 4096};
            pg8::MoeOrder S{(const LAS int*)(ldsl + LDS_TE), nT, 4, F.G, (int)blockIdx.x, (long)1024 * 2048 * 2, (long)256 * 2048 * 2, 0, (const LAS int*)(ldsl + LDS_TOK)};
            moe_tokbuf(F, S);
            pg8::EpiGateUp E{(bf16*)(F.ws + WS_ACT), DE};
            pg8::gemm_phase<pg8::EpiGateUp, pg8::MoeOrder, true, true, true, MOE_BAUX>(ldsl + RING_OFF, g, S, E, F.wave);
#endif
            } SEAM(pb + 9); }
        if (EN(10) && IN(pb + 10)) { _Pragma("unroll 1") for (int rep = 0; rep < NREP(10); ++rep) { REFRESH();
            const int nT = moe_tables(F, l);
#if MOE_FP8
            pg8::Gemm g{(const bf16*)(F.ws + WS_ACT), (const bf16*)(F.ws + WS_WD + (size_t)l * NE * 2048 * 512), PMAX, 2048, 256, 256, 0};
            pg8::MoeOrder S{(const LAS int*)(ldsl + LDS_TE), nT, 8, F.G, (int)blockIdx.x, (long)2048 * 512, (long)256 * 512, (long)256 * 512, (const LAS int*)(ldsl + LDS_TOK)};
            pg8::EpiFp8 E{F.ws + WS_YS, 2048, 16.f / 128.f};
            pg8::gemm_phase<pg8::EpiFp8, pg8::MoeOrder, DOWN_ALIGN, true, false, MOE_BAUX, true>(ldsl + RING_OFF, g, S, E, F.wave);
#else
            pg8::Gemm g{(const bf16*)(F.ws + WS_ACT), (const bf16*)(F.ws + WS_WD) + (size_t)l * NE * 2048 * 512, PMAX, 2048, DE, DE, 0};
            pg8::MoeOrder S{(const LAS int*)(ldsl + LDS_TE), nT, 8, F.G, (int)blockIdx.x, (long)2048 * 512 * 2, (long)256 * 512 * 2, (long)256 * 512 * 2, (const LAS int*)(ldsl + LDS_TOK)};
            pg8::EpiBf16 E{(bf16*)(F.ws + WS_YS), 2048, nullptr, 0, 0, 1.f};
            pg8::gemm_phase<pg8::EpiBf16, pg8::MoeOrder, DOWN_ALIGN, true, false, MOE_BAUX>(ldsl + RING_OFF, g, S, E, F.wave);
#endif
            } SEAM(pb + 10); }
    }
    if (EN(12) && IN(23)) { REFRESH(); norm_phase<3>(F, NL - 1);
#ifdef DBG_R3T
        xcd_barrier(bar);
        { const unsigned long long tt = __hip_atomic_load((unsigned long long*)(F.ctl + 20010 + 2 * DBG_R3T), RLX_AGENT); const float us = (float)tt * 0.01f / 12.f;
          const float sc = 1.f + us * 0.1f;
          for (size_t i = (size_t)blockIdx.x * 512 + threadIdx.x; i < (size_t)S_ * D_; i += (size_t)gridDim.x * 512) args.out[i] *= sc; }
#endif
#ifdef DBG_TILES
        xcd_barrier(bar);
        { const float avg = (float)__hip_atomic_load(F.ctl + 20000, RLX_AGENT) / 768.f; const float sc = 1.f + avg * 0.01f;
          for (size_t i = (size_t)blockIdx.x * 512 + threadIdx.x; i < (size_t)S_ * D_; i += (size_t)gridDim.x * 512) args.out[i] *= sc; }
#endif
#ifdef DBG_XCC
        xcd_barrier(bar);
        { bool okA = true, okB = true; for (int b = 0; b < 256; ++b) { const unsigned xb = __hip_atomic_load(F.ctl + 16384 + b, RLX_AGENT); if (xb != __hip_atomic_load(F.ctl + 16384 + (b & 7), RLX_AGENT)) okA = false; if (xb != __hip_atomic_load(F.ctl + 16384 + (b & ~31), RLX_AGENT)) okB = false; }
          const float sc = okA ? 1.1f : (okB ? 1.2f : 1.3f);
          for (size_t i = (size_t)blockIdx.x * 512 + threadIdx.x; i < (size_t)S_ * D_; i += (size_t)gridDim.x * 512) args.out[i] *= sc; }
#endif
    }
#undef IN
#undef SEAM
}

extern "C" void kernel_launch(void* const* d_in, const int* in_sizes, int n_in, void* d_out, int out_size, void* d_ws, size_t ws_size, hipStream_t stream) {
    static int grid = 0;
    if (grid == 0) {
        if (n_in != 17 || out_size != S_ * D_ || ws_size < WS_END) { fprintf(stderr, "kernel_launch: unexpected shapes (n_in %d out %d ws %zu)\n", n_in, out_size, ws_size); grid = -1; return; }
        int dev = 0, cus = 0, per_cu = 0;
        if (hipGetDevice(&dev) != hipSuccess || hipDeviceGetAttribute(&cus, hipDeviceAttributeMultiprocessorCount, dev) != hipSuccess) { grid = -1; return; }
        if (hipFuncSetAttribute((const void*)fwd_kernel, hipFuncAttributeMaxDynamicSharedMemorySize, LDS_BYTES) != hipSuccess) { fprintf(stderr, "kernel_launch: hipFuncSetAttribute failed\n"); grid = -1; return; }
        if (hipOccupancyMaxActiveBlocksPerMultiprocessor(&per_cu, (const void*)fwd_kernel, NWAVES * 64, LDS_BYTES) != hipSuccess || per_cu < 1)
            fprintf(stderr, "kernel_launch: note: occupancy query reports %d workgroups per CU\n", per_cu);
        (void)hipGetLastError();
        grid = cus;
    }
    if (grid < 0) return;
    if (hipMemsetAsync((char*)d_ws + WS_CTL, 0, CTL_ZERO_BYTES, stream) != hipSuccess) return;
    Args a{};
    for (int i = 0; i < 17; ++i) a.in[i] = (const float*)d_in[i];
    a.out = (float*)d_out; a.ws = (unsigned char*)d_ws;
#if MK_PER_PHASE
    for (int p = 0; p < N_PHASES; ++p) { a.ph_lo = p; a.ph_hi = p + 1; fwd_kernel<<<dim3(grid), dim3(NWAVES * 64), LDS_BYTES, stream>>>(a); }
#else
    a.ph_lo = 0; a.ph_hi = N_PHASES; fwd_kernel<<<dim3(grid), dim3(NWAVES * 64), LDS_BYTES, stream>>>(a);
#endif
}
```

```cpp
#define MK_PER_PHASE 0
#include <hip/hip_runtime.h>
#include <cstdio>
#include <cstdint>

#define GAS __attribute__((address_space(1)))
#define LAS __attribute__((address_space(3)))
typedef unsigned short bf16;
typedef unsigned v4u __attribute__((ext_vector_type(4)));
typedef unsigned v2u __attribute__((ext_vector_type(2)));
typedef float f32x2 __attribute__((ext_vector_type(2)));
typedef float f32x4 __attribute__((ext_vector_type(4)));
typedef float f32x16 __attribute__((ext_vector_type(16)));
typedef short bf16x8 __attribute__((ext_vector_type(8)));
typedef short s16x4 __attribute__((ext_vector_type(4)));
typedef GAS unsigned gu32;

constexpr int S_ = 16384, D_ = 2048, NL = 2, NIN = 6150, NPJ = 6144;
constexpr int C_CB = 0, C_CC = 512, C_CU = 1024, C_RQ = 1536, C_RK = 1920, C_RV = 2304, C_RG = 3072, C_FQ = 3840, C_FK = 4608, C_FV = 5376, C_FF = 6144;
constexpr int NPC = 1536;
constexpr int G_RQ = 0, G_RK = 3, G_RV = 6, G_RG = 12, G_FQ = 18, G_FK = 24, G_FV = 30;
constexpr int M_CONV = 0, M_RET = 512, M_FOX = 1280;
constexpr int NE = 64, DE = 512, PMAX = 49152;
constexpr float EPS_ = 1e-6f;

#ifndef X1_BF16
#define X1_BF16 0
#endif
__device__ __forceinline__ int lane_id_fresh() { int l; asm volatile("v_mbcnt_lo_u32_b32 %0, -1, 0\n\tv_mbcnt_hi_u32_b32 %0, -1, %0" : "=v"(l)); return l; }
#ifndef TID_V0
#define TID_V0 0
#endif
#if TID_V0
#define LANE_ID() ((int)(threadIdx.x & 63))
#else
#define LANE_ID() lane_id_fresh()
#endif
namespace pg8 {
#define PG8_LAS __attribute__((address_space(3)))
typedef unsigned short bf16_t;
typedef short bf16x8 __attribute__((ext_vector_type(8)));
typedef float f32x4 __attribute__((ext_vector_type(4)));
typedef unsigned u32x4 __attribute__((ext_vector_type(4)));
typedef int v8i_t __attribute__((ext_vector_type(8)));
typedef long l2_t __attribute__((ext_vector_type(2)));
constexpr int BM = 256, BK = 64, HALF = 128, HTB = HALF * BK * 2  , STAGE_BYTES = 8 * HTB, NXCD = 8, WGM = 8;

__host__ __device__ __forceinline__ int lds_byte(int r, int c) { const int st = (r >> 4) * 2 + (c >> 5), rr = r & 15, cc = c & 31, ob = rr * 64 + cc * 2; return st * 1024 + (ob ^ (((ob >> 9) & 1) << 5)); }
__host__ __device__ __forceinline__ void stage_rc(int b, int& R, int& C) { const int st = b / 1024, sb = b % 1024, swz = sb ^ (((sb >> 9) & 1) << 5); R = (st >> 1) * 16 + swz / 64; C = (st & 1) * 32 + (swz % 64) / 2; }
__host__ __device__ __forceinline__ int perm32(int rho) { const int n = rho >> 4, i = rho & 15; return 8 * (i >> 2) + 4 * n + (i & 3); }

struct Unit { int pm, pn; long ao, bo; };
struct Gemm { const bf16_t* A; const bf16_t* Bt; int M, N, K, KL, lda; };

struct DenseOrder {
    int nM, nN, nwg, G, c, i0, cnt; long tsB;
    __device__ void init(int M, int N, int K, int G_, int c_) { nM = M / BM; nN = N / BM; nwg = nM * nN; G = G_; c = c_; tsB = (long)BM * K * 2; i0 = 0; cnt = 1 << 30; }
    __device__ bool next(int i, Unit& u) const {
        if (i >= cnt) return false;
        const long L = (long)(i + i0) * G + c; if (L >= nwg) return false;
        int wgid = (int)L; { const int q = nwg / NXCD, r = nwg % NXCD, xcd = wgid % NXCD, off = wgid / NXCD; wgid = (xcd < r ? xcd * (q + 1) : r * (q + 1) + (xcd - r) * q) + off; }
        const int nig = WGM * nN, gid = wgid / nig, fm = gid * WGM, gsz = (nM - fm) < WGM ? (nM - fm) : WGM;
        u.pm = fm + ((wgid % nig) % gsz); u.pn = (wgid % nig) / gsz; u.ao = (long)u.pm * tsB; u.bo = (long)u.pn * tsB; return true;
    }
    __device__ __forceinline__ void a_ready(const Unit&) const {}
    __device__ __forceinline__ void done(const Unit&) const {}
};
struct MoeOrder {
    const PG8_LAS int* te; int nT, nN, G, c; long estride, tsB, tsA; const PG8_LAS int* tokbuf;
    __device__ bool next(int i, Unit& u) const {
        long L;
#if 1
        if (G == 256) { const int U = nT * nN, x = c & 7, q = U >> 3, rem = U & 7, len = q + (x < rem ? 1 : 0), start = x * q + (x < rem ? x : rem), idx = (c >> 3) + 32 * i;
            if (idx >= len) return false; L = start + idx; } else
#endif
        { L = (long)i * G + c; if (L >= (long)nT * nN) return false; }
        u.pm = (int)(L / nN); u.pn = (int)(L % nN); u.ao = (long)u.pm * tsA; u.bo = (long)te[u.pm] * estride + (long)u.pn * tsB; return true;
    }
    __device__ __forceinline__ int tok(int i, int r) const { return tokbuf[i * 256 + r]; }
    __device__ __forceinline__ void a_ready(const Unit&) const {}
    __device__ __forceinline__ void done(const Unit&) const {}
};
struct RouterOrder {
    int G, c; long tsA, kbytes;
    __device__ bool next(int i, Unit& u) const {
        const long L = (long)i * G + c; if (L >= 256) return false;
        u.pm = (int)(L >> 2); u.pn = (int)(L & 3); u.ao = (long)u.pm * tsA + (long)u.pn * kbytes; u.bo = (long)u.pn * kbytes; return true;
    }
    __device__ __forceinline__ void a_ready(const Unit&) const {}
    __device__ __forceinline__ void done(const Unit&) const {}
};

__device__ __forceinline__ unsigned cvt_pk_bf16(float lo, float hi) { unsigned r; asm volatile("v_cvt_pk_bf16_f32 %0, %1, %2" : "=v"(r) : "v"(lo), "v"(hi)); return r; }

struct EpiBf16 {
    static constexpr bool PERM = true, AFTER_DRAIN = false;
    bf16_t* O; int ldc; bf16_t* HM; int hm_col0, hm_rows; float scale;
    __device__ __forceinline__ void operator()(const f32x4 (&acc)[2][2][4][2], const Unit& u, int wr, int wc, int fr, int fq) const {
        const int row0 = u.pm * BM + wr * 64 + fr, col0 = u.pn * BM + wc * 32 + 8 * fq;
        const bool hm = HM != nullptr && u.pn * BM >= hm_col0;
        const int hd0 = hm ? (u.pn * BM - hm_col0) / 128 : 0;
#pragma unroll
        for (int ai = 0; ai < 2; ++ai)
#pragma unroll
            for (int m = 0; m < 4; ++m) { const int row = row0 + ai * HALF + m * 16;
#pragma unroll
                for (int bj = 0; bj < 2; ++bj) { const f32x4 v0 = acc[ai][bj][m][0] * scale, v1 = acc[ai][bj][m][1] * scale;
                    u32x4 w; w.x = cvt_pk_bf16(v0[0], v0[1]); w.y = cvt_pk_bf16(v0[2], v0[3]); w.z = cvt_pk_bf16(v1[0], v1[1]); w.w = cvt_pk_bf16(v1[2], v1[3]);
                    bf16_t* dst = hm ? HM + ((size_t)(hd0 + bj) * hm_rows + row) * 128 + wc * 32 + 8 * fq : O + (size_t)row * ldc + col0 + bj * HALF;
                    *(u32x4*)dst = w; asm volatile("" ::: "memory"); } }
    }
};
struct EpiResid {
    static constexpr bool PERM = false, AFTER_DRAIN = false;
    const float* Xi; float* Xo; const float* g; int ldc;
    __device__ __forceinline__ void operator()(const f32x4 (&acc)[2][2][4][2], const Unit& u, int wr, int wc, int fr, int fq) const {
        const int row0 = u.pm * BM + wr * 64 + fr, col0 = u.pn * BM + wc * 32 + 4 * fq;
        f32x4 gv[2][2];
#pragma unroll
        for (int bj = 0; bj < 2; ++bj)
#pragma unroll
            for (int n = 0; n < 2; ++n) gv[bj][n] = *(const f32x4*)(g + col0 + bj * HALF + 16 * n);
        const float* __restrict__ xin = Xi; float* __restrict__ xout = Xo;
#pragma unroll
        for (int ai = 0; ai < 2; ++ai)
#pragma unroll
            for (int mp = 0; mp < 4; mp += 2) { f32x4 xi[2][2][2];
#pragma unroll
                for (int mm = 0; mm < 2; ++mm) { const size_t ro = (size_t)(row0 + ai * HALF + (mp + mm) * 16) * ldc + col0;
#pragma unroll
                    for (int bj = 0; bj < 2; ++bj)
#pragma unroll
                        for (int n = 0; n < 2; ++n) xi[mm][bj][n] = *(const f32x4*)(xin + ro + bj * HALF + 16 * n); }
                asm volatile("" ::: "memory");
#pragma unroll
                for (int mm = 0; mm < 2; ++mm) { const size_t ro = (size_t)(row0 + ai * HALF + (mp + mm) * 16) * ldc + col0;
#pragma unroll
                    for (int bj = 0; bj < 2; ++bj)
#pragma unroll
                        for (int n = 0; n < 2; ++n) { const size_t o = ro + bj * HALF + 16 * n;
                            const f32x4 xo = xi[mm][bj][n] + gv[bj][n] * acc[ai][bj][mp + mm][n];
#if X1_BF16
                            { typedef unsigned u32x2 __attribute__((ext_vector_type(2))); *(u32x2*)((bf16_t*)xout + o) = (u32x2){cvt_pk_bf16(xo[0], xo[1]), cvt_pk_bf16(xo[2], xo[3])}; }
#else
                            *(f32x4*)(xout + o) = xo;
#endif
                        } }
                asm volatile("" ::: "memory"); }
    }
};
struct EpiLogits {
    static constexpr bool PERM = false, AFTER_DRAIN = false;
    float* Lg;
    __device__ __forceinline__ void operator()(const f32x4 (&acc)[2][2][4][2], const Unit& u, int wr, int wc, int fr, int fq) const {
        const int row0 = u.pn * 16384 + u.pm * BM + wr * 64 + fr, col0 = wc * 32 + 4 * fq;
#pragma unroll
        for (int ai = 0; ai < 2; ++ai)
#pragma unroll
            for (int m = 0; m < 4; ++m)
#pragma unroll
                for (int n = 0; n < 2; ++n) *(f32x4*)(Lg + (size_t)(row0 + ai * HALF + m * 16) * 128 + col0 + 16 * n) = acc[ai][0][m][n];
    }
};
struct EpiGateUp {
    static constexpr bool PERM = true, AFTER_DRAIN = false;
    bf16_t* O; int ldc;
    __device__ __forceinline__ void operator()(const f32x4 (&acc)[2][2][4][2], const Unit& u, int wr, int wc, int fr, int fq) const {
        const int row0 = u.pm * BM + wr * 64 + fr, col0 = u.pn * HALF + wc * 32 + 8 * fq;
#pragma unroll
        for (int ai = 0; ai < 2; ++ai)
#pragma unroll
            for (int m = 0; m < 4; ++m) { float a[8];
#pragma unroll
                for (int n = 0; n < 2; ++n)
#pragma unroll
                    for (int i = 0; i < 4; ++i) { const float gt = acc[ai][0][m][n][i], up = acc[ai][1][m][n][i];
                        a[n * 4 + i] = gt * __builtin_amdgcn_rcpf(1.f + __builtin_amdgcn_exp2f(-1.4426950408889634f * gt)) * up; }
                u32x4 w; w.x = cvt_pk_bf16(a[0], a[1]); w.y = cvt_pk_bf16(a[2], a[3]); w.z = cvt_pk_bf16(a[4], a[5]); w.w = cvt_pk_bf16(a[6], a[7]);
                *(u32x4*)(O + (size_t)(row0 + ai * HALF + m * 16) * ldc + col0) = w; }
    }
};
__device__ __forceinline__ float sat8(float x) { return __builtin_amdgcn_fmed3f(x, -448.f, 448.f); }
__device__ __forceinline__ int pk4_fp8_raw(float a, float b, float c, float d) { int w = __builtin_amdgcn_cvt_pk_fp8_f32(a, b, 0, false); return __builtin_amdgcn_cvt_pk_fp8_f32(c, d, w, true); }
__device__ __forceinline__ int pk4_fp8(float a, float b, float c, float d) { int w = __builtin_amdgcn_cvt_pk_fp8_f32(sat8(a), sat8(b), 0, false); return __builtin_amdgcn_cvt_pk_fp8_f32(sat8(c), sat8(d), w, true); }
struct EpiGateUp8 {
    static constexpr bool PERM = true, AFTER_DRAIN = false;
    unsigned char* O; int ldc; float in_scale, out_scale;
    __device__ __forceinline__ void operator()(const f32x4 (&acc)[2][2][4][2], const Unit& u, int wr, int wc, int fr, int fq) const {
        const int row0 = u.pm * BM + wr * 64 + fr, col0 = u.pn * HALF + wc * 32 + 8 * fq;
#pragma unroll
        for (int ai = 0; ai < 2; ++ai)
#pragma unroll
            for (int m = 0; m < 4; ++m) { float a[8];
#pragma unroll
                for (int n = 0; n < 2; ++n)
#pragma unroll
                    for (int i = 0; i < 4; ++i) { const float gt = acc[ai][0][m][n][i] * in_scale, up = acc[ai][1][m][n][i] * in_scale;
                        a[n * 4 + i] = gt * __builtin_amdgcn_rcpf(1.f + __builtin_amdgcn_exp2f(-1.4426950408889634f * gt)) * up * out_scale; }
                typedef int i32x2 __attribute__((ext_vector_type(2)));
                *(i32x2*)(O + (size_t)(row0 + ai * HALF + m * 16) * ldc + col0) = (i32x2){pk4_fp8(a[0], a[1], a[2], a[3]), pk4_fp8(a[4], a[5], a[6], a[7])}; asm volatile("" ::: "memory"); }
    }
};
struct EpiFp8 {
    static constexpr bool PERM = true, AFTER_DRAIN = false;
    unsigned char* O; int ldc; float scale;
    __device__ __forceinline__ void operator()(const f32x4 (&acc)[2][2][4][2], const Unit& u, int wr, int wc, int fr, int fq) const {
        const int row0 = u.pm * BM + wr * 64 + fr, col0 = u.pn * BM + wc * 32 + 8 * fq;
        typedef int i32x2 __attribute__((ext_vector_type(2)));
#pragma unroll
        for (int ai = 0; ai < 2; ++ai)
#pragma unroll
            for (int m = 0; m < 4; ++m)
#pragma unroll
                for (int bj = 0; bj < 2; ++bj) { const f32x4 v0 = acc[ai][bj][m][0] * scale, v1 = acc[ai][bj][m][1] * scale;
                    *(i32x2*)(O + (size_t)(row0 + ai * HALF + m * 16) * ldc + col0 + bj * HALF) = (i32x2){pk4_fp8(v0[0], v0[1], v0[2], v0[3]), pk4_fp8(v1[0], v1[1], v1[2], v1[3])}; asm volatile("" ::: "memory"); }
    }
};

template <class Epi, class Sched, bool ALIGN_EPI = false, bool SP2 = false, bool GATHER = false, int BAUX = 0, bool FP8 = false>
__device__ __forceinline__ void gemm_phase(PG8_LAS unsigned char* lds, const Gemm g, const Sched& S, const Epi& E, const int wv) {
    int tid = (wv << 6) | LANE_ID(); asm volatile("" : "+v"(tid));
    const int wid = __builtin_amdgcn_readfirstlane(tid >> 6), lane = tid & 63, wr = wid >> 2, wc = wid & 3, fr = lane & 15, fq = lane >> 4;
    static_assert(!GATHER || SP2, "gathered A rows: SP2 loop only");
    int kl_ = g.KL; asm volatile("" : "+s"(kl_));
    const int K = g.K, nt = kl_ / BK;
    unsigned voffA[2], voffB[2], gC2[2]; int gR[2];
#pragma unroll
    for (int i = 0; i < 2; ++i) { int R, C; stage_rc(tid * 16 + i * 8192, R, C); const int Rb = Epi::PERM ? ((R & ~31) + perm32(R & 31)) : R;
        voffA[i] = (unsigned)(R * K + C) * 2u; voffB[i] = (unsigned)(Rb * K + C) * 2u; gR[i] = R; gC2[i] = (unsigned)C * 2u; }
    unsigned vC[2][2], vN[2][2];
    const size_t kstep = (size_t)(BK * 2);
    const size_t hstep = (size_t)HALF * K * 2;
    const size_t tstep = 2 * hstep;
    const unsigned ldsw = (unsigned)wid * 1024u;
    const int aoff = lds_byte(wr * 64 + fr, fq * 8), boff = lds_byte(wc * 32 + fr, fq * 8);
#define PG8_SA(b, h) (((b) * 2 + (h)) * HTB)
#define PG8_SB(b, h) ((4 + (b) * 2 + (h)) * HTB)
#define PG8_STAGE(bufoff, gbase, voff) do { _Pragma("unroll") for (int _i = 0; _i < 2; ++_i) \
        __builtin_amdgcn_global_load_lds((const unsigned*)((const char*)(gbase) + (voff)[_i]), (PG8_LAS unsigned*)(lds + (bufoff) + ldsw + _i * 8192), 16, 0, 0); } while (0)
#define PG8_STAGE_A(bufoff, ptr, h, VS) do { if constexpr (GATHER) { PG8_STAGE(bufoff, ptr, VS[h]); } else { PG8_STAGE(bufoff, (ptr) + ((h) ? hstep : 0), voffA); } } while (0)
#define PG8_STAGE_B(bufoff, gbase, voff) do { _Pragma("unroll") for (int _i = 0; _i < 2; ++_i) \
        __builtin_amdgcn_global_load_lds((const unsigned*)((const char*)(gbase) + (voff)[_i]), (PG8_LAS unsigned*)(lds + (bufoff) + ldsw + _i * 8192), 16, 0, BAUX); } while (0)
#define PG8_LDA(dst, b, h) do { _Pragma("unroll") for (int m = 0; m < 4; ++m) _Pragma("unroll") for (int k = 0; k < 2; ++k) dst[m][k] = *(const PG8_LAS bf16x8*)(lds + PG8_SA(b, h) + aoff + m * 2048 + k * 1024); } while (0)
#define PG8_LDB(dst, b, h) do { _Pragma("unroll") for (int n = 0; n < 2; ++n) _Pragma("unroll") for (int k = 0; k < 2; ++k) dst[n][k] = *(const PG8_LAS bf16x8*)(lds + PG8_SB(b, h) + boff + n * 2048 + k * 1024); } while (0)
#define PG8_MMA(ai, bj, At, Bt) do { __builtin_amdgcn_s_setprio(1); _Pragma("unroll") for (int m = 0; m < 4; ++m) _Pragma("unroll") for (int n = 0; n < 2; ++n) { \
        if constexpr (FP8) { _Pragma("unroll") for (int k = 0; k < 2; ++k) { const l2_t a2 = __builtin_bit_cast(l2_t, At[m][k]), b2 = __builtin_bit_cast(l2_t, Bt[n][k]); \
                acc[ai][bj][m][n] = __builtin_amdgcn_mfma_f32_16x16x32_fp8_fp8(b2[0], a2[0], acc[ai][bj][m][n], 0, 0, 0); \
                acc[ai][bj][m][n] = __builtin_amdgcn_mfma_f32_16x16x32_fp8_fp8(b2[1], a2[1], acc[ai][bj][m][n], 0, 0, 0); } } \
        else { _Pragma("unroll") for (int k = 0; k < 2; ++k) acc[ai][bj][m][n] = __builtin_amdgcn_mfma_f32_16x16x32_bf16(Bt[n][k], At[m][k], acc[ai][bj][m][n], 0, 0, 0); } } \
        __builtin_amdgcn_s_setprio(0); } while (0)
#define PG8_WAIT_V(n) asm volatile("s_waitcnt vmcnt(" #n ")" ::: "memory")
#define PG8_WAIT_L(n) asm volatile("s_waitcnt lgkmcnt(" #n ")" ::: "memory")
#define PG8_BAR __builtin_amdgcn_s_barrier()
#define PG8_SCHED __builtin_amdgcn_sched_barrier(0)
    Unit cur, nxt; int ui = 0;
    if (!S.next(0, cur)) return;
    f32x4 acc[2][2][4][2];
#pragma unroll
    for (int a = 0; a < 2; ++a)
#pragma unroll
        for (int b = 0; b < 2; ++b)
#pragma unroll
            for (int m = 0; m < 4; ++m)
#pragma unroll
                for (int n = 0; n < 2; ++n) acc[a][b][m][n] = (f32x4){0.f, 0.f, 0.f, 0.f};
    bf16x8 At[4][2], B0[2][2], B1[2][2];
    const char* cA = (const char*)g.A + cur.ao; const char* cB = (const char*)g.Bt + cur.bo;
    if constexpr (GATHER) {
#pragma unroll
        for (int h = 0; h < 2; ++h)
#pragma unroll
            for (int i = 0; i < 2; ++i) { vC[h][i] = (unsigned)S.tok(0, gR[i] + HALF * h) * (unsigned)g.lda + gC2[i]; vN[h][i] = vC[h][i]; } }
    S.a_ready(cur);
    if constexpr (SP2) {
        PG8_STAGE_B(PG8_SB(0, 0), cB, voffB); PG8_STAGE_B(PG8_SB(0, 1), cB + hstep, voffB); PG8_STAGE_A(PG8_SA(0, 0), cA, 0, vC); PG8_STAGE_A(PG8_SA(0, 1), cA, 1, vC);
        if (wr == 1) PG8_BAR;
        PG8_WAIT_V(2); PG8_BAR;
        PG8_STAGE_B(PG8_SB(1, 0), cB + kstep, voffB); PG8_STAGE_A(PG8_SA(1, 0), cA + kstep, 0, vC); PG8_STAGE_B(PG8_SB(1, 1), cB + hstep + kstep, voffB);
        PG8_WAIT_V(6); PG8_BAR;
    } else {
        PG8_STAGE_B(PG8_SB(0, 0), cB, voffB); PG8_STAGE(PG8_SA(0, 0), cA, voffA); PG8_STAGE_B(PG8_SB(0, 1), cB + hstep, voffB); PG8_STAGE(PG8_SA(0, 1), cA + hstep, voffA);
        if (wr == 1) PG8_BAR;
        PG8_WAIT_V(4); PG8_BAR;
        PG8_STAGE_B(PG8_SB(1, 0), cB + kstep, voffB); PG8_STAGE(PG8_SA(1, 0), cA + kstep, voffA); PG8_STAGE_B(PG8_SB(1, 1), cB + hstep + kstep, voffB);
        PG8_WAIT_V(6); PG8_BAR;
    }
    for (;;) {
        const bool has_next = S.next(ui + 1, nxt);
        const char* nA = has_next ? (const char*)g.A + nxt.ao : cA; const char* nB = has_next ? (const char*)g.Bt + nxt.bo : cB;
        if constexpr (GATHER) { if (has_next) {
#pragma unroll
            for (int h = 0; h < 2; ++h)
#pragma unroll
                for (int i = 0; i < 2; ++i) vN[h][i] = (unsigned)S.tok(ui + 1, gR[i] + HALF * h) * (unsigned)g.lda + gC2[i]; } }
        for (int t = 0; t < nt; t += 2) {
            const bool last = (t == nt - 2);
            const char* a1 = cA + (size_t)(t + 1) * kstep;
            const char* a2 = last ? nA : cA + (size_t)(t + 2) * kstep; const char* b2 = last ? nB : cB + (size_t)(t + 2) * kstep;
            const char* a3 = a2 + kstep; const char* b3 = b2 + kstep;
            if (last && has_next) S.a_ready(nxt);
            unsigned v2[2][2];
            if constexpr (GATHER) { const bool un = last && has_next;
#pragma unroll
                for (int h = 0; h < 2; ++h)
#pragma unroll
                    for (int i = 0; i < 2; ++i) v2[h][i] = un ? vN[h][i] : vC[h][i]; }
            if constexpr (SP2) {
            PG8_LDB(B0, 0, 0); PG8_LDB(B1, 0, 1); PG8_SCHED; PG8_LDA(At, 0, 0); PG8_STAGE_A(PG8_SA(1, 1), a1, 1, vC);
            PG8_WAIT_V(8); PG8_WAIT_L(0); PG8_BAR; PG8_MMA(0, 0, At, B0); PG8_MMA(0, 1, At, B1); PG8_BAR; PG8_SCHED;
            PG8_LDA(At, 0, 1); PG8_STAGE_B(PG8_SB(0, 0), b2, voffB); PG8_STAGE_B(PG8_SB(0, 1), b2 + hstep, voffB); PG8_STAGE_A(PG8_SA(0, 0), a2, 0, v2);
            PG8_WAIT_V(8); PG8_WAIT_L(0); PG8_BAR; PG8_MMA(1, 0, At, B0); PG8_MMA(1, 1, At, B1); PG8_BAR; PG8_SCHED;
            PG8_LDB(B0, 1, 0); PG8_LDB(B1, 1, 1); PG8_SCHED; PG8_LDA(At, 1, 0); PG8_STAGE_A(PG8_SA(0, 1), a2, 1, v2);
            PG8_WAIT_V(8); PG8_WAIT_L(0); PG8_BAR; PG8_MMA(0, 0, At, B0); PG8_MMA(0, 1, At, B1); PG8_BAR; PG8_SCHED;
            PG8_LDA(At, 1, 1); PG8_STAGE_B(PG8_SB(1, 0), b3, voffB); PG8_STAGE_B(PG8_SB(1, 1), b3 + hstep, voffB); PG8_STAGE_A(PG8_SA(1, 0), a3, 0, v2);
            PG8_WAIT_V(8); PG8_WAIT_L(0); PG8_BAR; PG8_MMA(1, 0, At, B0); PG8_MMA(1, 1, At, B1); PG8_BAR; PG8_SCHED;
            } else {
            PG8_LDB(B0, 0, 0); PG8_SCHED; PG8_LDA(At, 0, 0); PG8_STAGE(PG8_SA(1, 1), a1 + hstep, voffA);
            PG8_WAIT_L(8); PG8_BAR; PG8_WAIT_L(0); PG8_MMA(0, 0, At, B0); PG8_BAR; PG8_SCHED;
            PG8_LDB(B1, 0, 1); PG8_STAGE_B(PG8_SB(0, 0), b2, voffB);
            PG8_BAR; PG8_WAIT_L(0); PG8_MMA(0, 1, At, B1); PG8_BAR;
            PG8_LDA(At, 0, 1); PG8_STAGE(PG8_SA(0, 0), a2, voffA);
            PG8_BAR; PG8_WAIT_L(0); PG8_MMA(1, 0, At, B0); PG8_BAR; PG8_SCHED;
            PG8_STAGE_B(PG8_SB(0, 1), b2 + hstep, voffB);
            PG8_WAIT_V(6); PG8_BAR; PG8_MMA(1, 1, At, B1); PG8_BAR;
            PG8_LDB(B0, 1, 0); PG8_SCHED; PG8_LDA(At, 1, 0); PG8_STAGE(PG8_SA(0, 1), a2 + hstep, voffA);
            PG8_WAIT_L(8); PG8_BAR; PG8_WAIT_L(0); PG8_MMA(0, 0, At, B0); PG8_BAR; PG8_SCHED;
            PG8_LDB(B1, 1, 1); PG8_STAGE_B(PG8_SB(1, 0), b3, voffB);
            PG8_BAR; PG8_WAIT_L(0); PG8_MMA(0, 1, At, B1); PG8_BAR;
            PG8_LDA(At, 1, 1); PG8_STAGE(PG8_SA(1, 0), a3, voffA);
            PG8_BAR; PG8_WAIT_L(0); PG8_MMA(1, 0, At, B0); PG8_BAR; PG8_SCHED;
            PG8_STAGE_B(PG8_SB(1, 1), b3 + hstep, voffB);
            PG8_WAIT_V(6); PG8_BAR; PG8_MMA(1, 1, At, B1); PG8_BAR;
            }
        }
        if constexpr (ALIGN_EPI) { if (wr == 0) PG8_BAR; }
        if constexpr (!Epi::AFTER_DRAIN) { E(acc, cur, wr, wc, fr, fq); S.done(cur); }
        if (!has_next) break;
#pragma unroll
        for (int a = 0; a < 2; ++a)
#pragma unroll
            for (int b = 0; b < 2; ++b)
#pragma unroll
                for (int m = 0; m < 4; ++m)
#pragma unroll
                    for (int n = 0; n < 2; ++n) acc[a][b][m][n] = (f32x4){0.f, 0.f, 0.f, 0.f};
        cur = nxt; cA = nA; cB = nB; ++ui;
        if constexpr (GATHER) {
#pragma unroll
            for (int h = 0; h < 2; ++h)
#pragma unroll
                for (int i = 0; i < 2; ++i) vC[h][i] = vN[h][i]; }
        if constexpr (ALIGN_EPI) { if (wr == 1) PG8_BAR; }
    }
    PG8_WAIT_V(0);
    if constexpr (!ALIGN_EPI) { if (wr == 0) PG8_BAR; }
    PG8_BAR;
    if constexpr (Epi::AFTER_DRAIN) { E.fused(acc, cur, wr, wc, fr, fq, lds, wid, lane); S.done(cur); }
#undef PG8_SA
#undef PG8_SB
#undef PG8_STAGE
#undef PG8_STAGE_B
#undef PG8_STAGE_A
#undef PG8_LDA
#undef PG8_LDB
#undef PG8_MMA
#undef PG8_WAIT_V
#undef PG8_WAIT_L
#undef PG8_BAR
#undef PG8_SCHED
}
}

namespace fa {
constexpr int D = 128, QBLK = 32, KVBLK = 64, QB = 256;
constexpr float SCALE = 0.08838834764831845f;
constexpr float THR = 8.f;
constexpr int SHM_K = KVBLK * D * 2, SHM_V = KVBLK * D * 2;
constexpr int OFF_V = 0, OFF_K = SHM_V, OFF_B = SHM_V + SHM_K, ATT_BUF = OFF_B + 256  , OFF_W = 2 * ATT_BUF, ATT_LDS = OFF_W + 8 * 64 * 4;
#define KSWZ(row, colB) ((row) * 256 + ((colB) ^ (((row) & 7) << 4)))
#define SBAR() __builtin_amdgcn_sched_barrier(0)
__device__ __forceinline__ int v_st(int k, int c) { const int kk = (k & ~0xC) | ((k & 4) << 1) | ((k & 8) >> 1); return ((kk >> 3) * 4 + (c >> 5)) * 512 + ((kk & 7) * 32 + (c & 31)) * 2; }
__device__ __forceinline__ int v_rd_base(int lane) { return ((lane & 3) << 3) | (((lane >> 2) & 3) << 6) | (((lane >> 4) & 1) << 5) | (((lane >> 5) & 1) << 8); }
constexpr int v_rd_off(int d0, int ks, int half) { return d0 * 512 + ks * 4096 + half * 2048; }
__device__ __forceinline__ int crow(int r, int hi) { return (r & 3) + 8 * (r >> 2) + 4 * hi; }
__device__ __forceinline__ unsigned cvtpk(float lo, float hi) { unsigned r; asm volatile("v_cvt_pk_bf16_f32 %0, %1, %2" : "=v"(r) : "v"(lo), "v"(hi)); return r; }
__device__ __forceinline__ void mask_tile(f32x16& p0, f32x16& p1, int dq) {
    const float NEG = -__builtin_inff();
#pragma unroll
    for (int r = 0; r < 16; ++r) {
        const int c = (r & 3) + 8 * (r >> 2);
        if (dq - c < 0) p0[r] = NEG;
        if (dq - c - 32 < 0) p1[r] = NEG;
    }
}
__device__ __forceinline__ void partialSM(f32x16& p0, f32x16& p1, float& m_reg, float& mn, float& alpha) {
    float pmax = p0[0];
#pragma unroll
    for (int r = 1; r < 16; ++r) pmax = fmaxf(pmax, p0[r]);
#pragma unroll
    for (int r = 0; r < 16; ++r) pmax = fmaxf(pmax, p1[r]);
    { auto rr = __builtin_amdgcn_permlane32_swap(__float_as_uint(pmax), __float_as_uint(pmax), false, false);
      pmax = fmaxf(__uint_as_float(rr[0]), __uint_as_float(rr[1])); }
    constexpr float C2 = 1.4426950408889634f * SCALE;
    if (__builtin_expect(__all((pmax - m_reg) * SCALE <= THR), 1)) { mn = m_reg; alpha = 1.f; }
    else { mn = fmaxf(m_reg, pmax); alpha = __builtin_amdgcn_exp2f((m_reg - mn) * C2); m_reg = mn; }
    const float mnL = -mn * C2;
#pragma unroll
    for (int r = 0; r < 16; ++r) p0[r] = fmaf(p0[r], C2, mnL);
#pragma unroll
    for (int r = 0; r < 16; ++r) p1[r] = fmaf(p1[r], C2, mnL);
#pragma unroll
    for (int r = 0; r < 16; ++r) p0[r] = __builtin_amdgcn_exp2f(p0[r]);
}
__device__ __forceinline__ void finishSM(f32x16& p0, f32x16& p1, float alpha, float& l_reg, bf16x8& pa0, bf16x8& pa1, bf16x8& pa2, bf16x8& pa3) {
#pragma unroll
    for (int r = 0; r < 16; ++r) p1[r] = __builtin_amdgcn_exp2f(p1[r]);
    float ps = 0;
#pragma unroll
    for (int r = 0; r < 16; ++r) ps += p0[r];
#pragma unroll
    for (int r = 0; r < 16; ++r) ps += p1[r];
    { auto rr = __builtin_amdgcn_permlane32_swap(__float_as_uint(ps), __float_as_uint(ps), false, false);
      ps = __uint_as_float(rr[0]) + __uint_as_float(rr[1]); }
    l_reg = l_reg * alpha + ps;
#define PK4(P, B_, OUT) do { unsigned a0 = cvtpk(P[B_+0], P[B_+1]), a1 = cvtpk(P[B_+2], P[B_+3]);                          \
        unsigned b0 = cvtpk(P[B_+4], P[B_+5]), b1 = cvtpk(P[B_+6], P[B_+7]);                                             \
        auto r0 = __builtin_amdgcn_permlane32_swap(a0, b0, false, false); auto r1 = __builtin_amdgcn_permlane32_swap(a1, b1, false, false); \
        v4u w = {r0[0], r1[0], r0[1], r1[1]}; OUT = *reinterpret_cast<bf16x8*>(&w); } while (0)
    PK4(p0, 0, pa0); PK4(p0, 8, pa1); PK4(p1, 0, pa2); PK4(p1, 8, pa3);
#undef PK4
}
__device__ __forceinline__ void qkt(f32x16& p0, f32x16& p1, const char* K_lds, const float* b_lds, int r32, int hi, const bf16x8* qr) {
#pragma unroll
    for (int g = 0; g < 4; ++g) { const f32x4 a = *(const f32x4*)(b_lds + 8 * g + 4 * hi), b = *(const f32x4*)(b_lds + 32 + 8 * g + 4 * hi);
#pragma unroll
        for (int i = 0; i < 4; ++i) { p0[4 * g + i] = a[i]; p1[4 * g + i] = b[i]; } }
    const char* kb[4];
#pragma unroll
    for (int dd = 0; dd < 4; ++dd) kb[dd] = K_lds + KSWZ(r32, (dd * 16 + hi * 8) * 2);
#pragma unroll
    for (int d0 = 0; d0 < 8; ++d0) { const char* a = kb[d0 & 3] + (d0 >> 2) * 128;
        bf16x8 b0 = *reinterpret_cast<const bf16x8*>(a);
        bf16x8 b1 = *reinterpret_cast<const bf16x8*>(a + 32 * 256);
        p0 = __builtin_amdgcn_mfma_f32_32x32x16_bf16(b0, qr[d0], p0, 0, 0, 0);
        p1 = __builtin_amdgcn_mfma_f32_32x32x16_bf16(b1, qr[d0], p1, 0, 0, 0); }
}
__device__ __forceinline__ void pv_tile(f32x16* o, int vb0, bf16x8 pa0, bf16x8 pa1, bf16x8 pa2, bf16x8 pa3) {
#define TRRD(dst, off) asm volatile("ds_read_b64_tr_b16 %0, %1 offset:%2" : "=&v"(dst) : "v"(vb0), "i"(off) : "memory")
#define PV_D0(d0) do { s16x4 l0, l1, l2, l3, h0, h1, h2, h3; constexpr int b_ = v_rd_off(d0, 0, 0);   \
        TRRD(l0, b_); TRRD(h0, b_ + 2048); TRRD(l1, b_ + 4096); TRRD(h1, b_ + 6144); TRRD(l2, b_ + 8192); TRRD(h2, b_ + 10240); TRRD(l3, b_ + 12288); TRRD(h3, b_ + 14336); \
        asm volatile("s_waitcnt lgkmcnt(0)" ::: "memory"); SBAR();                                                       \
        o[d0] = __builtin_amdgcn_mfma_f32_32x32x16_bf16(pa0, (bf16x8){l0[0], l0[1], l0[2], l0[3], h0[0], h0[1], h0[2], h0[3]}, o[d0], 0, 0, 0);   \
        o[d0] = __builtin_amdgcn_mfma_f32_32x32x16_bf16(pa1, (bf16x8){l1[0], l1[1], l1[2], l1[3], h1[0], h1[1], h1[2], h1[3]}, o[d0], 0, 0, 0);   \
        o[d0] = __builtin_amdgcn_mfma_f32_32x32x16_bf16(pa2, (bf16x8){l2[0], l2[1], l2[2], l2[3], h2[0], h2[1], h2[2], h2[3]}, o[d0], 0, 0, 0);   \
        o[d0] = __builtin_amdgcn_mfma_f32_32x32x16_bf16(pa3, (bf16x8){l3[0], l3[1], l3[2], l3[3], h3[0], h3[1], h3[2], h3[3]}, o[d0], 0, 0, 0); } while (0)
    PV_D0(0); PV_D0(1); PV_D0(2); PV_D0(3);
#undef PV_D0
#undef TRRD
}
}

namespace fa2 {
using namespace fa;
constexpr int PIN = 128, POUT = 2048, NW = 8;
constexpr int O2_V = 0, O2_K = 2 * SHM_V, O2_W = 2 * SHM_V + 2 * SHM_K, O2_B = O2_W + NW * 64 * 4, O2_Q = O2_B + 2 * 64 * 4, ATT2_LDS = O2_Q + NW * 8192;
__device__ __forceinline__ void mask_causal(f32x16& p0, f32x16& p1, int dq) {
    const float NEG = -__builtin_inff();
#pragma unroll
    for (int r = 0; r < 16; ++r) { const int c = (r & 3) + 8 * (r >> 2); if (dq - c < 0) p0[r] = NEG; if (dq - c - 32 < 0) p1[r] = NEG; }
}
template <int KB>
__device__ __forceinline__ void qkt(f32x16& p0, f32x16& p1, const char* K_lds, const float* b_lds, int r32, int hi, const char* qf) {
    { const float* bb = b_lds + KB * 64;
#pragma unroll
      for (int g = 0; g < 4; ++g) { const f32x4 a = *(const f32x4*)(bb + 8 * g + 4 * hi), b = *(const f32x4*)(bb + 32 + 8 * g + 4 * hi);
#pragma unroll
          for (int i = 0; i < 4; ++i) { p0[4 * g + i] = a[i]; p1[4 * g + i] = b[i]; } } }
    const char* kb[4];
#pragma unroll
    for (int dd = 0; dd < 4; ++dd) kb[dd] = K_lds + KB * SHM_K + KSWZ(r32, (dd * 16 + hi * 8) * 2);
#pragma unroll
    for (int d0 = 0; d0 < 8; ++d0) { const char* a = kb[d0 & 3] + (d0 >> 2) * 128;
        bf16x8 b0 = *reinterpret_cast<const bf16x8*>(a);
        bf16x8 b1 = *reinterpret_cast<const bf16x8*>(a + 32 * 256);
        const bf16x8 q = *reinterpret_cast<const bf16x8*>(qf + d0 * 1024);
        p0 = __builtin_amdgcn_mfma_f32_32x32x16_bf16(b0, q, p0, 0, 0, 0);
        p1 = __builtin_amdgcn_mfma_f32_32x32x16_bf16(b1, q, p1, 0, 0, 0); }
}
template <int VB>
__device__ __forceinline__ void pv_tile(f32x16* o, int vb0, bf16x8 pa0, bf16x8 pa1, bf16x8 pa2, bf16x8 pa3) {
#define TRRD(dst, off) asm volatile("ds_read_b64_tr_b16 %0, %1 offset:%2" : "=&v"(dst) : "v"(vb0), "i"(off) : "memory")
#define PV_D0(d0) do { s16x4 l0, l1, l2, l3, h0, h1, h2, h3; constexpr int b_ = VB * SHM_V + v_rd_off(d0, 0, 0);   \
        TRRD(l0, b_); TRRD(h0, b_ + 2048); TRRD(l1, b_ + 4096); TRRD(h1, b_ + 6144); TRRD(l2, b_ + 8192); TRRD(h2, b_ + 10240); TRRD(l3, b_ + 12288); TRRD(h3, b_ + 14336); \
        asm volatile("s_waitcnt lgkmcnt(0)" ::: "memory"); SBAR();                                                       \
        o[d0] = __builtin_amdgcn_mfma_f32_32x32x16_bf16(pa0, (bf16x8){l0[0], l0[1], l0[2], l0[3], h0[0], h0[1], h0[2], h0[3]}, o[d0], 0, 0, 0);   \
        o[d0] = __builtin_amdgcn_mfma_f32_32x32x16_bf16(pa1, (bf16x8){l1[0], l1[1], l1[2], l1[3], h1[0], h1[1], h1[2], h1[3]}, o[d0], 0, 0, 0);   \
        o[d0] = __builtin_amdgcn_mfma_f32_32x32x16_bf16(pa2, (bf16x8){l2[0], l2[1], l2[2], l2[3], h2[0], h2[1], h2[2], h2[3]}, o[d0], 0, 0, 0);   \
        o[d0] = __builtin_amdgcn_mfma_f32_32x32x16_bf16(pa3, (bf16x8){l3[0], l3[1], l3[2], l3[3], h3[0], h3[1], h3[2], h3[3]}, o[d0], 0, 0, 0); } while (0)
    PV_D0(0); PV_D0(1); PV_D0(2); PV_D0(3);
#undef PV_D0
#undef TRRD
}
struct BlockRef { const bf16* Q; const bf16* K; const bf16* V; bf16* O; const float* C; int P0, jlo; float cf; };
struct Seam { bf16x8 st_v0, st_v1, st_k0, st_k1; float st_b; };
#define A2_LD(p, k0, off32) (*(const bf16x8*)((const char*)(p) + (size_t)(k0) * (PIN * 2) + (off32)))
#define A2_VMW() asm volatile("s_waitcnt vmcnt(0)" ::: "memory")
#define A2_VMWN(n) asm volatile("s_waitcnt vmcnt(%0)" :: "i"(n) : "memory")
#define A2_SLOAD(R_, k0) do { S.st_v0 = A2_LD((R_).V, k0, go0); S.st_v1 = A2_LD((R_).V, k0, go1);              \
                              S.st_k0 = A2_LD((R_).K, k0, go0); S.st_k1 = A2_LD((R_).K, k0, go1); \
                              if (tid < 64) S.st_b = ((R_).cf - (R_).C[(k0) + tid]) * (1.0f / SCALE); } while (0)
#define A2_SWRITE_K(bf) do { *(bf16x8*)(K_lds + (bf) * SHM_K + kws) = S.st_k0; *(bf16x8*)(K_lds + (bf) * SHM_K + kws + 32 * 256) = S.st_k1; if (tid < 64) b_lds[(bf) * 64 + tid] = S.st_b; } while (0)
#define A2_SWRITE_V(bf) do { *(bf16x8*)(V_lds + (bf) * SHM_V + vst0) = S.st_v0; *(bf16x8*)(V_lds + (bf) * SHM_V + vst1) = S.st_v1; } while (0)
#define A2_SWRITE(bf) do { A2_SWRITE_V(bf); A2_SWRITE_K(bf); } while (0)
__device__ __forceinline__ void prime(const BlockRef& cur, char* lds, Seam& S, int tid) {
    const int wid = __builtin_amdgcn_readfirstlane(tid >> 6), lane = tid & 63, r32 = lane & 31, hi = lane >> 5;
    const int sr = tid >> 4, sc = (tid & 15) * 8, kws = KSWZ(sr, sc * 2); char* K_lds = lds + O2_K; float* b_lds = (float*)(lds + O2_B);
    const unsigned go0 = (unsigned)(sr * PIN + sc) * 2u, go1 = go0 + 32u * PIN * 2u, qo = (unsigned)(r32 * PIN + hi * 8) * 2u;
    const int kb0 = cur.jlo * KVBLK;
    { bf16x8 qr[8]; char* qf = lds + O2_Q + wid * 8192 + lane * 16;
#pragma unroll
      for (int d0 = 0; d0 < 8; ++d0) qr[d0] = *(const bf16x8*)((const char*)cur.Q + (size_t)(wid * QBLK) * (PIN * 2) + qo + d0 * 32);
      A2_SLOAD(cur, kb0); A2_VMW(); A2_SWRITE_K(0);
#pragma unroll
      for (int d0 = 0; d0 < 8; ++d0) *(bf16x8*)(qf + d0 * 1024) = qr[d0]; }
    __syncthreads();
}
__device__ __forceinline__ void block(const BlockRef& cur, char* lds, Seam& S, int tid) {
    const int wid = __builtin_amdgcn_readfirstlane(tid >> 6), lane = tid & 63, r32 = lane & 31, hi = lane >> 5;
    const int j_lo = cur.jlo, j_hi = (cur.P0 + QB - 1) / KVBLK + 1;
    const int NT = j_hi - j_lo;
    const int qlo = cur.P0 + wid * QBLK, qm = qlo + r32 - 4 * hi;
    char* V_lds = lds + O2_V; char* K_lds = lds + O2_K; float* b_lds = (float*)(lds + O2_B);
    float* ws = (float*)(lds + O2_W) + wid * 64; float* li_l = ws, * al_l = ws + 32;
    float m_reg = -1e30f, l_reg = 0; f32x16 o[4] = {};
    const int sr = tid >> 4, sc = (tid & 15) * 8, vst0 = v_st(sr, sc), vst1 = v_st(32 + sr, sc), kws = KSWZ(sr, sc * 2);
    const int vb0 = (int)(uintptr_t)V_lds + v_rd_base(lane);
    const unsigned go0 = (unsigned)(sr * PIN + sc) * 2u, go1 = go0 + 32u * PIN * 2u;
    const char* qf = lds + O2_Q + wid * 8192 + lane * 16;
#define RESC(a) do { if (__any((a) < 1.f)) { if (hi == 0) al_l[r32] = (a); asm volatile("s_waitcnt lgkmcnt(0)" ::: "memory");              \
                     for (int d_ = 0; d_ < 4; ++d_) for (int r = 0; r < 16; ++r) o[d_][r] *= al_l[crow(r, hi)]; } } while (0)
#define KBASE(t) ((j_lo + (t)) * KVBLK)
#define MASKT(P0_, P1_, t) do { const int kb_ = KBASE(t); if (kb_ + KVBLK - 1 > qlo) mask_causal(P0_, P1_, qm - kb_); } while (0)
    f32x16 pA0, pA1, pB0, pB1; float mnA, mnB, alA, alB; bf16x8 pa0, pa1, pa2, pa3;
    A2_SWRITE_V(0); SBAR();
    if (NT > 1) A2_SLOAD(cur, KBASE(1));
    SBAR(); qkt<0>(pA0, pA1, K_lds, b_lds, r32, hi, qf);
    MASKT(pA0, pA1, 0); partialSM(pA0, pA1, m_reg, mnA, alA);
    if (NT > 1) { A2_VMW(); A2_SWRITE(1); }
    __syncthreads();
#define HALF_STEP(PX0, PX1, mnX, alX, PY0, PY1, alY, t, KB, VB, SB) do {                                                      \
        SBAR(); qkt<KB>(PX0, PX1, K_lds, b_lds, r32, hi, qf);                                                               \
        finishSM(PY0, PY1, alY, l_reg, pa0, pa1, pa2, pa3); SBAR();                                                           \
        if ((t) + 1 < NT) { A2_SLOAD(cur, KBASE((t) + 1)); SBAR(); }                                                          \
        pv_tile<VB>(o, vb0, pa0, pa1, pa2, pa3); MASKT(PX0, PX1, (t)); partialSM(PX0, PX1, m_reg, mnX, alX);                  \
        __syncthreads();                                                                                                      \
        if ((t) + 1 < NT) { A2_VMW(); A2_SWRITE(SB); }                                                                        \
        RESC(alX); __syncthreads(); } while (0)
    for (int t = 1; t + 1 < NT; t += 2) {
        HALF_STEP(pB0, pB1, mnB, alB, pA0, pA1, alA, t, 1, 0, 0);
        HALF_STEP(pA0, pA1, mnA, alA, pB0, pB1, alB, t + 1, 0, 1, 1);
    }
    const bool even = (NT & 1) == 0;
    if (even) { SBAR(); qkt<1>(pB0, pB1, K_lds, b_lds, r32, hi, qf); SBAR(); }
    finishSM(pA0, pA1, alA, l_reg, pa0, pa1, pa2, pa3); SBAR();
    pv_tile<0>(o, vb0, pa0, pa1, pa2, pa3);
    if (even) { MASKT(pB0, pB1, NT - 1); partialSM(pB0, pB1, m_reg, mnB, alB); __syncthreads(); RESC(alB);
        finishSM(pB0, pB1, alB, l_reg, pa0, pa1, pa2, pa3); SBAR(); pv_tile<1>(o, vb0, pa0, pa1, pa2, pa3); }
    if (hi == 0) li_l[r32] = l_reg; asm volatile("s_waitcnt lgkmcnt(0)" ::: "memory");
    char* Ob = (char*)(cur.O + (size_t)(wid * QBLK) * POUT); const unsigned oo = (unsigned)(4 * hi * POUT + r32) * 2u;
#pragma unroll
    for (int r = 0; r < 16; ++r) { const float rl = __builtin_amdgcn_rcpf(li_l[crow(r, hi)]);
#pragma unroll
        for (int d0 = 0; d0 < 4; ++d0) { const float v = o[d0][r] * rl; const float vn = __shfl_xor(v, 1);
            if ((r32 & 1) == 0) *(unsigned*)(Ob + (size_t)(((r & 3) + 8 * (r >> 2)) * POUT * 2 + d0 * 64) + oo) = cvtpk(v, vn); } }
    __syncthreads();
#undef RESC
#undef KBASE
#undef MASKT
#undef HALF_STEP
}
#undef A2_LD
#undef A2_VMW
#undef A2_VMWN
#undef A2_SLOAD
#undef A2_SWRITE_K
#undef A2_SWRITE_V
#undef A2_SWRITE
}

constexpr size_t MiB = 1u << 20;
constexpr size_t WS_CTL = 0, CTL_ZERO_BYTES = 1 * MiB;
constexpr size_t WS_MODP = 1 * MiB;
constexpr size_t WS_MODF = 2 * MiB;
constexpr size_t WS_LS = 3 * MiB;
constexpr size_t WS_CUM = 4 * MiB;
constexpr size_t WS_MAXQK = 5 * MiB;
constexpr size_t WS_ROUTE = 6 * MiB;
constexpr size_t WS_LOGIT = 1298 * MiB;
constexpr size_t WS_TOKTAB = 1330 * MiB;
constexpr size_t WS_ROT = 1932 * MiB;
constexpr size_t WS_WOUT = 18 * MiB;
constexpr size_t WS_WIN = 34 * MiB;
constexpr size_t WS_WGU = 82 * MiB;
constexpr size_t WS_WD = 594 * MiB;
constexpr size_t WS_H = 850 * MiB;
constexpr size_t WS_PROJ = 914 * MiB;
constexpr size_t WS_MIXED = 1106 * MiB;
constexpr size_t WS_X1 = 1170 * MiB;
constexpr size_t WS_ACT = 1490 * MiB;
constexpr size_t WS_YS = 1538 * MiB;
constexpr size_t WS_KVT = 1730 * MiB;
constexpr size_t WS_PREVT = 1778 * MiB;
constexpr size_t WS_H2X = 1802 * MiB;
constexpr size_t WS_RWT2 = 1930 * MiB;
constexpr size_t WS_QKVH = 962 * MiB;
constexpr size_t WS_END = 1936 * MiB;
constexpr int CW_TMO = 0, CW_CODE = 1;
constexpr int CW_BAR = 4096;
constexpr int CW_CNT = 8192;
constexpr int CW_Q = 8448;
constexpr int CW_QX = 16384 + 1024;
constexpr int RING_OFF = 0, RING_BYTES = 131072;
constexpr int SCR_WAVE = 16640;
constexpr int LDSCTL_OFF = 135168;
constexpr int LDS_TE = LDSCTL_OFF + 256;
constexpr int LDS_OFFS = LDS_TE + 1024;
constexpr int LDS_XT = LDSCTL_OFF + 2048;
constexpr int LDS_TOK = LDSCTL_OFF + 3072;
constexpr int LDS_BYTES = 147456;
constexpr int NWAVES = 8;
#ifndef MOE_FP8
#define MOE_FP8 1
#endif

#define RLX_AGENT __ATOMIC_RELAXED, __HIP_MEMORY_SCOPE_AGENT
#define LDS_WAIT() asm volatile("s_waitcnt lgkmcnt(0)" ::: "memory")
#define VM_WAIT() asm volatile("s_waitcnt vmcnt(0)" ::: "memory")
__device__ __forceinline__ unsigned pk2(float lo, float hi) { unsigned r; asm volatile("v_cvt_pk_bf16_f32 %0, %1, %2" : "=v"(r) : "v"(lo), "v"(hi)); return r; }
__device__ __forceinline__ float bflo(unsigned w) { return __uint_as_float(w << 16); }
__device__ __forceinline__ float bfhi(unsigned w) { return __uint_as_float(w & 0xffff0000u); }
__device__ __forceinline__ float bf1(bf16 h) { return __uint_as_float((unsigned)h << 16); }
__device__ __forceinline__ bf16 f2bf(float f) { return (bf16)(pk2(f, 0.f) & 0xffffu); }
#define DPP_F(v, ctrl) __builtin_bit_cast(float, __builtin_amdgcn_update_dpp(0, __builtin_bit_cast(int, (v)), (ctrl), 0xF, 0xF, true))
#define DPP_I(v, ctrl) __builtin_amdgcn_update_dpp(0, (v), (ctrl), 0xF, 0xF, true)
#define RDL_F(v, l) __builtin_bit_cast(float, __builtin_amdgcn_readlane(__builtin_bit_cast(int, (v)), (l)))
#ifndef DPP_RED
#define DPP_RED 0
#endif
#if !DPP_RED
__device__ __forceinline__ float wave_sum(float v) {
#pragma unroll
    for (int o = 1; o < 64; o <<= 1) v += __shfl_xor(v, o);
    return v;
}
__device__ __forceinline__ float wave_max(float v) {
#pragma unroll
    for (int o = 1; o < 64; o <<= 1) v = fmaxf(v, __shfl_xor(v, o));
    return v;
}
__device__ __forceinline__ int wave_min_i(int v) {
#pragma unroll
    for (int o = 1; o < 64; o <<= 1) { const int w = __shfl_xor(v, o); v = w < v ? w : v; }
    return v;
}
#else
__device__ __forceinline__ float wave_sum(float v) {
    v += DPP_F(v, 0xB1); v += DPP_F(v, 0x4E); v += DPP_F(v, 0x141); v += DPP_F(v, 0x140);
    return (RDL_F(v, 0) + RDL_F(v, 16)) + (RDL_F(v, 32) + RDL_F(v, 48));
}
__device__ __forceinline__ float wave_max(float v) {
    v = fmaxf(v, DPP_F(v, 0xB1)); v = fmaxf(v, DPP_F(v, 0x4E)); v = fmaxf(v, DPP_F(v, 0x141)); v = fmaxf(v, DPP_F(v, 0x140));
    return fmaxf(fmaxf(RDL_F(v, 0), RDL_F(v, 16)), fmaxf(RDL_F(v, 32), RDL_F(v, 48)));
}
__device__ __forceinline__ int wave_min_i(int v) {
    v = min(v, DPP_I(v, 0xB1)); v = min(v, DPP_I(v, 0x4E)); v = min(v, DPP_I(v, 0x141)); v = min(v, DPP_I(v, 0x140));
    return min(min(__builtin_amdgcn_readlane(v, 0), __builtin_amdgcn_readlane(v, 16)), min(__builtin_amdgcn_readlane(v, 32), __builtin_amdgcn_readlane(v, 48)));
}
#endif

#define XB_TMO      128
#define XB_XCNT(j)  (256  + 64 * (j))
#define XB_XSUB(j)  (1280 + 64 * (j))
#define XB_XGEN(j)  (2304 + 64 * (j))
#define XB_TOP      3328
#define XB_TOPGEN   3392
#define XCD_BAR_WORDS 3456
#define XB_SPIN_CAP (1u << 18)

__device__ __forceinline__ unsigned xb_ld(unsigned* p)              { return __hip_atomic_load(p, __ATOMIC_RELAXED, __HIP_MEMORY_SCOPE_AGENT); }
__device__ __forceinline__ unsigned xb_add(unsigned* p, unsigned v) { return __hip_atomic_fetch_add(p, v, __ATOMIC_RELAXED, __HIP_MEMORY_SCOPE_AGENT); }
__device__ __forceinline__ unsigned xb_xcc_id() { return (unsigned)__builtin_amdgcn_s_getreg((3 << 11) | 20) & 0xFu; }
#define XB_SPIN(cond, bar) do { unsigned _sp = 0; while (cond) { __builtin_amdgcn_s_sleep(1); \
    if ((++_sp & 255u) == 0u) { if (xb_ld(&(bar)[XB_TMO])) break; if (_sp > XB_SPIN_CAP) { atomicAdd(&(bar)[XB_TMO], 1u); break; } } } } while (0)

struct XcdBarrier {
    unsigned* bar; unsigned x; unsigned wv;
    volatile LAS unsigned* st;
};

__device__ __forceinline__ XcdBarrier xcd_barrier_post(unsigned* bar, volatile LAS unsigned* st) {
    XcdBarrier b; b.bar = bar; b.x = xb_xcc_id(); b.st = st; b.wv = (unsigned)__builtin_amdgcn_readfirstlane((int)(threadIdx.x >> 6));
    if (threadIdx.x == 0) (void)xb_add(&bar[XB_XCNT(b.x)], 1u);
    return b;
}
__device__ __forceinline__ void xcd_barrier_complete(unsigned* bar, unsigned x, unsigned& nloc, unsigned& nx) {
    const unsigned G = gridDim.x * gridDim.y * gridDim.z;
    unsigned sum, cnt, mine, sp = 0u;
    for (;;) {
        sum = 0u; cnt = 0u; mine = 0u;
#pragma unroll
        for (unsigned j = 0; j < 16; ++j) { const unsigned c = xb_ld(&bar[XB_XCNT(j)]); sum += c; cnt += (c > 0u) ? 1u : 0u; mine = (j == x) ? c : mine; }
        if (sum == G) break;
        __builtin_amdgcn_s_sleep(1);
        if ((++sp & 255u) == 0u) { if (xb_ld(&bar[XB_TMO])) break; if (sp > XB_SPIN_CAP) { atomicAdd(&bar[XB_TMO], 1u); break; } }
    }
    nloc = mine > 0u ? mine : 1u; nx = cnt > 0u ? cnt : 1u;
}

__device__ __forceinline__ void xcd_barrier(const XcdBarrier& b) {
    asm volatile("s_waitcnt vmcnt(0)" ::: "memory");
    __syncthreads();
    if (b.wv == 0u && LANE_ID() == 0) {
        unsigned* bar = b.bar;
        __builtin_amdgcn_s_waitcnt(0);
        unsigned nloc = b.st[0], nx = b.st[1];
        if (nloc == 0u) { xcd_barrier_complete(bar, b.x, nloc, nx); b.st[0] = nloc; b.st[1] = nx; }
        const unsigned old = xb_add(&bar[XB_XSUB(b.x)], 1u);
        const unsigned gen = old / nloc;
        if (old + 1u == (gen + 1u) * nloc) {
            __builtin_amdgcn_fence(__ATOMIC_RELEASE, "agent");
            asm volatile("s_waitcnt vmcnt(0)" ::: "memory");
            const unsigned og = xb_add(&bar[XB_TOP], 1u);
            const unsigned tg = og / nx;
            if (og + 1u == (tg + 1u) * nx) xb_add(&bar[XB_TOPGEN], 1u);
            else XB_SPIN(xb_ld(&bar[XB_TOPGEN]) == tg, bar);
            __builtin_amdgcn_fence(__ATOMIC_ACQUIRE, "agent");
            xb_add(&bar[XB_XGEN(b.x)], 1u);
            asm volatile("s_waitcnt vmcnt(0)" ::: "memory");
        } else {
            XB_SPIN(xb_ld(&bar[XB_XGEN(b.x)]) == gen, bar);
            __builtin_amdgcn_fence(__ATOMIC_ACQUIRE, "agent");
            asm volatile("s_waitcnt vmcnt(0)" ::: "memory");
        }
    }
    __syncthreads();
}

#ifndef N_NT
#define N_NT 0
#endif
#ifndef T_NT
#define T_NT 1
#endif
#ifndef T_NTS
#define T_NTS 0
#endif
struct Args { const float* in[17]; float* out; unsigned char* ws; int ph_lo, ph_hi; };
enum { I_X = 0, I_C, I_ADAW, I_ADAB, I_N1G, I_N2G, I_WIN, I_CONVW, I_GNG, I_FB, I_WOUT, I_RW, I_RB, I_WG, I_WU, I_WD, I_FG };
struct Frame {
    unsigned char* lds;
    gu32* ctl;
    unsigned char* ws;
    const Args* a;
    int tid, lane, wave, vcu, G;
};
__device__ __constant__ float INV_TAB[32] = {
    1.000000000e+00f, 7.498942614e-01f, 5.623413324e-01f, 4.216965139e-01f, 3.162277639e-01f, 2.371373773e-01f, 1.778279394e-01f, 1.333521307e-01f,
    1.000000015e-01f, 7.498941571e-02f, 5.623413250e-02f, 4.216965288e-02f, 3.162277490e-02f, 2.371373773e-02f, 1.778279431e-02f, 1.333521493e-02f,
    9.999999776e-03f, 7.498941850e-03f, 5.623413250e-03f, 4.216964822e-03f, 3.162277630e-03f, 2.371373586e-03f, 1.778279431e-03f, 1.333521446e-03f,
    1.000000047e-03f, 7.498942432e-04f, 5.623413017e-04f, 4.216965172e-04f, 3.162277571e-04f, 2.371373703e-04f, 1.778279402e-04f, 1.333521504e-04f};
__device__ __forceinline__ float ret_lg2(int h) { return __log2f(1.f - __builtin_amdgcn_exp2f((float)(-5 - h))); }

template <bool VEC2>
__device__ __forceinline__ void transpose_item(const float* W, int ldw, bf16* dst, int ldd, float* scr, int lane) {
    asm volatile("" : "+v"(lane));
    if (!VEC2) {
        const int kr = lane >> 4, nc = (lane & 15) * 4;
        f32x4 v[16];
#pragma unroll
        for (int i = 0; i < 16; ++i) v[i] = *(const f32x4*)(W + (size_t)(4 * i + kr) * ldw + nc);
#pragma unroll
        for (int i = 0; i < 16; ++i) { float* s = scr + (4 * i + kr) * 65 + nc; s[0] = v[i][0]; s[1] = v[i][1]; s[2] = v[i][2]; s[3] = v[i][3]; }
    } else {
        const int kr = lane >> 5, nc = (lane & 31) * 2;
#pragma unroll
        for (int hb = 0; hb < 2; ++hb) {
            f32x2 v[16];
#pragma unroll
            for (int i = 0; i < 16; ++i) v[i] = *(const f32x2*)(W + (size_t)(32 * hb + 2 * i + kr) * ldw + nc);
#pragma unroll
            for (int i = 0; i < 16; ++i) { float* s = scr + (32 * hb + 2 * i + kr) * 65 + nc; s[0] = v[i][0]; s[1] = v[i][1]; }
        }
    }
    LDS_WAIT();
    const int c = (lane & 3) + 4 * (lane >> 5), nn = (lane >> 2) & 7;
#pragma unroll
    for (int j = 0; j < 8; ++j) { const int n = nn + 8 * j; const float* s = scr + (8 * c) * 65 + n;
        v4u o; o.x = pk2(s[0 * 65], s[1 * 65]); o.y = pk2(s[2 * 65], s[3 * 65]); o.z = pk2(s[4 * 65], s[5 * 65]); o.w = pk2(s[6 * 65], s[7 * 65]);
        *(v4u*)(dst + (size_t)n * ldd + 8 * c) = o; }
    LDS_WAIT();
}
__device__ __forceinline__ void router_item(const float* W, bf16* dst, float* scr, int lane) {
    asm volatile("" : "+v"(lane));
    const int kr = lane >> 4, nc = (lane & 15) * 4;
    f32x4 v[16];
#pragma unroll
    for (int i = 0; i < 16; ++i) v[i] = *(const f32x4*)(W + (size_t)(4 * i + kr) * 64 + nc);
#pragma unroll
    for (int i = 0; i < 16; ++i) { float* s = scr + (4 * i + kr) * 65 + nc; s[0] = v[i][0]; s[1] = v[i][1]; s[2] = v[i][2]; s[3] = v[i][3]; }
    LDS_WAIT();
    const int c = (lane & 3) + 4 * (lane >> 5), nn = (lane >> 2) & 7;
#pragma unroll
    for (int j = 0; j < 8; ++j) { const int n = nn + 8 * j; const float* s = scr + (8 * c) * 65 + n; float x[8], lo[8];
#pragma unroll
        for (int e = 0; e < 8; ++e) { x[e] = s[e * 65]; lo[e] = x[e] - bf1(f2bf(x[e])); }
        const v4u oh = {pk2(x[0], x[1]), pk2(x[2], x[3]), pk2(x[4], x[5]), pk2(x[6], x[7])}, ol = {pk2(lo[0], lo[1]), pk2(lo[2], lo[3]), pk2(lo[4], lo[5]), pk2(lo[6], lo[7])};
        *(v4u*)(dst + (size_t)n * 4096 + 8 * c) = oh; *(v4u*)(dst + (size_t)n * 4096 + 2048 + 8 * c) = oh; *(v4u*)(dst + (size_t)(64 + n) * 4096 + 8 * c) = ol; }
    LDS_WAIT();
}
#ifndef NORM_PF
#define NORM_PF 0
#endif
#ifndef NPFJ
#define NPFJ 4
#endif
#ifndef CONV_V2
#define CONV_V2 1
#endif
#ifndef CONV_A1
#define CONV_A1 0
#endif
#ifndef CNS
#define CNS 2
#endif
#if CONV_V2
__device__ __forceinline__ void convert_items(Frame& F, int ml, int si0, int sstride, int nsup) {
    static_assert(MOE_FP8, "fp8 expert weights only");
    const Args& A = *F.a;
    int lane = F.lane; asm volatile("" : "+v"(lane));
    constexpr int TP = 144;
    unsigned char* tile = F.lds + F.wave * (64 * TP);
    const int nq = lane & 15, kg = lane >> 4;
    const int rn = lane >> 3, rc = lane & 7;
    const int NQP = ((4 * nsup + CNS - 1) / CNS) * CNS;
    const unsigned lo512 = (unsigned)((8 * kg * 512 + 4 * nq) * 4), lo2048 = (unsigned)((8 * kg * 2048 + 4 * nq) * 4);
#define C_SRC(si_, src, ldw) do { int r_ = (si_); \
        if (r_ < 16384) { const int s_ = r_ >> 13, e_ = (r_ >> 7) & 63, q_ = r_ & 127, kb_ = q_ >> 3, nb_ = q_ & 7; \
            src = A.in[s_ ? I_WU : I_WG] + ((size_t)(ml * 64 + e_) * 2048 + kb_ * 128) * 512 + nb_ * 64; ldw = 512; } \
        else { r_ -= 16384; const int e_ = r_ >> 7, q_ = r_ & 127, kb_ = q_ >> 5, nb_ = q_ & 31; \
            src = A.in[I_WD] + ((size_t)(ml * 64 + e_) * 512 + kb_ * 128) * 2048 + nb_ * 64; ldw = 2048; } } while (0)
#define C_DST(si_, dst, ldd) do { int r_ = (si_); \
        if (r_ < 16384) { const int s_ = r_ >> 13, e_ = (r_ >> 7) & 63, q_ = r_ & 127, kb_ = q_ >> 3, nb_ = q_ & 7, n0_ = nb_ * 64; \
            dst = F.ws + WS_WGU + ((size_t)(ml * 64 + e_) * 1024 + 256 * (n0_ >> 7) + 128 * s_ + (n0_ & 127)) * 2048 + kb_ * 128; ldd = 2048; } \
        else { r_ -= 16384; const int e_ = r_ >> 7, q_ = r_ & 127, kb_ = q_ >> 5, nb_ = q_ & 31; \
            dst = F.ws + WS_WD + ((size_t)(ml * 64 + e_) * 2048 + nb_ * 64) * 512 + kb_ * 128; ldd = 512; } } while (0)
#define C_LOAD(set, qq) do { const int q_l = (qq); const int si_l = si0 + min(q_l >> 2, nsup - 1) * sstride; const float* src_l; int ldw_l; C_SRC(si_l, src_l, ldw_l); \
        const char* pu = (const char*)(src_l + (size_t)(32 * (q_l & 3)) * ldw_l); const unsigned lo_l = ldw_l == 512 ? lo512 : lo2048; \
        _Pragma("unroll") for (int r = 0; r < 8; ++r) { const f32x4* pp = (const f32x4*)(pu + (size_t)r * ldw_l * 4 + lo_l); v[set][r] = T_NT ? __builtin_nontemporal_load(pp) : *pp; } } while (0)
#define C_PROC(set, qq) do { const int q_p = (qq), ks_p = q_p & 3; \
        _Pragma("unroll") for (int e = 0; e < 4; ++e) { i32x2 o; \
            o[0] = pg8::pk4_fp8(32.f * v[set][0][e], 32.f * v[set][1][e], 32.f * v[set][2][e], 32.f * v[set][3][e]); \
            o[1] = pg8::pk4_fp8(32.f * v[set][4][e], 32.f * v[set][5][e], 32.f * v[set][6][e], 32.f * v[set][7][e]); \
            *(i32x2*)(tile + (4 * nq + e) * TP + 32 * ks_p + 8 * kg) = o; } \
        if (ks_p == 3) { const int si_p = si0 + min(q_p >> 2, nsup - 1) * sstride; unsigned char* dst_p; int ldd_p; C_DST(si_p, dst_p, ldd_p); const unsigned so = (unsigned)(rn * ldd_p + 16 * rc); \
            LDS_WAIT(); \
            _Pragma("unroll") for (int j = 0; j < 8; ++j) { const v4u o = *(const v4u*)(tile + (rn + 8 * j) * TP + 16 * rc); v4u* g = (v4u*)(dst_p + (size_t)(8 * j) * ldd_p + so); \
                if (T_NTS) __builtin_nontemporal_store(o, g); else *g = o; } \
            LDS_WAIT(); } } while (0)
    typedef int i32x2 __attribute__((ext_vector_type(2)));
    f32x4 v[CNS][8];
#pragma unroll
    for (int s = 0; s < CNS - 1; ++s) C_LOAD(s, s);
    int q0 = 0;
#pragma unroll 1
    for (; q0 < NQP - CNS; q0 += CNS) {
#pragma unroll
        for (int s = 0; s < CNS; ++s) { C_LOAD((s + CNS - 1) % CNS, q0 + s + CNS - 1); C_PROC(s, q0 + s); }
    }
    C_LOAD(CNS - 1, q0 + CNS - 1);
#pragma unroll
    for (int s = 0; s < CNS; ++s) C_PROC(s, q0 + s);
#undef C_SRC
#undef C_DST
#undef C_LOAD
#undef C_PROC
}
#else
__device__ __forceinline__ void convert_items(Frame& F, int ml) {
    const Args& A = *F.a;
    float* scr = (float*)(F.lds + F.wave * SCR_WAVE);
    const int NGW = F.G * NWAVES;
    constexpr int N_ML = 16384, NIT = 3 * N_ML;
    constexpr bool is8 = MOE_FP8;
#define T_DECODE(r_, src, ldw, dst, ldd) do { int r = (r_); \
        if (r < 2 * N_ML) { const int s = r / N_ML, q0 = r % N_ML, le = ml * 64 + q0 / 256, q = q0 % 256, kb = q / 8, nb = q % 8, n0 = nb * 64; \
            const int row = 256 * (n0 >> 7) + 128 * s + (n0 & 127); \
            src = A.in[s ? I_WU : I_WG] + ((size_t)le * 2048 + kb * 64) * 512 + n0; ldw = 512; ldd = 2048; \
            dst = MOE_FP8 ? (bf16*)(F.ws + WS_WGU + ((size_t)le * 1024 + row) * 2048 + kb * 64) : (bf16*)(F.ws + WS_WGU) + ((size_t)le * 1024 + row) * 2048 + kb * 64; } \
        else { r -= 2 * N_ML; const int le = ml * 64 + r / 256, q = r % 256, kb = q / 32, nb = q % 32; \
            src = A.in[I_WD] + ((size_t)le * 512 + kb * 64) * 2048 + nb * 64; ldw = 2048; ldd = 512; \
            dst = MOE_FP8 ? (bf16*)(F.ws + WS_WD + ((size_t)le * 2048 + nb * 64) * 512 + kb * 64) : (bf16*)(F.ws + WS_WD) + ((size_t)le * 2048 + nb * 64) * 512 + kb * 64; } } while (0)
#define T_LOAD(v, src, ldw) do { _Pragma("unroll") for (int i = 0; i < 16; ++i) v[i] = T_NT ? __builtin_nontemporal_load((const f32x4*)(src + (size_t)(4 * i + kr) * ldw + nc)) : *(const f32x4*)(src + (size_t)(4 * i + kr) * ldw + nc); } while (0)
#define T_PROC(v, dst, ldd, is8) do { _Pragma("unroll") for (int i = 0; i < 16; ++i) { float* s = scr + (4 * i + kr) * 65 + nc; s[0] = v[i][0]; s[1] = v[i][1]; s[2] = v[i][2]; s[3] = v[i][3]; } \
        LDS_WAIT(); \
        if (is8) { const int c4 = lane & 3, n4 = lane >> 2;                    \
            _Pragma("unroll") for (int j = 0; j < 4; ++j) { const int n = n4 + 16 * j; const float* s = scr + (16 * c4) * 65 + n; v4u o; \
                o.x = (unsigned)pg8::pk4_fp8(32.f * s[0 * 65], 32.f * s[1 * 65], 32.f * s[2 * 65], 32.f * s[3 * 65]); o.y = (unsigned)pg8::pk4_fp8(32.f * s[4 * 65], 32.f * s[5 * 65], 32.f * s[6 * 65], 32.f * s[7 * 65]); \
                o.z = (unsigned)pg8::pk4_fp8(32.f * s[8 * 65], 32.f * s[9 * 65], 32.f * s[10 * 65], 32.f * s[11 * 65]); o.w = (unsigned)pg8::pk4_fp8(32.f * s[12 * 65], 32.f * s[13 * 65], 32.f * s[14 * 65], 32.f * s[15 * 65]); \
                if (T_NTS) __builtin_nontemporal_store(o, (v4u*)((unsigned char*)dst + (size_t)n * ldd + 16 * c4)); else *(v4u*)((unsigned char*)dst + (size_t)n * ldd + 16 * c4) = o; asm volatile("" ::: "memory"); } } \
        else { _Pragma("unroll") for (int j = 0; j < 8; ++j) { const int n = nn + 8 * j; const float* s = scr + (8 * cch) * 65 + n; \
            v4u o; o.x = pk2(s[0 * 65], s[1 * 65]); o.y = pk2(s[2 * 65], s[3 * 65]); o.z = pk2(s[4 * 65], s[5 * 65]); o.w = pk2(s[6 * 65], s[7 * 65]); \
            if (T_NTS) __builtin_nontemporal_store(o, (v4u*)(dst + (size_t)n * ldd + 8 * cch)); else *(v4u*)(dst + (size_t)n * ldd + 8 * cch) = o; } } \
        LDS_WAIT(); } while (0)
    { int lane = F.lane; asm volatile("" : "+v"(lane));
      const int kr = lane >> 4, nc = (lane & 15) * 4, cch = (lane & 3) + 4 * (lane >> 5), nn = (lane >> 2) & 7;
      int it = F.vcu * NWAVES + F.wave;
      if (it < NIT) {
          f32x4 va[16], vb[16]; const float* sa; const float* sb; bf16* da; bf16* db; int lwa, lda_, lwb, ldb_;
          T_DECODE(it, sa, lwa, da, lda_); T_LOAD(va, sa, lwa);
          for (;;) {
              const bool hb = it + NGW < NIT;
              if (hb) { T_DECODE(it + NGW, sb, lwb, db, ldb_); T_LOAD(vb, sb, lwb); }
              T_PROC(va, da, lda_, is8);
#ifdef DBL_TPROC
              T_PROC(va, da, lda_, is8);
#endif
              if (!hb) break;
              it += NGW;
              const bool ha = it + NGW < NIT;
              if (ha) { T_DECODE(it + NGW, sa, lwa, da, lda_); T_LOAD(va, sa, lwa); }
              T_PROC(vb, db, ldb_, is8);
#ifdef DBL_TPROC
              T_PROC(vb, db, ldb_, is8);
#endif
              if (!ha) break;
              it += NGW;
          }
      } }
#undef T_DECODE
#undef T_LOAD
#undef T_PROC
}
#endif
__device__ __forceinline__ void p0_prologue(Frame& F) {
    const Args& A = *F.a;
    float* scr = (float*)(F.lds + F.wave * SCR_WAVE);
    const int gw = F.wave * F.G + F.vcu, NGW = F.G * NWAVES;
    { const float* cv = A.in[I_C]; const float* W = A.in[I_ADAW]; float* MP = (float*)(F.ws + WS_MODP);
      for (int it = gw; it < 2 * 8 * 48; it += NGW) {
          const int l = it / 384, r = it % 384, ks = r / 48, nb = r % 48;
          const float* wp = W + ((size_t)l * 2048 + ks * 256) * 12288 + nb * 256 + F.lane * 4;
          f32x4 acc = {0.f, 0.f, 0.f, 0.f};
#pragma unroll 32
          for (int k = 0; k < 256; ++k) { const float cx = cv[ks * 256 + k]; const float sl = cx / (1.f + __expf(-cx)); acc += sl * (T_NT ? __builtin_nontemporal_load((const f32x4*)(wp + (size_t)k * 12288)) : *(const f32x4*)(wp + (size_t)k * 12288)); }
          *(f32x4*)(MP + (size_t)(l * 8 + ks) * 12288 + nb * 256 + F.lane * 4) = acc;
      } }
    { float* ROT = (float*)(F.ws + WS_ROT); const int gt = (F.vcu * NWAVES + F.wave) * 64 + F.lane, NT = NGW * 64;
      for (int idx = gt; idx < S_ * 32; idx += NT) { const int pos = idx >> 5, i = idx & 31;
          const float ang = (float)pos * INV_TAB[i]; double rev = (double)ang * 0.15915494309189535; rev -= __builtin_rint(rev); const float fr = (float)rev;
          *(f32x2*)(ROT + (size_t)idx * 2) = (f32x2){__builtin_amdgcn_cosf(fr), __builtin_amdgcn_sinf(fr)}; }
      v4u* z = (v4u*)(F.ws + WS_RWT2); const v4u zero = {0u, 0u, 0u, 0u};
      for (int idx = gt; idx < 64 * 256 + 128 * 512; idx += NT) { const int o = idx < 64 * 256 ? (64 + idx / 256) * 512 + 256 + idx % 256 : 128 * 512 + (idx - 64 * 256); z[o] = zero; } }
    constexpr int N_WIN = 2 * 32 * 96, N_RW = 32;
    for (int it = gw; it < N_WIN; it += NGW) { const int l = it / 3072, q = it % 3072, kb = q / 96, nb = q % 96;
        transpose_item<true>(A.in[I_WIN] + ((size_t)l * 2048 + kb * 64) * NIN + nb * 64, NIN, (bf16*)(F.ws + WS_WIN) + ((size_t)l * NPJ + nb * 64) * 2048 + kb * 64, 2048, scr, F.lane); }
    for (int it = gw; it < N_RW; it += NGW) router_item(A.in[I_RW] + (size_t)(it * 64) * 64, (bf16*)(F.ws + WS_RWT2) + it * 64, scr, F.lane);
    for (int it = gw; it < 2 * 32 * 32; it += NGW) { const int l = it / 1024, q = it % 1024, kb = q / 32, nb = q % 32;
        transpose_item<false>(A.in[I_WOUT] + ((size_t)l * 2048 + kb * 64) * 2048 + nb * 64, 2048, (bf16*)(F.ws + WS_WOUT) + ((size_t)l * 2048 + nb * 64) * 2048 + kb * 64, 2048, scr, F.lane); }
}

__device__ __forceinline__ float modv(const Args& A, const unsigned char* ws, int l, int idx) {
    const float* MP = (const float*)(ws + WS_MODP) + (size_t)l * 8 * 12288 + idx; float s = A.in[I_ADAB][l * 12288 + idx];
#pragma unroll
    for (int ks = 0; ks < 8; ++ks) s += MP[(size_t)ks * 12288];
    return s;
}
__device__ __forceinline__ float logsig(float x) { return fminf(x, 0.f) - __logf(1.f + __expf(-fabsf(x))); }
__device__ __forceinline__ int moe_tables(Frame& F, int l);
template <int MODE>
__device__ __forceinline__ void norm_phase(Frame& F, int l) {
    const Args& A = *F.a;
    if (MODE == 1 || MODE == 3) (void)moe_tables(F, MODE == 1 ? l - 1 : l);
    float* Av = (float*)F.lds; float* Bv = Av + 2048; float* Gv = Bv + 2048; float* W6 = Gv + 2048;
    const float* MODFr = (const float*)(F.ws + WS_MODF); const float* W6Tr = (const float*)(F.ws + WS_MODF + 131072);
    {
        float av_[4], bv_[4], gv_[4], w6_[4][6];
#pragma unroll
        for (int q = 0; q < 4; ++q) { const int col = F.tid + NWAVES * 64 * q; gv_[q] = 0.f;
            if (MODE == 0) {
                const float ng = A.in[I_N1G][l * 2048 + col], sh = modv(A, F.ws, l, col), sc = modv(A, F.ws, l, 2048 + col);
                av_[q] = ng * (1.f + sc); bv_[q] = sh;
                const float* w = A.in[I_WIN] + ((size_t)l * 2048 + col) * NIN + C_FF;
#pragma unroll
                for (int j = 0; j < 6; ++j) w6_[q][j] = w[j];
            } else if (MODE == 1) {
                av_[q] = A.in[I_N1G][l * 2048 + col] * (1.f + MODFr[l * 12288 + 2048 + col]); bv_[q] = MODFr[l * 12288 + col];
#pragma unroll
                for (int j = 0; j < 6; ++j) w6_[q][j] = W6Tr[(l * 6 + j) * 2048 + col];
            } else if (MODE == 2) {
                const float ng = A.in[I_N2G][l * 2048 + col], sh = modv(A, F.ws, l, 6144 + col), sc = modv(A, F.ws, l, 8192 + col);
                av_[q] = ng * (1.f + sc); bv_[q] = sh;
            } else { av_[q] = A.in[I_FG][col]; bv_[q] = 0.f; }
            if (MODE == 1 || MODE == 3) gv_[q] = MODFr[(MODE == 1 ? l - 1 : l) * 12288 + 10240 + col]; }
        asm volatile("" ::: "memory");
#pragma unroll
        for (int q = 0; q < 4; ++q) { const int col = F.tid + NWAVES * 64 * q; Av[col] = av_[q]; Bv[col] = bv_[q];
            if (MODE == 1 || MODE == 3) Gv[col] = gv_[q];
            if (MODE == 0 || MODE == 1) {
#pragma unroll
                for (int j = 0; j < 6; ++j) W6[j * 2048 + col] = w6_[q][j]; } }
    }
    if (MODE == 0) {
        if (F.tid < 96) { const int lyr = F.tid / 48, idx = F.vcu * 48 + F.tid % 48; ((float*)(F.ws + WS_MODF))[lyr * 12288 + idx] = modv(A, F.ws, lyr, idx); }
        else if (F.tid >= 128 && F.tid < 224) { const int id = F.vcu * 96 + (F.tid - 128), lyr = id / 12288, rem = id % 12288, col = rem / 6, j = rem % 6;
            ((float*)(F.ws + WS_MODF + 131072))[(lyr * 6 + j) * 2048 + col] = A.in[I_WIN][((size_t)lyr * 2048 + col) * NIN + C_FF + j]; }
    }
    __syncthreads();
    const float* X1 = (const float*)(F.ws + WS_X1); const bf16* YS = (const bf16*)(F.ws + WS_YS);
    const int* TOPE = (const int*)(F.ws + WS_ROUTE); const int* TOPPOS = (const int*)(F.ws + WS_ROUTE + 2 * 131072); const float* TOPW = (const float*)(F.ws + WS_ROUTE + 131072);
    const int* offs = (const int*)(F.lds + LDS_OFFS);
    bf16* H = (bf16*)(F.ws + WS_H); float* LS = (float*)(F.ws + WS_LS);
    const int gw = F.vcu * NWAVES + F.wave, NGW = F.G * NWAVES;
    int ns0 = 0, ns1 = 0; float nw0 = 0.f, nw1 = 0.f;
    if ((MODE == 1 || MODE == 3) && gw < S_) { ns0 = offs[TOPE[2 * gw]] + TOPPOS[2 * gw]; ns1 = offs[TOPE[2 * gw + 1]] + TOPPOS[2 * gw + 1]; nw0 = TOPW[2 * gw]; nw1 = TOPW[2 * gw + 1]; }
#if NORM_PF
    const float* XS = MODE == 0 ? A.in[I_X] : X1;
    f32x4 xn[NPFJ];
    { int ln0 = F.lane; asm volatile("" : "+v"(ln0));
#pragma unroll
      for (int j = 0; j < NPFJ; ++j) xn[j] = *(const f32x4*)(XS + (size_t)gw * 2048 + ln0 * 4 + 256 * j); }
#endif
    for (int t = gw; t < S_; t += NGW) {
        int ln_ = F.lane; asm volatile("" : "+v"(ln_)); f32x4 x[8]; const int c0 = ln_ * 4;
#if NORM_PF
        { const int tn = t + NGW < S_ ? t + NGW : t;
#pragma unroll
          for (int j = NPFJ; j < 8; ++j) x[j] = *(const f32x4*)(XS + (size_t)t * 2048 + c0 + 256 * j);
#pragma unroll
          for (int j = 0; j < NPFJ; ++j) { x[j] = xn[j]; xn[j] = *(const f32x4*)(XS + (size_t)tn * 2048 + c0 + 256 * j); } }
#else
        if (MODE == 0) {
#pragma unroll
            for (int j = 0; j < 8; ++j) x[j] = *(const f32x4*)(A.in[I_X] + (size_t)t * 2048 + c0 + 256 * j);
        } else {
#pragma unroll
#if X1_BF16
            for (int j = 0; j < 8; ++j) { const v2u w = *(const v2u*)((const bf16*)X1 + (size_t)t * 2048 + c0 + 256 * j); x[j] = (f32x4){bflo(w.x), bfhi(w.x), bflo(w.y), bfhi(w.y)}; }
#else
            for (int j = 0; j < 8; ++j) x[j] = (N_NT && (MODE == 1 || MODE == 3)) ? __builtin_nontemporal_load((const f32x4*)(X1 + (size_t)t * 2048 + c0 + 256 * j)) : *(const f32x4*)(X1 + (size_t)t * 2048 + c0 + 256 * j);
#endif
        }
#endif
        if (MODE == 1 || MODE == 3) {
            const int s0 = ns0, s1 = ns1; const float w0 = nw0, w1 = nw1;
            { const int tn = t + NGW < S_ ? t + NGW : t; ns0 = offs[TOPE[2 * tn]] + TOPPOS[2 * tn]; ns1 = offs[TOPE[2 * tn + 1]] + TOPPOS[2 * tn + 1]; nw0 = TOPW[2 * tn]; nw1 = TOPW[2 * tn + 1]; }
#pragma unroll
            for (int j = 0; j < 8; ++j) { const f32x4 g = *(const f32x4*)(Gv + c0 + 256 * j);
#if MOE_FP8
                const int a = N_NT ? __builtin_nontemporal_load((const int*)((const unsigned char*)YS + (size_t)s0 * 2048 + c0 + 256 * j)) : *(const int*)((const unsigned char*)YS + (size_t)s0 * 2048 + c0 + 256 * j), b = N_NT ? __builtin_nontemporal_load((const int*)((const unsigned char*)YS + (size_t)s1 * 2048 + c0 + 256 * j)) : *(const int*)((const unsigned char*)YS + (size_t)s1 * 2048 + c0 + 256 * j);
                const float u0 = w0 * (1.f / 16.f), u1 = w1 * (1.f / 16.f);
                x[j][0] += g[0] * (u0 * __builtin_amdgcn_cvt_f32_fp8(a, 0) + u1 * __builtin_amdgcn_cvt_f32_fp8(b, 0)); x[j][1] += g[1] * (u0 * __builtin_amdgcn_cvt_f32_fp8(a, 1) + u1 * __builtin_amdgcn_cvt_f32_fp8(b, 1));
                x[j][2] += g[2] * (u0 * __builtin_amdgcn_cvt_f32_fp8(a, 2) + u1 * __builtin_amdgcn_cvt_f32_fp8(b, 2)); x[j][3] += g[3] * (u0 * __builtin_amdgcn_cvt_f32_fp8(a, 3) + u1 * __builtin_amdgcn_cvt_f32_fp8(b, 3));
                if (NORM_PF && (j & 3) == 3) asm volatile("" ::: "memory");
#else
                const v2u a = *(const v2u*)(YS + (size_t)s0 * 2048 + c0 + 256 * j), b = *(const v2u*)(YS + (size_t)s1 * 2048 + c0 + 256 * j);
                x[j][0] += g[0] * (w0 * bflo(a.x) + w1 * bflo(b.x)); x[j][1] += g[1] * (w0 * bfhi(a.x) + w1 * bfhi(b.x));
                x[j][2] += g[2] * (w0 * bflo(a.y) + w1 * bflo(b.y)); x[j][3] += g[3] * (w0 * bfhi(a.y) + w1 * bfhi(b.y));
#endif
                }
            if (MODE == 1) {
#pragma unroll
                for (int j = 0; j < 8; ++j) *(f32x4*)(A.out + (size_t)t * 2048 + c0 + 256 * j) = x[j];
            }
        }
        float ss = 0.f;
#pragma unroll
        for (int j = 0; j < 8; ++j) ss += (x[j][0] * x[j][0] + x[j][1] * x[j][1]) + (x[j][2] * x[j][2] + x[j][3] * x[j][3]);
        const float rs = 1.0f / sqrtf(wave_sum(ss) * (1.f / 2048.f) + EPS_);
        float ff[6] = {0.f, 0.f, 0.f, 0.f, 0.f, 0.f};
#pragma unroll
        for (int j = 0; j < 8; ++j) { const f32x4 av = *(const f32x4*)(Av + c0 + 256 * j), bv = *(const f32x4*)(Bv + c0 + 256 * j);
            const f32x4 hv = x[j] * rs * av + bv;
            if (MODE == 3) *(f32x4*)(A.out + (size_t)t * 2048 + c0 + 256 * j) = hv;
            else if (MODE == 2) { v2u o; o.x = pk2(hv[0], hv[1]); o.y = pk2(hv[2], hv[3]); bf16* hp = (bf16*)(F.ws + WS_H2X) + (size_t)t * 4096 + c0 + 256 * j; *(v2u*)hp = o;
                v2u q; q.x = pk2(hv[0] - bflo(o.x), hv[1] - bfhi(o.x)); q.y = pk2(hv[2] - bflo(o.y), hv[3] - bfhi(o.y)); *(v2u*)(hp + 2048) = q; }
            else { v2u o; o.x = pk2(hv[0], hv[1]); o.y = pk2(hv[2], hv[3]); *(v2u*)(H + (size_t)t * 2048 + c0 + 256 * j) = o; }
            if (MODE == 0 || MODE == 1) {
#pragma unroll
                for (int q = 0; q < 6; ++q) { const f32x4 w = *(const f32x4*)(W6 + q * 2048 + c0 + 256 * j); ff[q] += (hv[0] * w[0] + hv[1] * w[1]) + (hv[2] * w[2] + hv[3] * w[3]); }
            }
            asm volatile("" ::: "memory");
        }
        if (MODE == 0 || MODE == 1) {
#pragma unroll
            for (int q = 0; q < 6; ++q) { const float f = wave_sum(ff[q]); if (F.lane == q) LS[(size_t)q * S_ + t] = logsig(f + A.in[I_FB][l * 6 + q]); }
        }
    }
}

__device__ __forceinline__ void cum_item(Frame& F, int h) {
    const float* LS = (const float*)(F.ws + WS_LS); float* CUM = (float*)(F.ws + WS_CUM) + (size_t)h * S_;
    float* red = (float*)F.lds;
    const int p0 = F.tid * 32; float v[32]; float run = 0.f;
#pragma unroll
    for (int i = 0; i < 32; i += 4) { const f32x4 x4 = *(const f32x4*)(LS + (size_t)h * S_ + p0 + i); run += x4[0]; v[i] = run; run += x4[1]; v[i + 1] = run; run += x4[2]; v[i + 2] = run; run += x4[3]; v[i + 3] = run; }
    float inc = run;
#pragma unroll
    for (int o = 1; o < 64; o <<= 1) { const float u = __shfl_up(inc, o); if (F.lane >= o) inc += u; }
    if (F.lane == 63) red[F.wave] = inc;
    __syncthreads();
    float base = inc - run;
    for (int w = 0; w < F.wave; ++w) base += red[w];
#pragma unroll
    for (int i = 0; i < 32; i += 4) *(f32x4*)(CUM + p0 + i) = (f32x4){base + v[i], base + v[i + 1], base + v[i + 2], base + v[i + 3]};
    __syncthreads();
}
__device__ __forceinline__ void qknorm_item(Frame& F, int h, int qb) {
    const bf16* PJ = (const bf16*)(F.ws + WS_PROJ); float* MQK = (float*)(F.ws + WS_MAXQK);
    float* red = (float*)F.lds;
    const int row = qb * 256 + (F.tid >> 1), half = F.tid & 1;
    const bf16* QH = (const bf16*)(F.ws + WS_QKVH); const bf16* qp = QH + ((size_t)(G_FQ + h) * S_ + row) * 128 + 64 * half; const bf16* kp = QH + ((size_t)(G_FK + h) * S_ + row) * 128 + 64 * half;
    float sq = 0.f, sk = 0.f;
#pragma unroll
    for (int i = 0; i < 8; ++i) { const v4u a = *(const v4u*)(qp + 8 * i), b = *(const v4u*)(kp + 8 * i);
#pragma unroll
        for (int e = 0; e < 4; ++e) { const float a0 = bflo(a[e]), a1 = bfhi(a[e]), b0 = bflo(b[e]), b1 = bfhi(b[e]); sq += a0 * a0 + a1 * a1; sk += b0 * b0 + b1 * b1; } }
    sq += __shfl_xor(sq, 1); sk += __shfl_xor(sk, 1);
    const float mq = wave_max(sqrtf(sq)), mk = wave_max(sqrtf(sk));
    if (F.lane == 0) { red[F.wave * 2] = mq; red[F.wave * 2 + 1] = mk; }
    __syncthreads();
    if (F.tid == 0) { float a = 0.f, b = 0.f; for (int w = 0; w < 8; ++w) { a = fmaxf(a, red[2 * w]); b = fmaxf(b, red[2 * w + 1]); } MQK[(h * 64 + qb) * 2] = a; MQK[(h * 64 + qb) * 2 + 1] = b; }
    __syncthreads();
}
__device__ __forceinline__ void conv_item(Frame& F, int l, int rb) {
    const Args& A = *F.a; const bf16* PJ = (const bf16*)(F.ws + WS_PROJ); bf16* MX = (bf16*)(F.ws + WS_MIXED);
    int tid = F.tid; asm volatile("" : "+v"(tid));
    const int ch = (tid & 63) * 8, t0 = rb * 64 + (tid >> 6) * 8;
    float w0[8], w1[8], w2[8], z1[8], z2[8];
#pragma unroll
    for (int e = 0; e < 8; ++e) { w0[e] = A.in[I_CONVW][(l * 3 + 0) * 512 + ch + e]; w1[e] = A.in[I_CONVW][(l * 3 + 1) * 512 + ch + e]; w2[e] = A.in[I_CONVW][(l * 3 + 2) * 512 + ch + e]; z1[e] = 0.f; z2[e] = 0.f; }
    const bf16* __restrict__ pj = PJ; bf16* __restrict__ mx = MX;
    v4u cc[10], cu[10], cb[8];
#pragma unroll
    for (int i = 0; i < 10; ++i) { const int t = t0 + i - 2, tc = t < 0 ? 0 : t; const bf16* rp = pj + (size_t)tc * NPC + ch; cc[i] = *(const v4u*)(rp + C_CC); cu[i] = *(const v4u*)(rp + C_CU); if (i >= 2) cb[i - 2] = *(const v4u*)(rp + C_CB); }
    asm volatile("" ::: "memory");
#pragma unroll
    for (int i = 0; i < 10; ++i) { const int t = t0 + i - 2; const float live = t < 0 ? 0.f : 1.f;
        float z[8];
#pragma unroll
        for (int e = 0; e < 4; ++e) { z[2 * e] = live * bflo(cc[i][e]) * bflo(cu[i][e]); z[2 * e + 1] = live * bfhi(cc[i][e]) * bfhi(cu[i][e]); }
        if (i >= 2) { const v4u g = cb[i - 2]; float y[8];
#pragma unroll
            for (int e = 0; e < 4; ++e) { y[2 * e] = bflo(g[e]) * (w0[2 * e] * z2[2 * e] + w1[2 * e] * z1[2 * e] + w2[2 * e] * z[2 * e]);
                                          y[2 * e + 1] = bfhi(g[e]) * (w0[2 * e + 1] * z2[2 * e + 1] + w1[2 * e + 1] * z1[2 * e + 1] + w2[2 * e + 1] * z[2 * e + 1]); }
            v4u o; o.x = pk2(y[0], y[1]); o.y = pk2(y[2], y[3]); o.z = pk2(y[4], y[5]); o.w = pk2(y[6], y[7]);
            *(v4u*)(mx + (size_t)t * 2048 + M_CONV + ch) = o; }
#pragma unroll
        for (int e = 0; e < 8; ++e) { z2[e] = z1[e]; z1[e] = z[e]; }
    }
}
__device__ __forceinline__ void rot4(const bf16* rowp, const float* ROT, int pos, int i0, float (&o1)[4], float (&o2)[4]) {
    const v2u a = *(const v2u*)(rowp + i0), b = *(const v2u*)(rowp + 32 + i0);
    const f32x4 c0 = *(const f32x4*)(ROT + ((size_t)pos * 32 + i0) * 2), c1 = *(const f32x4*)(ROT + ((size_t)pos * 32 + i0) * 2 + 4);
    const float x1[4] = {bflo(a.x), bfhi(a.x), bflo(a.y), bfhi(a.y)}, x2[4] = {bflo(b.x), bfhi(b.x), bflo(b.y), bfhi(b.y)};
    const float cs[4] = {c0[0], c0[2], c1[0], c1[2]}, sn[4] = {c0[1], c0[3], c1[1], c1[3]};
#pragma unroll
    for (int e = 0; e < 4; ++e) { o1[e] = x1[e] * cs[e] - x2[e] * sn[e]; o2[e] = x2[e] * cs[e] + x1[e] * sn[e]; }
}
constexpr int RP = 72;
constexpr int PVR = 160, PKR = 96;
typedef short v4i16_t __attribute__((ext_vector_type(4)));
__device__ __forceinline__ s16x4 trrd(const bf16* p) { return __builtin_bit_cast(s16x4, __builtin_amdgcn_ds_read_tr16_b64_v4i16((LAS v4i16_t*)p)); }
__device__ __forceinline__ bf16x8 tr_frag(const bf16* T, int pitch, int rowA, int rowB, int col0, int lane) {
    const int blk = (lane >> 4) & 1, q = (lane & 15) >> 2, p = lane & 3; const bf16* b = T + q * pitch + col0 + 16 * blk + 4 * p;
    const s16x4 lo = trrd(b + rowA * pitch), hi = trrd(b + rowB * pitch);
    return (bf16x8){lo[0], lo[1], lo[2], lo[3], hi[0], hi[1], hi[2], hi[3]};
}
__device__ __forceinline__ void stage_vr(unsigned char* ws, int tid, bf16* VR, int c, int h) {
    const bf16* HM = (const bf16*)(ws + WS_QKVH);
    const int m = tid >> 3, v0 = (tid & 7) * 16; const bf16* vp = HM + ((size_t)(G_RV + h) * S_ + 64 * c + m) * 128 + v0;
    const v4u a = *(const v4u*)vp, b = *(const v4u*)(vp + 8);
    *(v4u*)(VR + m * PVR + v0) = a; *(v4u*)(VR + m * PVR + v0 + 8) = b;
}
__device__ __forceinline__ void stage_vr_load(unsigned char* ws, int tid, int c, int h, v4u& a, v4u& b) {
    const bf16* HM = (const bf16*)(ws + WS_QKVH);
    const int m = tid >> 3, v0 = (tid & 7) * 16; const bf16* vp = HM + ((size_t)(G_RV + h) * S_ + 64 * c + m) * 128 + v0;
    a = *(const v4u*)vp; b = *(const v4u*)(vp + 8);
}
__device__ __forceinline__ void stage_vr_store(int tid, bf16* VR, v4u a, v4u b) { const int m = tid >> 3, v0 = (tid & 7) * 16; *(v4u*)(VR + m * PVR + v0) = a; *(v4u*)(VR + m * PVR + v0 + 8) = b; }
__device__ __forceinline__ void r1_item(Frame& FF, int c, int h) {
    struct { unsigned char* lds; unsigned char* ws; int tid, lane, wave; } F; F.lds = FF.lds; F.ws = FF.ws; F.wave = FF.wave;
    { int t_ = FF.tid; asm volatile("" : "+v"(t_)); F.tid = t_; F.lane = t_ & 63; }
    const bf16* PJ = (const bf16*)(F.ws + WS_PROJ); const float* ROT = (const float*)(F.ws + WS_ROT);
    bf16* KR = (bf16*)F.lds; bf16* VR = KR + 64 * PKR;
    const float lg2 = ret_lg2(h);
    v4u va_, vb_; stage_vr_load(F.ws, F.tid, c, h, va_, vb_);
    { const int m = F.tid >> 3, i0 = (F.tid & 7) * 4, pos = 64 * c + m; float o1[4], o2[4];
      rot4((const bf16*)(F.ws + WS_QKVH) + ((size_t)(G_RK + (h >> 1)) * S_ + pos) * 128 + 64 * (h & 1), ROT, pos, i0, o1, o2);
      const float sc = 0.125f * __builtin_amdgcn_exp2f(lg2 * (float)(63 - m));
      *(v2u*)(KR + m * PKR + i0) = (v2u){pk2(o1[0] * sc, o1[1] * sc), pk2(o1[2] * sc, o1[3] * sc)}; *(v2u*)(KR + m * PKR + 32 + i0) = (v2u){pk2(o2[0] * sc, o2[1] * sc), pk2(o2[2] * sc, o2[3] * sc)}; }
    stage_vr_store(F.tid, VR, va_, vb_);
    __syncthreads();
    const int r32 = F.lane & 31, hh = F.lane >> 5, vi = F.wave >> 1, di = F.wave & 1;
    f32x16 acc = {};
#pragma unroll
    for (int s = 0; s < 4; ++s) { const bf16x8 a = tr_frag(VR, PVR, 16 * s + 8 * hh, 16 * s + 8 * hh + 4, 32 * vi, F.lane), b = tr_frag(KR, PKR, 16 * s + 8 * hh, 16 * s + 8 * hh + 4, 32 * di, F.lane);
        acc = __builtin_amdgcn_mfma_f32_32x32x16_bf16(a, b, acc, 0, 0, 0); }
    float* KVT = (float*)(F.ws + WS_KVT) + (size_t)(c * 6 + h) * 8192;
#pragma unroll
    for (int r = 0; r < 16; ++r) KVT[(32 * vi + fa::crow(r, hh)) * 64 + 32 * di + r32] = acc[r];
    __syncthreads();
}
#ifndef R1_IN_A0
#define R1_IN_A0 0
#endif
__device__ __forceinline__ void mixa0_phase(Frame& F) {
    constexpr int N_CUM = 6, N_QK = 384;
    for (int it = F.vcu; it < N_CUM + N_QK; it += F.G) { if (it < N_CUM) cum_item(F, it); else qknorm_item(F, (it - N_CUM) % 6, (it - N_CUM) / 6); }
#if R1_IN_A0
#pragma unroll 1
    for (int it = F.G - 1 - F.vcu; it < 1536; it += F.G) r1_item(F, it / 6, it % 6);
#endif
}
__device__ __forceinline__ void mixb_phase(Frame& F) {
    const float* __restrict__ KVT = (const float*)(F.ws + WS_KVT); bf16* __restrict__ PV = (bf16*)(F.ws + WS_PREVT);
    const int gt = (F.wave * F.G + F.vcu) * 64 + F.lane;
    if (gt < 6 * 8192) { const int h = gt / 8192; const float dec = __builtin_amdgcn_exp2f(ret_lg2(h) * 64.f); float st = 0.f;
        float kv[32], kn[32];
#pragma unroll
        for (int i = 0; i < 32; ++i) kv[i] = KVT[(size_t)i * 49152 + gt];
#pragma unroll 1
        for (int c0 = 0; c0 < 256; c0 += 32) { const int cn = c0 + 32 < 256 ? c0 + 32 : c0;
#pragma unroll
            for (int i = 0; i < 32; ++i) kn[i] = KVT[(size_t)(cn + i) * 49152 + gt];
#pragma unroll
            for (int i = 0; i < 32; ++i) { PV[(size_t)(c0 + i) * 49152 + gt] = f2bf(st); st = st * dec + kv[i]; }
#pragma unroll
            for (int i = 0; i < 32; ++i) kv[i] = kn[i]; } }
}
struct R3In { v2u qa, qb, ka, kb; f32x4 r0, r1; v4u va, vb, g0, g1; bf16x8 pvf[4]; f32x4 gn[4]; };
__device__ __forceinline__ void r3_load(Frame& FF, int l, int c, int h, R3In& I) {
    int tid = FF.tid; asm volatile("" : "+v"(tid)); const int lane = tid & 63;
    const bf16* PJ = (const bf16*)(FF.ws + WS_PROJ); const float* ROT = (const float*)(FF.ws + WS_ROT);
    const int m = tid >> 3, i0 = (tid & 7) * 4, pos = 64 * c + m; const bf16* HM = (const bf16*)(FF.ws + WS_QKVH);
    { const bf16* qp = HM + ((size_t)(G_RQ + (h >> 1)) * S_ + pos) * 128 + 64 * (h & 1) + i0; const bf16* kp = HM + ((size_t)(G_RK + (h >> 1)) * S_ + pos) * 128 + 64 * (h & 1) + i0;
      I.qa = *(const v2u*)qp; I.qb = *(const v2u*)(qp + 32); I.ka = *(const v2u*)kp; I.kb = *(const v2u*)(kp + 32); }
    I.r0 = *(const f32x4*)(ROT + ((size_t)pos * 32 + i0) * 2); I.r1 = *(const f32x4*)(ROT + ((size_t)pos * 32 + i0) * 2 + 4);
    { const bf16* vp = HM + ((size_t)(G_RV + h) * S_ + pos) * 128 + (tid & 7) * 16; I.va = *(const v4u*)vp; I.vb = *(const v4u*)(vp + 8); }
    { const bf16* gp = HM + ((size_t)(G_RG + h) * S_ + pos) * 128 + 16 * (tid & 7); I.g0 = *(const v4u*)gp; I.g1 = *(const v4u*)(gp + 8); }
    { const float* gnp = FF.a->in[I_GNG] + l * 768 + 128 * h + 16 * (tid & 7);
#pragma unroll
      for (int q = 0; q < 4; ++q) I.gn[q] = *(const f32x4*)(gnp + 4 * q); }
    { const int r32_ = lane & 31, hh_ = lane >> 5, vi_ = FF.wave >> 1; const bf16* PV = (const bf16*)(FF.ws + WS_PREVT) + ((size_t)(c * 6 + h) * 128 + 32 * vi_ + r32_) * 64;
#pragma unroll
      for (int s = 0; s < 4; ++s) I.pvf[s] = *(const bf16x8*)(PV + 16 * s + 8 * hh_); }
}
__device__ __forceinline__ void rot4v(v2u a, v2u b, f32x4 c0, f32x4 c1, float (&o1)[4], float (&o2)[4]) {
    const float x1[4] = {bflo(a.x), bfhi(a.x), bflo(a.y), bfhi(a.y)}, x2[4] = {bflo(b.x), bfhi(b.x), bflo(b.y), bfhi(b.y)};
    const float cs[4] = {c0[0], c0[2], c1[0], c1[2]}, sn[4] = {c0[1], c0[3], c1[1], c1[3]};
#pragma unroll
    for (int e = 0; e < 4; ++e) { o1[e] = x1[e] * cs[e] - x2[e] * sn[e]; o2[e] = x2[e] * cs[e] + x1[e] * sn[e]; }
}
__device__ __forceinline__ void r3_compute(Frame& FF, int l, int c, int h, const R3In& I) {
    struct { unsigned char* lds; unsigned char* ws; const Args* a; int tid, lane, wave; } F; F.lds = FF.lds; F.ws = FF.ws; F.a = FF.a; F.wave = FF.wave;
    { int t_ = FF.tid; asm volatile("" : "+v"(t_)); F.tid = t_; F.lane = t_ & 63; }
#ifdef DBG_R3T
    const unsigned long long t0_ = __builtin_amdgcn_s_memrealtime();
#endif
    const Args& A = *F.a;
    bf16* QS = (bf16*)F.lds; bf16* KS = QS + 64 * RP; bf16* VR = KS + 64 * RP; float* OS = (float*)(VR + 64 * PVR);
    const float lg2 = ret_lg2(h);
#ifndef R3_REP1
#define R3_REP1 1
#define R3_REP2 1
#define R3_REP3 1
#endif
#pragma unroll 1
    for (int rp1 = 0; rp1 < R3_REP1; ++rp1) {
    { const int m = F.tid >> 3, i0 = (F.tid & 7) * 4; float o1[4], o2[4];
      rot4v(I.qa, I.qb, I.r0, I.r1, o1, o2);
      *(v2u*)(QS + m * RP + i0) = (v2u){pk2(o1[0], o1[1]), pk2(o1[2], o1[3])}; *(v2u*)(QS + m * RP + 32 + i0) = (v2u){pk2(o2[0], o2[1]), pk2(o2[2], o2[3])};
      rot4v(I.ka, I.kb, I.r0, I.r1, o1, o2);
      *(v2u*)(KS + m * RP + i0) = (v2u){pk2(o1[0] * 0.125f, o1[1] * 0.125f), pk2(o1[2] * 0.125f, o1[3] * 0.125f)};
      *(v2u*)(KS + m * RP + 32 + i0) = (v2u){pk2(o2[0] * 0.125f, o2[1] * 0.125f), pk2(o2[2] * 0.125f, o2[3] * 0.125f)};
      const int v0 = (F.tid & 7) * 16; *(v4u*)(VR + m * PVR + v0) = I.va; *(v4u*)(VR + m * PVR + v0 + 8) = I.vb; }
    __syncthreads(); }
#ifdef DBG_R3T
    unsigned long long t1_ = __builtin_amdgcn_s_memrealtime(); if (FF.tid == 0 && blockIdx.x == 1) __hip_atomic_fetch_add((unsigned long long*)(FF.ctl + 20010 + 2 * 1), t1_ - t0_, RLX_AGENT);
#endif
    const int r32 = F.lane & 31, hh = F.lane >> 5, ni = F.wave & 1, vi = F.wave >> 1;
#pragma unroll 1
    for (int rp2 = 0; rp2 < R3_REP2; ++rp2) {
    f32x16 oacc = {}, cacc = {};
#pragma unroll
    for (int mj = 0; mj < 2; ++mj) {
        f32x16 X = {};
#pragma unroll
        for (int s = 0; s < 4; ++s) { const bf16x8 a = *(const bf16x8*)(KS + (32 * mj + r32) * RP + 16 * s + 8 * hh), b = *(const bf16x8*)(QS + (32 * ni + r32) * RP + 16 * s + 8 * hh);
            X = __builtin_amdgcn_mfma_f32_32x32x16_bf16(a, b, X, 0, 0, 0); }
#pragma unroll
        for (int r = 0; r < 16; ++r) { const int dm = (32 * ni + r32) - (32 * mj + fa::crow(r, hh)); X[r] *= __builtin_amdgcn_exp2f(lg2 * (float)(dm < 0 ? -dm : dm)); }
#pragma unroll
        for (int s2 = 0; s2 < 2; ++s2) {
            v4u pw; pw.x = pk2(X[8 * s2 + 0], X[8 * s2 + 1]); pw.y = pk2(X[8 * s2 + 2], X[8 * s2 + 3]); pw.z = pk2(X[8 * s2 + 4], X[8 * s2 + 5]); pw.w = pk2(X[8 * s2 + 6], X[8 * s2 + 7]);
            const bf16x8 bwf = tr_frag(VR, PVR, 32 * mj + 16 * s2 + 4 * hh, 32 * mj + 16 * s2 + 8 + 4 * hh, 32 * vi, F.lane);
            oacc = __builtin_amdgcn_mfma_f32_32x32x16_bf16(*(const bf16x8*)&pw, bwf, oacc, 0, 0, 0); }
    }
    {
#pragma unroll
      for (int s = 0; s < 4; ++s) { const bf16x8 a = *(const bf16x8*)(QS + (32 * ni + r32) * RP + 16 * s + 8 * hh), b = I.pvf[s];
          cacc = __builtin_amdgcn_mfma_f32_32x32x16_bf16(a, b, cacc, 0, 0, 0); } }
#pragma unroll
    for (int r = 0; r < 16; ++r) { const int n = 32 * ni + fa::crow(r, hh); OS[n * 132 + 32 * vi + r32] = oacc[r] + __builtin_amdgcn_exp2f(lg2 * (float)(n + 1)) * cacc[r]; }
    __syncthreads(); }
#ifdef DBG_R3T
    unsigned long long t2_ = __builtin_amdgcn_s_memrealtime(); if (FF.tid == 0 && blockIdx.x == 1) __hip_atomic_fetch_add((unsigned long long*)(FF.ctl + 20010 + 2 * 2), t2_ - t1_, RLX_AGENT);
#endif
#pragma unroll 1
    for (int rp3 = 0; rp3 < R3_REP3; ++rp3) {
    { const int n = F.tid >> 3, part = F.tid & 7, pos = 64 * c + n; float x[16]; float s = 0.f;
#pragma unroll
      for (int q = 0; q < 4; ++q) { const f32x4 v = *(const f32x4*)(OS + n * 132 + 16 * part + 4 * q); x[4 * q] = v[0]; x[4 * q + 1] = v[1]; x[4 * q + 2] = v[2]; x[4 * q + 3] = v[3]; s += (v[0] + v[1]) + (v[2] + v[3]); }
      s += __shfl_xor(s, 1); s += __shfl_xor(s, 2); s += __shfl_xor(s, 4);
      const float mu = s * (1.f / 128.f); float q2 = 0.f;
#pragma unroll
      for (int e = 0; e < 16; ++e) { x[e] -= mu; q2 += x[e] * x[e]; }
      q2 += __shfl_xor(q2, 1); q2 += __shfl_xor(q2, 2); q2 += __shfl_xor(q2, 4);
      const float rstd = 1.0f / sqrtf(q2 * (1.f / 128.f) + EPS_);
      const v4u g0 = I.g0, g1 = I.g1;
      float gn[16];
#pragma unroll
      for (int q = 0; q < 4; ++q) { gn[4 * q] = I.gn[q][0]; gn[4 * q + 1] = I.gn[q][1]; gn[4 * q + 2] = I.gn[q][2]; gn[4 * q + 3] = I.gn[q][3]; }
      float y[16];
#pragma unroll
      for (int e = 0; e < 8; ++e) { const unsigned gw_ = e < 4 ? g0[e] : g1[e - 4];
          const float ga = bflo(gw_), gb = bfhi(gw_);
          y[2 * e] = x[2 * e] * rstd * gn[2 * e] * (ga / (1.f + __expf(-ga))); y[2 * e + 1] = x[2 * e + 1] * rstd * gn[2 * e + 1] * (gb / (1.f + __expf(-gb))); }
      bf16* op = (bf16*)(F.ws + WS_MIXED) + (size_t)pos * 2048 + M_RET + 128 * h + 16 * part;
      *(v4u*)op = (v4u){pk2(y[0], y[1]), pk2(y[2], y[3]), pk2(y[4], y[5]), pk2(y[6], y[7])};
      *(v4u*)(op + 8) = (v4u){pk2(y[8], y[9]), pk2(y[10], y[11]), pk2(y[12], y[13]), pk2(y[14], y[15])}; }
    __syncthreads(); }
#ifdef DBG_R3T
    if (FF.tid == 0 && blockIdx.x == 1) { const unsigned long long t3_ = __builtin_amdgcn_s_memrealtime(); __hip_atomic_fetch_add((unsigned long long*)(FF.ctl + 20010 + 2 * 3), t3_ - t2_, RLX_AGENT); }
#endif
}
__device__ __forceinline__ void attn_unit(Frame& F, int h, int qb) {
    using namespace fa;
    const bf16* PJ = (const bf16*)(F.ws + WS_PROJ); const float* CUM = (const float*)(F.ws + WS_CUM) + (size_t)h * S_; const float* MQK = (const float*)(F.ws + WS_MAXQK);
    char* lds = (char*)F.lds; char* V_lds = lds + OFF_V; char* K_lds = lds + OFF_K; float* b_lds = (float*)(lds + OFF_B);
    float* wsm = (float*)(lds + OFF_W) + F.wave * 64; float* li_l = wsm; float* al_l = wsm + 32;
    int tid = F.tid; asm volatile("" : "+v"(tid));
    const int wid = F.wave, lane = tid & 63, r32 = lane & 31, hi = lane >> 5;
    const int qlo = qb * QB + wid * QBLK;
    bf16x8 qr[8];
#pragma unroll
    for (int d0 = 0; d0 < 8; ++d0) qr[d0] = *(const bf16x8*)(PJ + (size_t)(qlo + r32) * NPJ + C_FQ + 128 * h + d0 * 16 + hi * 8);
    const int j_hi = 4 * qb + 4;
    const float cfirst = CUM[qb * QB];
    int j_lo;
    { const float kmx = wave_max(lane <= qb ? MQK[(h * 64 + lane) * 2 + 1] : 0.f);
      const float Dn = MQK[(h * 64 + qb) * 2] * (kmx + MQK[(h * 64 + qb) * 2 + 1]) * SCALE + 30.f;
      int cand = 4 * qb;
#pragma unroll
      for (int i = 0; i < 4; ++i) { const int j = lane + 64 * i; if (j < 4 * qb) { const bool skip = (cfirst - CUM[64 * j + 63]) < -Dn; if (!skip && j < cand) cand = j; } }
      j_lo = wave_min_i(cand); }
    float m_reg = -1e30f, l_reg = 0.f; f32x16 o[4] = {};
    const int sr = tid >> 4, sc = (tid & 15) * 8, vst0 = v_st(sr, sc), vst1 = v_st(32 + sr, sc), kws = KSWZ(sr, sc * 2);
    const int vb0 = (int)(uintptr_t)V_lds + v_rd_base(lane);
    const bf16* Kg = PJ + C_FK + 128 * h + sc; const bf16* Vg = PJ + C_FV + 128 * h + sc;
    v4u k0, k1, v0, v1; float bia = 0.f;
#define ATT_LOAD(t_) do { const int kb_ = (t_) * KVBLK; k0 = *(const v4u*)(Kg + (size_t)(kb_ + sr) * NPJ); k1 = *(const v4u*)(Kg + (size_t)(kb_ + 32 + sr) * NPJ); \
        v0 = *(const v4u*)(Vg + (size_t)(kb_ + sr) * NPJ); v1 = *(const v4u*)(Vg + (size_t)(kb_ + 32 + sr) * NPJ); if (tid < 64) bia = (cfirst - CUM[kb_ + tid]) * (1.0f / SCALE); } while (0)
    ATT_LOAD(j_lo);
    for (int t = j_lo; t < j_hi; ++t) {
        const int kb = t * KVBLK, bo = ((t - j_lo) & 1) * ATT_BUF;
        *(v4u*)(K_lds + bo + kws) = k0; *(v4u*)(K_lds + bo + kws + 32 * 256) = k1; *(v4u*)(V_lds + bo + vst0) = v0; *(v4u*)(V_lds + bo + vst1) = v1;
        if (tid < 64) b_lds[bo / 4 + tid] = bia;
        if (t + 1 < j_hi) ATT_LOAD(t + 1);
        __syncthreads();
        if (kb <= qlo + QBLK - 1) {
            f32x16 p0, p1; float mn, alpha; bf16x8 pa0, pa1, pa2, pa3;
            qkt(p0, p1, K_lds + bo, b_lds + bo / 4, r32, hi, qr);
            if (kb + KVBLK - 1 > qlo) mask_tile(p0, p1, qlo + r32 - 4 * hi - kb);
            partialSM(p0, p1, m_reg, mn, alpha);
            if (__any(alpha < 1.f)) { if (hi == 0) al_l[r32] = alpha; asm volatile("s_waitcnt lgkmcnt(0)" ::: "memory");
#pragma unroll
                for (int d_ = 0; d_ < 4; ++d_)
#pragma unroll
                    for (int r = 0; r < 16; ++r) o[d_][r] *= al_l[crow(r, hi)]; }
            finishSM(p0, p1, alpha, l_reg, pa0, pa1, pa2, pa3);
            pv_tile(o, vb0 + bo, pa0, pa1, pa2, pa3);
        }
    }
#undef ATT_LOAD
    if (hi == 0) li_l[r32] = l_reg; asm volatile("s_waitcnt lgkmcnt(0)" ::: "memory");
    float rli[16];
#pragma unroll
    for (int r = 0; r < 16; ++r) rli[r] = __builtin_amdgcn_rcpf(li_l[crow(r, hi)]);
    bf16* Ow = (bf16*)(F.ws + WS_MIXED) + (size_t)qlo * 2048 + M_FOX + 128 * h;
#pragma unroll
    for (int r = 0; r < 16; ++r) { const int orow = crow(r, hi);
#pragma unroll
        for (int d0 = 0; d0 < 4; ++d0) { const float v = o[d0][r] * rli[r]; const float vn = __shfl_xor(v, 1);
            if ((r32 & 1) == 0) *(unsigned*)(Ow + (size_t)orow * 2048 + d0 * 32 + r32) = cvtpk(v, vn); } }
    __syncthreads();
}
__device__ __forceinline__ int att_jlo(Frame& F, int h, int qb, int lane, float& cfirst) {
    asm volatile("" : "+v"(lane));
    const float* CUM = (const float*)(F.ws + WS_CUM) + (size_t)h * S_; const float* MQK = (const float*)(F.ws + WS_MAXQK);
    cfirst = CUM[qb * 256];
    const float kmx = wave_max(lane <= qb ? MQK[(h * 64 + lane) * 2 + 1] : 0.f);
    const float Dn = MQK[(h * 64 + qb) * 2] * (kmx + MQK[(h * 64 + qb) * 2 + 1]) * fa::SCALE + 30.f;
    int cand = 4 * qb;
    float cj[4];
#pragma unroll
    for (int i = 0; i < 4; ++i) { const int j = lane + 64 * i, jc = j < 4 * qb ? j : 0; cj[i] = CUM[64 * jc + 63]; }
#pragma unroll
    for (int i = 0; i < 4; ++i) { const int j = lane + 64 * i; if (j < 4 * qb) { const bool skip = (cfirst - cj[i]) < -Dn; if (!skip && j < cand) cand = j; } }
    return wave_min_i(cand);
}
__device__ __forceinline__ void att_ref(Frame& F, int id, int lane, fa2::BlockRef& r) {
    const int h = id >> 6, qb = id & 63; const bf16* QH = (const bf16*)(F.ws + WS_QKVH);
    r.Q = QH + ((size_t)(G_FQ + h) * S_ + qb * 256) * 128; r.K = QH + (size_t)(G_FK + h) * S_ * 128; r.V = QH + (size_t)(G_FV + h) * S_ * 128;
    r.O = (bf16*)(F.ws + WS_MIXED) + (size_t)(qb * 256) * 2048 + M_FOX + 128 * h; r.C = (const float*)(F.ws + WS_CUM) + (size_t)h * S_; r.P0 = qb * 256;
    float cf; const int jl = att_jlo(F, h, qb, lane, cf); r.jlo = __builtin_amdgcn_readfirstlane(jl); r.cf = __builtin_bit_cast(float, __builtin_amdgcn_readfirstlane(__builtin_bit_cast(int, cf)));
}
#ifndef REPATT
#define REPATT 1
#endif
#ifndef REPR3
#define REPR3 1
#endif
__device__ __forceinline__ void mixa1_phase(Frame& F, int l, int rep) {
    volatile unsigned* nxt = (volatile unsigned*)(F.lds + LDSCTL_OFF + 64);
    unsigned* head = (unsigned*)(F.ctl + CW_Q + 128 * l + 16 * rep);
#pragma unroll 1
    for (int ra = 0; ra < REPATT; ++ra) {
        int tid = F.tid; asm volatile("" : "+v"(tid)); const int lane = tid & 63;
        unsigned* xh = (unsigned*)(F.ctl + CW_QX + (((l * 2 + rep) * 2 + ra) * 8 + (int)(blockIdx.x & 7)) * 16);
        const int ubase = 48 * (int)(blockIdx.x & 7);
        if (F.tid == 0) *nxt = __hip_atomic_fetch_add(xh, 1u, RLX_AGENT);
        __syncthreads();
        int k = __builtin_amdgcn_readfirstlane((int)*nxt);
        __syncthreads();
        while (k < 48) {
            fa2::Seam S; fa2::BlockRef cur;
            att_ref(F, ubase + k, lane, cur);
#ifdef DBG_TILES
            if (F.tid == 0) __hip_atomic_fetch_add(F.ctl + 20000, (unsigned)((cur.P0 + 255) / 64 + 1 - cur.jlo), RLX_AGENT);
#endif
            fa2::prime(cur, (char*)F.lds, S, tid);
            fa2::block(cur, (char*)F.lds, S, tid);
            if (F.tid == 0) *nxt = __hip_atomic_fetch_add(xh, 1u, RLX_AGENT);
            __syncthreads();
            k = __builtin_amdgcn_readfirstlane((int)*nxt);
            __syncthreads();
        }
    }
    constexpr int N_CONV = 256, N_R1 = 1536;
#pragma unroll 1
    for (int rr = 0; rr < REPR3; ++rr)
    for (;;) {
        if (F.tid == 0) *nxt = __hip_atomic_fetch_add(head + 64 + 4 * rr, 1u, RLX_AGENT);
        __syncthreads();
        const int id = __builtin_amdgcn_readfirstlane((int)*nxt);
        __syncthreads();
        constexpr int N_F1 = N_CONV + (R1_IN_A0 ? 0 : N_R1 / 4), N_CC = CONV_A1 ? 256 : 0;
        if (id >= N_F1 + N_CC) break;
        if (id < N_CONV) conv_item(F, l, id);
        else if (id < N_F1) {
#pragma unroll 1
            for (int q = 0; q < 4; ++q) { const int it = (id - N_CONV) * 4 + q; r1_item(F, it / 6, it % 6); } }
        else convert_items(F, l, 16384 + (id - N_F1) * 32 + F.wave, 8, 4);
    }
}
__device__ __forceinline__ void mixr3_phase(Frame& F, int l) {
    int it = F.vcu;
    if (it < 1536) {
        R3In a, b;
        r3_load(F, l, it / 6, it % 6, a);
        for (;;) {
            const bool hb = it + F.G < 1536; const int itb = hb ? it + F.G : it;
            r3_load(F, l, itb / 6, itb % 6, b);
            r3_compute(F, l, it / 6, it % 6, a);
            if (!hb) break;
            it += F.G;
            const bool ha = it + F.G < 1536; const int ita = ha ? it + F.G : it;
            r3_load(F, l, ita / 6, ita % 6, a);
            r3_compute(F, l, it / 6, it % 6, b);
            if (!ha) break;
            it += F.G;
        }
    }
}

__device__ __forceinline__ void route_phase(Frame& F, int l) {
    const Args& A = *F.a; const float* rb = A.in[I_RB];
    const int t = (F.vcu * NWAVES + F.wave) * 64 + F.lane;
    if (t >= S_) return;
    const float* lg = (const float*)(F.ws + WS_LOGIT) + (size_t)t * 128;
    float bgs = -__builtin_inff(); int be0 = 0, be1 = 0; float ba0 = 0.f, ba1 = 0.f;
#pragma unroll
    for (int g = 0; g < 8; ++g) {
        f32x4 v0 = {0.f, 0.f, 0.f, 0.f}, v1 = {0.f, 0.f, 0.f, 0.f};
#pragma unroll
        for (int ks = 0; ks < 4; ++ks) { const float* p = lg + (size_t)ks * S_ * 128; v0 += *(const f32x4*)(p + 8 * g) + *(const f32x4*)(p + 64 + 8 * g); v1 += *(const f32x4*)(p + 8 * g + 4) + *(const f32x4*)(p + 64 + 8 * g + 4); }
        float s1 = -__builtin_inff(), s2 = -__builtin_inff(), a1 = 0.f, a2 = 0.f; int i1 = 0, i2 = 0;
#pragma unroll
        for (int i = 0; i < 8; ++i) { const float x = i < 4 ? v0[i] : v1[i - 4]; const float aff = 1.f / (1.f + __expf(-x)); const float sel = aff + rb[8 * g + i];
            if (sel > s1) { s2 = s1; i2 = i1; a2 = a1; s1 = sel; i1 = i; a1 = aff; } else if (sel > s2) { s2 = sel; i2 = i; a2 = aff; } }
        const float gs = s1 + s2;
        if (gs > bgs) { bgs = gs; be0 = 8 * g + i1; be1 = 8 * g + i2; ba0 = a1; ba1 = a2; }
    }
    const float inv = 1.f / (ba0 + ba1);
    unsigned* cnt = (unsigned*)(F.ctl + CW_CNT + 64 * l);
    const int p0 = (int)__hip_atomic_fetch_add(cnt + be0, 1u, RLX_AGENT), p1 = (int)__hip_atomic_fetch_add(cnt + be1, 1u, RLX_AGENT);
    int* TOPE = (int*)(F.ws + WS_ROUTE); float* TOPW = (float*)(F.ws + WS_ROUTE + 131072); int* TOPPOS = (int*)(F.ws + WS_ROUTE + 2 * 131072); int* TOKTAB = (int*)(F.ws + WS_TOKTAB);
    TOPE[2 * t] = be0; TOPE[2 * t + 1] = be1; TOPW[2 * t] = ba0 * inv; TOPW[2 * t + 1] = ba1 * inv; TOPPOS[2 * t] = p0; TOPPOS[2 * t + 1] = p1;
    TOKTAB[be0 * 16384 + p0] = t; TOKTAB[be1 * 16384 + p1] = t;
}
#ifndef ROUTER_HILO
#define ROUTER_HILO 0
#endif
__device__ __forceinline__ void normb_route_phase(Frame& F, int l) {
    const Args& A = *F.a;
    constexpr int AP = 2056;
    bf16* Ahi = (bf16*)F.lds; bf16* Alo = Ahi + 16 * AP; float* red = (float*)F.lds; float* fin = red + 8 * 1024;
    static_assert(!ROUTER_HILO, "the modulation vectors reuse the lo tile's LDS");
    float* AVl = (float*)Alo; float* BVl = AVl + 2048;
    const float* MODF = (const float*)(F.ws + WS_MODF) + l * 12288; const float* X1 = (const float*)(F.ws + WS_X1); bf16* H = (bf16*)(F.ws + WS_H);
    const bf16* RW = (const bf16*)(F.ws + WS_RWT2);
    const int lane = F.lane, c0 = lane * 4;
    float a_[4], b_[4];
    {
#pragma unroll
      for (int q = 0; q < 4; ++q) { const int col = F.tid + NWAVES * 64 * q; a_[q] = A.in[I_N2G][l * 2048 + col] * (1.f + MODF[8192 + col]); b_[q] = MODF[6144 + col]; } }

    const int w = F.wave, mr = lane & 15, kq = lane >> 4;
#if !ROUTER_HILO
    bf16x8 wf[8][4];
#pragma unroll
    for (int ks = 0; ks < 8; ++ks)
#pragma unroll
        for (int et = 0; et < 4; ++et) wf[ks][et] = *(const bf16x8*)(RW + (size_t)(16 * et + mr) * 4096 + 256 * w + 32 * ks + 8 * kq);
#endif
    asm volatile("" ::: "memory");
#pragma unroll
    for (int q = 0; q < 4; ++q) { const int col = F.tid + NWAVES * 64 * q; AVl[col] = a_[q]; BVl[col] = b_[q]; }
    __syncthreads();
    for (int blk = F.vcu; blk < S_ / 16; blk += F.G) {
        const int R0 = blk * 16;
        f32x4 xr[2][8];
#pragma unroll
        for (int q = 0; q < 2; ++q) { const int t = R0 + 2 * w + q;
#pragma unroll
            for (int j = 0; j < 8; ++j) {
#if X1_BF16
                { const v2u w2 = *(const v2u*)((const bf16*)X1 + (size_t)t * 2048 + c0 + 256 * j); xr[q][j] = (f32x4){bflo(w2.x), bfhi(w2.x), bflo(w2.y), bfhi(w2.y)}; }
#else
                xr[q][j] = *(const f32x4*)(X1 + (size_t)t * 2048 + c0 + 256 * j);
#endif
            } }
        asm volatile("" ::: "memory");
#pragma unroll
        for (int q = 0; q < 2; ++q) { const int rl = 2 * w + q, t = R0 + rl; f32x4 x[8]; float ss = 0.f;
#pragma unroll
            for (int j = 0; j < 8; ++j) { x[j] = xr[q][j];
                ss += (x[j][0] * x[j][0] + x[j][1] * x[j][1]) + (x[j][2] * x[j][2] + x[j][3] * x[j][3]); }
            const float rs = 1.0f / sqrtf(wave_sum(ss) * (1.f / 2048.f) + EPS_);
#pragma unroll
            for (int j = 0; j < 8; ++j) { const f32x4 hv = x[j] * rs * *(const f32x4*)(AVl + c0 + 256 * j) + *(const f32x4*)(BVl + c0 + 256 * j); v2u o; o.x = pk2(hv[0], hv[1]); o.y = pk2(hv[2], hv[3]);
                v2u ql; ql.x = pk2(hv[0] - bflo(o.x), hv[1] - bfhi(o.x)); ql.y = pk2(hv[2] - bflo(o.y), hv[3] - bfhi(o.y));
                if (MOE_FP8) *(int*)((unsigned char*)H + (size_t)t * 2048 + c0 + 256 * j) = pg8::pk4_fp8(4.f * hv[0], 4.f * hv[1], 4.f * hv[2], 4.f * hv[3]);
                else *(v2u*)(H + (size_t)t * 2048 + c0 + 256 * j) = o;
                *(v2u*)(Ahi + rl * AP + c0 + 256 * j) = o; if (ROUTER_HILO) *(v2u*)(Alo + rl * AP + c0 + 256 * j) = ql; } }
        __syncthreads();
        f32x4 acc[4] = {{0.f, 0.f, 0.f, 0.f}, {0.f, 0.f, 0.f, 0.f}, {0.f, 0.f, 0.f, 0.f}, {0.f, 0.f, 0.f, 0.f}};
#if ROUTER_HILO
#pragma unroll 2
        for (int ks = 0; ks < 8; ++ks) { const int k0 = 256 * w + 32 * ks + 8 * kq;
            const bf16x8 ah = *(const bf16x8*)(Ahi + mr * AP + k0), al = *(const bf16x8*)(Alo + mr * AP + k0);
#pragma unroll
            for (int et = 0; et < 4; ++et) { const bf16x8 wh = *(const bf16x8*)(RW + (size_t)(16 * et + mr) * 4096 + k0), wl = *(const bf16x8*)(RW + (size_t)(64 + 16 * et + mr) * 4096 + k0);
                acc[et] = __builtin_amdgcn_mfma_f32_16x16x32_bf16(ah, wh, acc[et], 0, 0, 0);
                acc[et] = __builtin_amdgcn_mfma_f32_16x16x32_bf16(al, wh, acc[et], 0, 0, 0); acc[et] = __builtin_amdgcn_mfma_f32_16x16x32_bf16(ah, wl, acc[et], 0, 0, 0); } }
#else
#pragma unroll
        for (int ks = 0; ks < 8; ++ks) { const bf16x8 ah = *(const bf16x8*)(Ahi + mr * AP + 256 * w + 32 * ks + 8 * kq);
#pragma unroll
            for (int et = 0; et < 4; ++et) acc[et] = __builtin_amdgcn_mfma_f32_16x16x32_bf16(ah, wf[ks][et], acc[et], 0, 0, 0); }
#endif
        __syncthreads();
#pragma unroll
        for (int et = 0; et < 4; ++et)
#pragma unroll
            for (int r = 0; r < 4; ++r) red[w * 1024 + (4 * kq + r) * 64 + 16 * et + mr] = acc[et][r];
        __syncthreads();
#pragma unroll
        for (int q = 0; q < 2; ++q) { const int idx = F.tid + 512 * q; float s = 0.f;
#pragma unroll
            for (int ww = 0; ww < 8; ++ww) s += red[ww * 1024 + idx];
            fin[idx] = s; }
        __syncthreads();
        if (F.tid < 128) {
            const int rl = F.tid >> 3, g = F.tid & 7, t = R0 + rl; const float* lg = fin + rl * 64 + 8 * g;
            float s1 = -__builtin_inff(), s2 = -__builtin_inff(), a1 = 0.f, a2 = 0.f; int i1 = 0, i2 = 0;
#pragma unroll
            for (int i = 0; i < 8; ++i) { const float aff = 1.f / (1.f + __expf(-lg[i])); const float sel = aff + A.in[I_RB][8 * g + i];
                if (sel > s1) { s2 = s1; i2 = i1; a2 = a1; s1 = sel; i1 = i; a1 = aff; } else if (sel > s2) { s2 = sel; i2 = i; a2 = aff; } }
            float gs = s1 + s2; int bg = g, e0 = 8 * g + i1, e1 = 8 * g + i2;
#pragma unroll
            for (int o = 1; o < 8; o <<= 1) { const float ogs = __shfl_xor(gs, o); const int obg = __shfl_xor(bg, o), oe0 = __shfl_xor(e0, o), oe1 = __shfl_xor(e1, o); const float oa1 = __shfl_xor(a1, o), oa2 = __shfl_xor(a2, o);
                if (ogs > gs || (ogs == gs && obg < bg)) { gs = ogs; bg = obg; e0 = oe0; e1 = oe1; a1 = oa1; a2 = oa2; } }
            if (g == 0) { const float inv = 1.f / (a1 + a2);
                unsigned* cnt = (unsigned*)(F.ctl + CW_CNT + 64 * l);
                const int p0 = (int)__hip_atomic_fetch_add(cnt + e0, 1u, RLX_AGENT), p1 = (int)__hip_atomic_fetch_add(cnt + e1, 1u, RLX_AGENT);
                int* TOPE = (int*)(F.ws + WS_ROUTE); float* TOPW = (float*)(F.ws + WS_ROUTE + 131072); int* TOPPOS = (int*)(F.ws + WS_ROUTE + 2 * 131072); int* TOKTAB = (int*)(F.ws + WS_TOKTAB);
                TOPE[2 * t] = e0; TOPE[2 * t + 1] = e1; TOPW[2 * t] = a1 * inv; TOPW[2 * t + 1] = a2 * inv; TOPPOS[2 * t] = p0; TOPPOS[2 * t + 1] = p1;
                TOKTAB[e0 * 16384 + p0] = t; TOKTAB[e1 * 16384 + p1] = t; } }
        __syncthreads();
    }
}
__device__ __forceinline__ int moe_tables(Frame& F, int l) {
    int* te = (int*)(F.lds + LDS_TE); int* off = (int*)(F.lds + LDS_OFFS); int* cn = off + 128;
    const unsigned* cnt = (const unsigned*)(F.ctl + CW_CNT + 64 * l);
    static_assert(NE == 64, "one expert per lane of wave 0");
    if (__builtin_amdgcn_readfirstlane(F.tid >> 6) == 0) {
        const int e = F.lane;
        const int c = (int)__hip_atomic_load(cnt + e, RLX_AGENT);
        const int n = (c + 255) >> 8;
        int incl = n;
#pragma unroll
        for (int o = 1; o < 64; o <<= 1) { const int t = __shfl_up(incl, o); if (e >= o) incl += t; }
        const int start = incl - n;
        cn[e] = c; off[e] = start * 256;
        for (int q = 0; q < n; ++q) { const int ti = start + q; if (ti < 192) te[ti] = e; }
        if (e == NE - 1) off[NE] = incl < 192 ? incl : 192;
    }
    __syncthreads();
    return off[NE];
}
template <class Sched>
__device__ __forceinline__ void moe_tokbuf(Frame& F, const Sched& S) {
    const int* te = (const int*)(F.lds + LDS_TE); const int* off = (const int*)(F.lds + LDS_OFFS); const int* cn = off + 128; int* tb = (int*)(F.lds + LDS_TOK);
    const int* TOKTAB = (const int*)(F.ws + WS_TOKTAB);
    const int tr = F.tid & 255;
#pragma unroll 1
    for (int i0 = 0; i0 < 9; i0 += 3) { int tv[3]; bool ok[3];
#pragma unroll
        for (int q = 0; q < 3; ++q) { pg8::Unit u; ok[q] = S.next(i0 + q, u); const int pm = ok[q] ? u.pm : 0; const int e = te[pm], idx = (pm - (off[e] >> 8)) * 256 + tr; const bool in = ok[q] && idx < cn[e];
            tv[q] = TOKTAB[in ? e * 16384 + idx : 0]; if (!in) tv[q] = 0; }
        asm volatile("" ::: "memory");
#pragma unroll
        for (int q = 0; q < 3; ++q) if (ok[q] && F.tid < 256) tb[(i0 + q) * 256 + F.tid] = tv[q];
        if (!ok[2]) break; }
    __syncthreads();
}

constexpr int N_PHASES = 24;
#ifndef MK_PER_PHASE
#define MK_PER_PHASE 0
#endif
__global__ void __launch_bounds__(NWAVES * 64, 2) fwd_kernel(Args args) {
    extern __shared__ __attribute__((aligned(16))) unsigned char lds[];
    Frame F;
    F.lds = lds; F.ws = args.ws; F.a = &args; F.ctl = (gu32*)(args.ws + WS_CTL);
    F.tid = threadIdx.x; F.lane = F.tid & 63; F.wave = __builtin_amdgcn_readfirstlane(F.tid >> 6);
    F.G = gridDim.x; { const int bx = blockIdx.x; F.vcu = (F.G % 8 == 0) ? (bx % 8) * (F.G / 8) + bx / 8 : bx; }
    for (int u = F.tid; u < (LDS_BYTES - LDSCTL_OFF) / 4; u += NWAVES * 64) ((unsigned*)(lds + LDSCTL_OFF))[u] = 0u;
    __syncthreads();
    XcdBarrier bar; bar.bar = (unsigned*)(F.ctl + CW_BAR); bar.x = 0; bar.st = nullptr; bar.wv = (unsigned)F.wave;
    if (!MK_PER_PHASE) bar = xcd_barrier_post((unsigned*)(F.ctl + CW_BAR), (volatile LAS unsigned*)(lds + LDSCTL_OFF));
#ifdef DBG_XCC
    if (threadIdx.x == 0) __hip_atomic_store(F.ctl + 16384 + blockIdx.x, 1u + (xb_xcc_id() & 15u), RLX_AGENT);
#endif
    const int lo = args.ph_lo, hi = args.ph_hi; (void)lo; (void)hi;
#ifndef PHMASK
#define PHMASK 0xFFFFFF
#endif
#if MK_PER_PHASE
#define IN(k) (lo <= (k) && (k) < hi)
#else
#define IN(k) true
#endif
#define EN(j) ((PHMASK >> (j)) & 1)
#ifndef REPMASK
#define REPMASK 0
#endif
#define NREP(j) (((REPMASK >> (j)) & 1) ? 2 : 1)
#define REFRESH() do { int t_ = (F.wave << 6) | LANE_ID(); asm volatile("" : "+v"(t_)); F.tid = t_; F.lane = t_ & 63; unsigned long long z_ = 0; asm volatile("" : "+s"(z_)); F.ws = args.ws + z_; F.ctl = (gu32*)(F.ws + WS_CTL); int g_ = (int)gridDim.x, b_ = (int)blockIdx.x; asm volatile("" : "+s"(g_), "+s"(b_)); F.G = g_; F.vcu = (g_ % 8 == 0) ? (b_ % 8) * (g_ / 8) + b_ / 8 : b_; } while (0)
#ifndef G1_ALIGN
#define G1_ALIGN true
#endif
#ifndef DOWN_ALIGN
#define DOWN_ALIGN true
#endif
#ifndef MOE_BAUX
#define MOE_BAUX 0
#endif
#ifndef NBAR
#define NBAR 1
#endif
#ifndef MOE_CONV_IN_G1
#define MOE_CONV_IN_G1 1
#endif
#define CONV_G1_LIM (CONV_A1 ? 16384 : 24576)
#ifndef REPCONV
#define REPCONV 1
#endif
#ifndef G1_SLOTS
#define G1_SLOTS 7
#endif
#define SEAM(k) do { if (IN((k) + 1)) { if (!MK_PER_PHASE) { bar.bar = (unsigned*)(F.ctl + CW_BAR); for (int nb_ = 0; nb_ < NBAR; ++nb_) xcd_barrier(bar); } } } while (0)
    LAS unsigned char* ldsl = (LAS unsigned char*)lds;

    if (EN(11) && IN(0)) { _Pragma("unroll 1") for (int rep = 0; rep < NREP(11); ++rep) p0_prologue(F);
        if (MOE_CONV_IN_G1 != 1) { __syncthreads(); _Pragma("unroll 1") for (int l = 0; l < NL; ++l) { REFRESH(); const int w0 = F.vcu * NWAVES + F.wave, NGW = F.G * NWAVES; convert_items(F, l, w0, NGW, (24576 - w0 + NGW - 1) / NGW); } }
        SEAM(0); }
    for (int l = 0; l < NL; ++l) {
        const int pb = 1 + 11 * l;
        if (EN(0) && IN(pb + 0)) { _Pragma("unroll 1") for (int rep = 0; rep < NREP(0); ++rep) { REFRESH(); if (l == 0) { if (EN(13)) norm_phase<0>(F, l); } else { if (EN(14)) norm_phase<1>(F, l); } } SEAM(pb + 0); }
        if (EN(1) && IN(pb + 1)) { _Pragma("unroll 1") for (int rep = 0; rep < NREP(1); ++rep) {
            _Pragma("unroll 1") for (int part = 0; part < (MOE_CONV_IN_G1 ? 2 : 1); ++part) { REFRESH();
                pg8::Gemm g{(const bf16*)(F.ws + WS_H), (const bf16*)(F.ws + WS_WIN) + (size_t)l * NPJ * 2048, S_, NPJ, 2048, 2048, 0};
                pg8::DenseOrder S; S.init(S_, NPJ, 2048, F.G, (int)blockIdx.x);
                pg8::EpiBf16 E{(bf16*)(F.ws + WS_PROJ), NPC, (bf16*)(F.ws + WS_QKVH), C_RQ, S_, 1.f};
                if (MOE_CONV_IN_G1) { const int slot = (((int)blockIdx.x >> 3) * G1_SLOTS) >> 5;
                    S.i0 = part ? slot : 0; S.cnt = part ? (1 << 30) : slot; }
                pg8::gemm_phase<pg8::EpiBf16, pg8::DenseOrder, G1_ALIGN, true>(ldsl + RING_OFF, g, S, E, F.wave);
                if (MOE_CONV_IN_G1 == 1 && part == 0) { __syncthreads(); const int w0 = F.vcu * NWAVES + F.wave, NGW = F.G * NWAVES;
                    _Pragma("unroll 1") for (int rc = 0; rc < REPCONV; ++rc) convert_items(F, l, w0, NGW, (CONV_G1_LIM - w0 + NGW - 1) / NGW); __syncthreads(); }
            }
            } SEAM(pb + 1); }
        if (EN(2) && IN(pb + 2)) { _Pragma("unroll 1") for (int rep = 0; rep < NREP(2); ++rep) { REFRESH(); mixa0_phase(F); } SEAM(pb + 2); }
        if (EN(3) && IN(pb + 3)) { _Pragma("unroll 1") for (int rep = 0; rep < NREP(3); ++rep) { REFRESH(); mixa1_phase(F, l, rep); } SEAM(pb + 3); }
        if (EN(4) && IN(pb + 4)) { _Pragma("unroll 1") for (int rep = 0; rep < NREP(4); ++rep) { REFRESH(); mixb_phase(F); } SEAM(pb + 4); }
        if (EN(5) && IN(pb + 5)) { _Pragma("unroll 1") for (int rep = 0; rep < NREP(5); ++rep) { REFRESH(); mixr3_phase(F, l); } SEAM(pb + 5); }
        if (EN(6) && IN(pb + 6)) { _Pragma("unroll 1") for (int rep = 0; rep < NREP(6); ++rep) { REFRESH();
            pg8::Gemm g{(const bf16*)(F.ws + WS_MIXED), (const bf16*)(F.ws + WS_WOUT) + (size_t)l * 2048 * 2048, S_, 2048, 2048, 2048, 0};
            pg8::DenseOrder S; S.init(S_, 2048, 2048, F.G, (int)blockIdx.x);
            pg8::EpiResid E{l == 0 ? args.in[I_X] : (const float*)args.out, (float*)(F.ws + WS_X1), (const float*)(F.ws + WS_MODF) + l * 12288 + 4096, 2048};
            pg8::gemm_phase<pg8::EpiResid, pg8::DenseOrder, true, true>(ldsl + RING_OFF, g, S, E, F.wave);
            } SEAM(pb + 6); }
        if (EN(7) && IN(pb + 7)) { _Pragma("unroll 1") for (int rep = 0; rep < NREP(7); ++rep) { REFRESH(); if (rep == 0) normb_route_phase(F, l); } SEAM(pb + 7); }
        if (EN(9) && IN(pb + 9)) { _Pragma("unroll 1") for (int rep = 0; rep < NREP(9); ++rep) { REFRESH();
            const int nT = moe_tables(F, l);
#if MOE_FP8
            pg8::Gemm g{(const bf16*)(F.ws + WS_H), (const bf16*)(F.ws + WS_WGU + (size_t)l * NE * 1024 * 2048), PMAX, 1024, 1024, 1024, 2048};
            pg8::MoeOrder S{(const LAS int*)(ldsl + LDS_TE), nT, 4, F.G, (int)blockIdx.x, (long)1024 * 2048, (long)256 * 2048, 0, (const LAS int*)(ldsl + LDS_TOK)};
            moe_tokbuf(F, S);
            pg8::EpiGateUp8 E{F.ws + WS_ACT, DE, 1.f / 128.f, 4.f};
            pg8::gemm_phase<pg8::EpiGateUp8, pg8::MoeOrder, true, true, true, MOE_BAUX, true>(ldsl + RING_OFF, g, S, E, F.wave);
#else
            pg8::Gemm g{(const bf16*)(F.ws + WS_H), (const bf16*)(F.ws + WS_WGU) + (size_t)l * NE * 1024 * 2048, PMAX, 1024, 2048, 2048, 4096};
            pg8::MoeOrder S{(const LAS int*)(ldsl + LDS_TE), nT, 4, F.G, (int)blockIdx.x, (long)1024 * 2048 * 2, (long)256 * 2048 * 2, 0, (const LAS int*)(ldsl + LDS_TOK)};
            moe_tokbuf(F, S);
            pg8::EpiGateUp E{(bf16*)(F.ws + WS_ACT), DE};
            pg8::gemm_phase<pg8::EpiGateUp, pg8::MoeOrder, true, true, true, MOE_BAUX>(ldsl + RING_OFF, g, S, E, F.wave);
#endif
            } SEAM(pb + 9); }
        if (EN(10) && IN(pb + 10)) { _Pragma("unroll 1") for (int rep = 0; rep < NREP(10); ++rep) { REFRESH();
            const int nT = moe_tables(F, l);
#if MOE_FP8
            pg8::Gemm g{(const bf16*)(F.ws + WS_ACT), (const bf16*)(F.ws + WS_WD + (size_t)l * NE * 2048 * 512), PMAX, 2048, 256, 256, 0};
            pg8::MoeOrder S{(const LAS int*)(ldsl + LDS_TE), nT, 8, F.G, (int)blockIdx.x, (long)2048 * 512, (long)256 * 512, (long)256 * 512, (const LAS int*)(ldsl + LDS_TOK)};
            pg8::EpiFp8 E{F.ws + WS_YS, 2048, 16.f / 128.f};
            pg8::gemm_phase<pg8::EpiFp8, pg8::MoeOrder, DOWN_ALIGN, true, false, MOE_BAUX, true>(ldsl + RING_OFF, g, S, E, F.wave);
#else
            pg8::Gemm g{(const bf16*)(F.ws + WS_ACT), (const bf16*)(F.ws + WS_WD) + (size_t)l * NE * 2048 * 512, PMAX, 2048, DE, DE, 0};
            pg8::MoeOrder S{(const LAS int*)(ldsl + LDS_TE), nT, 8, F.G, (int)blockIdx.x, (long)2048 * 512 * 2, (long)256 * 512 * 2, (long)256 * 512 * 2, (const LAS int*)(ldsl + LDS_TOK)};
            pg8::EpiBf16 E{(bf16*)(F.ws + WS_YS), 2048, nullptr, 0, 0, 1.f};
            pg8::gemm_phase<pg8::EpiBf16, pg8::MoeOrder, DOWN_ALIGN, true, false, MOE_BAUX>(ldsl + RING_OFF, g, S, E, F.wave);
#endif
            } SEAM(pb + 10); }
    }
    if (EN(12) && IN(23)) { REFRESH(); norm_phase<3>(F, NL - 1);
#ifdef DBG_R3T
        xcd_barrier(bar);
        { const unsigned long long tt = __hip_atomic_load((unsigned long long*)(F.ctl + 20010 + 2 * DBG_R3T), RLX_AGENT); const float us = (float)tt * 0.01f / 12.f;
          const float sc = 1.f + us * 0.1f;
          for (size_t i = (size_t)blockIdx.x * 512 + threadIdx.x; i < (size_t)S_ * D_; i += (size_t)gridDim.x * 512) args.out[i] *= sc; }
#endif
#ifdef DBG_TILES
        xcd_barrier(bar);
        { const float avg = (float)__hip_atomic_load(F.ctl + 20000, RLX_AGENT) / 768.f; const float sc = 1.f + avg * 0.01f;
          for (size_t i = (size_t)blockIdx.x * 512 + threadIdx.x; i < (size_t)S_ * D_; i += (size_t)gridDim.x * 512) args.out[i] *= sc; }
#endif
#ifdef DBG_XCC
        xcd_barrier(bar);
        { bool okA = true, okB = true; for (int b = 0; b < 256; ++b) { const unsigned xb = __hip_atomic_load(F.ctl + 16384 + b, RLX_AGENT); if (xb != __hip_atomic_load(F.ctl + 16384 + (b & 7), RLX_AGENT)) okA = false; if (xb != __hip_atomic_load(F.ctl + 16384 + (b & ~31), RLX_AGENT)) okB = false; }
          const float sc = okA ? 1.1f : (okB ? 1.2f : 1.3f);
          for (size_t i = (size_t)blockIdx.x * 512 + threadIdx.x; i < (size_t)S_ * D_; i += (size_t)gridDim.x * 512) args.out[i] *= sc; }
#endif
    }
#undef IN
#undef SEAM
}

extern "C" void kernel_launch(void* const* d_in, const int* in_sizes, int n_in, void* d_out, int out_size, void* d_ws, size_t ws_size, hipStream_t stream) {
    static int grid = 0;
    if (grid == 0) {
        if (n_in != 17 || out_size != S_ * D_ || ws_size < WS_END) { fprintf(stderr, "kernel_launch: unexpected shapes (n_in %d out %d ws %zu)\n", n_in, out_size, ws_size); grid = -1; return; }
        int dev = 0, cus = 0, per_cu = 0;
        if (hipGetDevice(&dev) != hipSuccess || hipDeviceGetAttribute(&cus, hipDeviceAttributeMultiprocessorCount, dev) != hipSuccess) { grid = -1; return; }
        if (hipFuncSetAttribute((const void*)fwd_kernel, hipFuncAttributeMaxDynamicSharedMemorySize, LDS_BYTES) != hipSuccess) { fprintf(stderr, "kernel_launch: hipFuncSetAttribute failed\n"); grid = -1; return; }
        if (hipOccupancyMaxActiveBlocksPerMultiprocessor(&per_cu, (const void*)fwd_kernel, NWAVES * 64, LDS_BYTES) != hipSuccess || per_cu < 1)
            fprintf(stderr, "kernel_launch: note: occupancy query reports %d workgroups per CU\n", per_cu);
        (void)hipGetLastError();
        grid = cus;
    }
    if (grid < 0) return;
    if (hipMemsetAsync((char*)d_ws + WS_CTL, 0, CTL_ZERO_BYTES, stream) != hipSuccess) return;
    Args a{};
    for (int i = 0; i < 17; ++i) a.in[i] = (const float*)d_in[i];
    a.out = (float*)d_out; a.ws = (unsigned char*)d_ws;
#if MK_PER_PHASE
    for (int p = 0; p < N_PHASES; ++p) { a.ph_lo = p; a.ph_hi = p + 1; fwd_kernel<<<dim3(grid), dim3(NWAVES * 64), LDS_BYTES, stream>>>(a); }
#else
    a.ph_lo = 0; a.ph_hi = N_PHASES; fwd_kernel<<<dim3(grid), dim3(NWAVES * 64), LDS_BYTES, stream>>>(a);
#endif
}
```
